# Optimizing an MI355X kernel written in HIP

```python
import math
import jax, jax.numpy as jnp
from jax import lax
import numpy as np

D_MODEL = 2048
BATCH = 16
SEQ = 256
DEPTH = 4
DEC_BATCH = 2
DEC_SEQ = 2048
PAST_LEN = 256

GRID_W = 64
EPS = 1e-6
ROPE_BASE = 10000.0
Q_BLOCK = 128

MLA_HEADS = 8
QK_NOPE = 128
QK_ROPE = 64
V_HEAD = 128
Q_LORA = 512
KV_LORA = 512
MLA_W = MLA_HEADS * V_HEAD
SGU_CHUNK = 128
SGU_GROUPS = 8
SGU_W = 1024
SGU_GC = SGU_W // SGU_GROUPS
RET_HEADS = 8
RET_DK = 128
RET_DV = 128
RET_W = RET_HEADS * RET_DV
RET_CHUNK = 128
N_BRANCH = 3

IN_SPLITS = (Q_LORA, KV_LORA, QK_ROPE, MLA_W,
             SGU_W, SGU_W, SGU_W,
             RET_HEADS * RET_DK, RET_HEADS * RET_DK, RET_W, RET_W,
             N_BRANCH * D_MODEL)
IN_COLS = sum(IN_SPLITS)

kernel_name = "hybrid_mla_sgu_retention_diffusion_step"


def rms_norm(x, g):
    xf = x.astype(jnp.float32)
    y = xf * lax.rsqrt(jnp.mean(xf * xf, axis=-1, keepdims=True) + EPS)
    return (y * g.astype(jnp.float32)).astype(x.dtype)


def axial_rope(n_tok):
    rows = n_tok // GRID_W
    row = jnp.repeat(jnp.arange(rows, dtype=jnp.float32), GRID_W)
    col = jnp.tile(jnp.arange(GRID_W, dtype=jnp.float32), rows)
    n_freq = QK_ROPE // 4
    inv = ROPE_BASE ** (-jnp.arange(n_freq, dtype=jnp.float32) / n_freq)
    ang_r = (row[:, None] * inv)[:, None, :]
    ang_c = (col[:, None] * inv)[:, None, :]
    return (jnp.cos(ang_r), jnp.sin(ang_r), jnp.cos(ang_c), jnp.sin(ang_c))


def rotate_pairs(x, cos, sin):
    x1, x2 = jnp.split(x, 2, axis=-1)
    return jnp.concatenate([x1 * cos - x2 * sin, x2 * cos + x1 * sin], axis=-1)


def apply_axial_rope(x, rope):
    cr, sr, cc, sc = rope
    xf = x.astype(jnp.float32)
    half = QK_ROPE // 2
    out = jnp.concatenate([rotate_pairs(xf[..., :half], cr, sr),
                           rotate_pairs(xf[..., half:], cc, sc)], axis=-1)
    return out.astype(x.dtype)


def block_attention(q, k, v):
    b, lq, h, dk = q.shape
    scale = dk ** -0.5
    qb = q.reshape(b, lq // Q_BLOCK, Q_BLOCK, h, dk).transpose(1, 0, 2, 3, 4)

    def one(qblk):
        s = jnp.einsum('bqhd,bkhd->bhqk', qblk, k).astype(jnp.float32) * scale
        p = jax.nn.softmax(s, axis=-1).astype(v.dtype)
        return jnp.einsum('bhqk,bkhe->bqhe', p, v)

    o = lax.map(one, qb)
    return o.transpose(1, 0, 2, 3, 4).reshape(b, lq, h, v.shape[-1])


def mla_query(cq, g_q, w_uq, rope):
    b, L, _ = cq.shape
    q = (rms_norm(cq, g_q) @ w_uq).reshape(b, L, MLA_HEADS, QK_NOPE + QK_ROPE)
    if rope is not None:
        q = jnp.concatenate([q[..., :QK_NOPE], apply_axial_rope(q[..., QK_NOPE:], rope)], axis=-1)
    return q


def mla_keys(ckv_n, k_rope, w_ukv):
    b, L, _ = ckv_n.shape
    kv = (ckv_n @ w_ukv).reshape(b, L, MLA_HEADS, QK_NOPE + V_HEAD)
    k = jnp.concatenate([kv[..., :QK_NOPE],
                         jnp.broadcast_to(k_rope[:, :, None, :], (b, L, MLA_HEADS, QK_ROPE))], axis=-1)
    return k, kv[..., QK_NOPE:]


def chunk_sgu(u, v, g_sgu, w_s, b_s):
    b, L, _ = u.shape
    vn = rms_norm(v, g_sgu).reshape(b, L // SGU_CHUNK, SGU_CHUNK, SGU_GROUPS, SGU_GC)
    s = jnp.einsum('gpq,bnqgc->bnpgc', w_s, vn) + b_s[None, None, :, :, None]
    return u * s.reshape(b, L, SGU_W).astype(u.dtype)


def retention_scan(q, k, v, log_g, r0, inclusive):
    b, L, h, _ = q.shape
    C = RET_CHUNK
    n = L // C
    idx = jnp.arange(C, dtype=jnp.float32)
    diff = idx[:, None] - idx[None, :]
    mask = (diff >= 0) if inclusive else (diff > 0)
    dec = jnp.where(mask[None], jnp.exp(jnp.where(mask, diff, 0.0)[None] * log_g[:, None, None]), 0.0)
    xi = jnp.exp((idx[:, None] + 1.0) * log_g[None, :])[None, :, :, None]
    zeta = jnp.exp((C - 1.0 - idx)[:, None] * log_g[None, :])[None, :, :, None]
    g_c = jnp.exp(C * log_g)[None, :, None, None]

    def to_chunks(t):
        return t.reshape(b, n, C, h, t.shape[-1]).transpose(1, 0, 2, 3, 4)

    def step(r, inp):
        qc, kc, vc = inp
        att = jnp.einsum('bihd,bjhd->bhij', qc, kc) * dec[None]
        o = jnp.einsum('bhij,bjhe->bihe', att, vc) + jnp.einsum('bihd,bhde->bihe', qc, r) * xi
        r = g_c * r + jnp.einsum('bjhd,bjhe->bhde', kc * zeta, vc)
        return r, o

    r, o = lax.scan(step, r0, (to_chunks(q), to_chunks(k), to_chunks(v)))
    return o.transpose(1, 0, 2, 3, 4).reshape(b, L, h, v.shape[-1]), r


def bidir_retention(q, k, v, log_g2, r0_f, r0_b):
    o_f, r_f = retention_scan(q, k, v, log_g2[0], r0_f, True)
    flip = lambda t: jnp.flip(t, axis=1)
    o_b, r_b = retention_scan(flip(q), flip(k), flip(v), log_g2[1], r0_b, False)
    return o_f + flip(o_b), r_f, r_b


def head_layer_norm(o, g):
    b, L = o.shape[:2]
    mu = jnp.mean(o, axis=-1, keepdims=True)
    var = jnp.mean(jnp.square(o - mu), axis=-1, keepdims=True)
    y = (o - mu) * lax.rsqrt(var + EPS)
    return y.reshape(b, L, RET_W) * g.astype(jnp.float32)


def layer_forward(x, cond, lw, rope, ctx):
    b, L, _ = x.shape
    mod = jax.nn.silu(cond) @ lw['w_mod'] + lw['b_mod']
    shift, scale, gate = jnp.split(mod[:, None, :], 3, axis=-1)
    h = rms_norm(x, lw['g_pre']) * (1 + scale) + shift
    z = h @ lw['w_in']
    offs = tuple(int(o) for o in np.cumsum(IN_SPLITS)[:-1])
    (cq, ckv_raw, krope, gp_mla, u, v_s, gp_sgu, rq, rk, rv, gp_ret, merge) = jnp.split(z, offs, axis=-1)

    ckv_n = rms_norm(ckv_raw, lw['g_kv'])
    if rope is not None:
        krope = apply_axial_rope(krope[:, :, None, :], rope)[:, :, 0, :]
    q = mla_query(cq, lw['g_q'], lw['w_uq'], rope)
    k, vv = mla_keys(ckv_n, krope, lw['w_ukv'])
    if ctx is not None:
        kc, vc = mla_keys(ctx[0], ctx[1], lw['w_ukv'])
        k = jnp.concatenate([kc, k], axis=1)
        vv = jnp.concatenate([vc, vv], axis=1)
    o_mla = block_attention(q, k, vv).reshape(b, L, MLA_W)

    o_sgu = chunk_sgu(u, v_s, lw['g_sgu'], lw['w_sgu'], lw['b_sgu'])

    log_g2 = jax.nn.log_sigmoid(lw['ret_decay'].astype(jnp.float32))
    rqf = rq.reshape(b, L, RET_HEADS, RET_DK).astype(jnp.float32)
    rkf = rk.reshape(b, L, RET_HEADS, RET_DK).astype(jnp.float32) * (RET_DK ** -0.5)
    rvf = rv.reshape(b, L, RET_HEADS, RET_DV).astype(jnp.float32)
    if ctx is None:
        r0_f = jnp.zeros((b, RET_HEADS, RET_DK, RET_DV), jnp.float32)
        r0_b = r0_f
    else:
        r0_f = ctx[2].astype(jnp.float32)
        r0_b = ctx[3].astype(jnp.float32)
    o_ret, r_f, r_b = bidir_retention(rqf, rkf, rvf, log_g2, r0_f, r0_b)
    o_ret = head_layer_norm(o_ret, lw['g_ret']).astype(x.dtype)

    y_mla = (jax.nn.silu(gp_mla) * o_mla) @ lw['w_br_mla']
    y_sgu = (jax.nn.silu(gp_sgu) * o_sgu) @ lw['w_br_sgu']
    y_ret = (jax.nn.silu(gp_ret) * o_ret) @ lw['w_br_ret']
    m_mla, m_sgu, m_ret = jnp.split(jax.nn.sigmoid(merge), N_BRANCH, axis=-1)
    y = (m_mla * y_mla + m_sgu * y_sgu + m_ret * y_ret) @ lw['w_out']
    x = x + gate * rms_norm(y, lw['g_post'])
    return x, (ckv_n, krope, r_f.astype(x.dtype), r_b.astype(x.dtype))


def setup_inputs(seed: int = 0) -> dict:
    key = jax.random.key(seed)
    ks = jax.random.split(key, 25)
    f32 = jnp.float32
    nrm = lambda k, shape, s: jax.random.normal(k, shape, f32) * s
    heads = jnp.arange(RET_HEADS, dtype=f32)
    one_minus = 2.0 ** (-5.0 - heads)
    decay_logit = jnp.log1p(-one_minus) - jnp.log(one_minus)
    return {
        "x_prompt": nrm(ks[0], (BATCH, SEQ, D_MODEL), 1.0),
        "x_sample": nrm(ks[1], (DEC_BATCH, DEC_SEQ, D_MODEL), 1.0),
        "cache_ckv": nrm(ks[2], (DEC_BATCH, DEPTH, PAST_LEN, KV_LORA), 1.0),
        "cache_krope": nrm(ks[3], (DEC_BATCH, DEPTH, PAST_LEN, QK_ROPE), 1.0),
        "state_ret": nrm(ks[4], (DEC_BATCH, DEPTH, 2, RET_HEADS, RET_DK, RET_DV), 0.5),
        "c": nrm(ks[5], (DEC_BATCH, D_MODEL), 1.0),
        "c_ctx": nrm(ks[6], (D_MODEL,), 1.0),
        "w_mod": nrm(ks[7], (DEPTH, D_MODEL, 3 * D_MODEL), 0.5 * D_MODEL ** -0.5),
        "b_mod": nrm(ks[8], (DEPTH, 3 * D_MODEL), 0.01),
        "g_pre": 1.0 + nrm(ks[9], (DEPTH, D_MODEL), 0.1),
        "g_post": 1.0 + nrm(ks[10], (DEPTH, D_MODEL), 0.1),
        "w_in": nrm(ks[11], (DEPTH, D_MODEL, IN_COLS), D_MODEL ** -0.5),
        "g_q": 1.0 + nrm(ks[12], (DEPTH, Q_LORA), 0.1),
        "g_kv": 1.0 + nrm(ks[13], (DEPTH, KV_LORA), 0.1),
        "w_uq": nrm(ks[14], (DEPTH, Q_LORA, MLA_HEADS * (QK_NOPE + QK_ROPE)), Q_LORA ** -0.5),
        "w_ukv": nrm(ks[15], (DEPTH, KV_LORA, MLA_HEADS * (QK_NOPE + V_HEAD)), KV_LORA ** -0.5),
        "g_sgu": 1.0 + nrm(ks[16], (DEPTH, SGU_W), 0.1),
        "w_sgu": nrm(ks[17], (DEPTH, SGU_GROUPS, SGU_CHUNK, SGU_CHUNK), SGU_CHUNK ** -0.5),
        "b_sgu": nrm(ks[18], (DEPTH, SGU_CHUNK, SGU_GROUPS), 0.1),
        "ret_decay": decay_logit[None, None, :] + nrm(ks[19], (DEPTH, 2, RET_HEADS), 0.1),
        "g_ret": 1.0 + nrm(ks[20], (DEPTH, RET_W), 0.1),
        "w_br_mla": nrm(ks[21], (DEPTH, MLA_W, D_MODEL), MLA_W ** -0.5),
        "w_br_sgu": nrm(ks[22], (DEPTH, SGU_W, D_MODEL), SGU_W ** -0.5),
        "w_br_ret": nrm(ks[23], (DEPTH, RET_W, D_MODEL), RET_W ** -0.5),
        "w_out": nrm(ks[24], (DEPTH, D_MODEL, D_MODEL), D_MODEL ** -0.5),
    }


def reference(x_prompt, x_sample, cache_ckv, cache_krope, state_ret, c, c_ctx,
              w_mod, b_mod, g_pre, g_post, w_in, g_q, g_kv, w_uq, w_ukv,
              g_sgu, w_sgu, b_sgu, ret_decay, g_ret, w_br_mla, w_br_sgu, w_br_ret, w_out):
    def layer_weights(l):
        return dict(w_mod=w_mod[l], b_mod=b_mod[l], g_pre=g_pre[l], g_post=g_post[l], w_in=w_in[l],
                    g_q=g_q[l], g_kv=g_kv[l], w_uq=w_uq[l], w_ukv=w_ukv[l], g_sgu=g_sgu[l],
                    w_sgu=w_sgu[l], b_sgu=b_sgu[l], ret_decay=ret_decay[l], g_ret=g_ret[l],
                    w_br_mla=w_br_mla[l], w_br_sgu=w_br_sgu[l], w_br_ret=w_br_ret[l], w_out=w_out[l])

    y_prompt = x_prompt
    ckvs, kropes, rets = [], [], []
    for l in range(DEPTH):
        y_prompt, (ckv_n, kr, r_f, r_b) = layer_forward(y_prompt, c_ctx[None, :], layer_weights(l), None, None)
        ckvs.append(ckv_n)
        kropes.append(kr)
        rets.append(jnp.stack([r_f, r_b], axis=1))
    new_ckv = jnp.stack(ckvs, axis=1)
    new_krope = jnp.stack(kropes, axis=1)
    new_ret = jnp.stack(rets, axis=1)

    rope = axial_rope(x_sample.shape[1])
    y_sample = x_sample
    for l in range(DEPTH):
        ctx = (cache_ckv[:, l], cache_krope[:, l], state_ret[:, l, 0], state_ret[:, l, 1])
        y_sample, _ = layer_forward(y_sample, c, layer_weights(l), rope, ctx)

    return (y_prompt, y_sample, new_ckv, new_krope, new_ret)
```

```cpp
#define MK_MULTI 0
#include <hip/hip_runtime.h>
#include <hip/hip_cooperative_groups.h>
#include <cstdio>
namespace cg = cooperative_groups;

#define LAS __attribute__((address_space(3)))
typedef unsigned short bf16_t;
typedef short bf16x8 __attribute__((ext_vector_type(8)));
typedef float f32x4 __attribute__((ext_vector_type(4)));
typedef float f32x16 __attribute__((ext_vector_type(16)));
typedef unsigned u32x4 __attribute__((ext_vector_type(4)));
typedef unsigned u32x2 __attribute__((ext_vector_type(2)));

constexpr int NTHREADS = 512;
constexpr int LDS_BYTES = 147456;
constexpr int T = 8192, DM = 2048, ZW = 15616, NL = 4, INC = 15424;
constexpr float EPSN = 1e-6f;
constexpr int Z_CQ = 0, Z_CKV = 512, Z_GPM = 1024, Z_U = 2048, Z_VS = 3072, Z_GPS = 4096, Z_RQ = 5120, Z_RK = 6144, Z_RV = 7168, Z_GPR = 8192, Z_MRG = 9216, Z_KR = 15360;
constexpr size_t OUT_YP = 0, OUT_YS = 8388608, OUT_CKV = 16777216, OUT_KR = 25165824, OUT_RET = 26214400;

constexpr size_t O_WIN = 0,                         S_WIN = (size_t)NL * ZW * 2048 * 2;
constexpr size_t O_WUQ = O_WIN + S_WIN,             S_WUQ = (size_t)NL * 1536 * 512 * 2;
constexpr size_t O_WKG = O_WUQ + S_WUQ,             S_WK = (size_t)NL * 1024 * 512 * 2;
constexpr size_t O_WVG = O_WKG + S_WK;
constexpr size_t O_WKP = O_WVG + S_WK;
constexpr size_t O_WVP = O_WKP + S_WK;
constexpr size_t O_WBR = O_WVP + S_WK,              S_WBR = (size_t)NL * 3 * 2048 * 1024 * 2;
constexpr size_t O_WOUT = O_WBR + S_WBR,            S_WOUT = (size_t)NL * 2048 * 2048 * 2;
constexpr size_t O_CKVC = O_WOUT + S_WOUT,          S_CKVC = (size_t)NL * 512 * 512 * 2;
constexpr size_t O_KRC = O_CKVC + S_CKVC,           S_KRC = (size_t)NL * 512 * 64 * 2;
constexpr size_t O_KC = O_KRC + S_KRC,              S_KC = (size_t)NL * 512 * 1024 * 2;
constexpr size_t O_VTC = O_KC + S_KC;
constexpr size_t O_MOD = O_VTC + S_KC,              S_MOD = (size_t)NL * 3 * 6144 * 4;
constexpr size_t O_ROPE = O_MOD + S_MOD,            S_ROPE = 64 * 16 * 8;
constexpr size_t O_RSS = O_ROPE + S_ROPE,           S_RSS = (size_t)4 * T * 4;
constexpr size_t O_H = O_RSS + S_RSS,               S_H = (size_t)T * DM * 2;
constexpr size_t O_X = O_H + S_H,                   S_X = (size_t)T * DM * 4;
constexpr size_t O_Z = O_X + S_X,                   S_Z = (size_t)T * ZW * 2;
constexpr size_t O_VST = O_Z + S_Z,                 S_T16 = (size_t)1024 * T * 2;
constexpr size_t O_RVT = O_VST + S_T16;
constexpr size_t O_VT = O_RVT + S_T16;
constexpr size_t O_KN = O_VT + S_T16;
constexpr size_t O_AM = O_KN + S_T16;
constexpr size_t O_AS = O_AM + S_T16;
constexpr size_t O_AR = O_AS + S_T16;
constexpr size_t O_Q = O_AR + S_T16,                S_Q = (size_t)T * 1536 * 2;
constexpr size_t O_KR = O_Q + S_Q,                  S_KR = (size_t)T * 64 * 2;
constexpr size_t O_ST = O_KR + S_KR,                S_ST = (size_t)64 * 8 * 2 * 16384 * 4;
constexpr size_t O_YMF = O_ST + S_ST;
constexpr size_t O_YMB = O_YMF + S_X;
constexpr size_t O_Y = O_YMB + S_H;
constexpr size_t WS_END = O_Y + S_X;

struct Args { const float* in[25]; float* out; unsigned char* ws; int ph_lo, ph_hi; };

__device__ __forceinline__ unsigned cvt_pk(float lo, float hi) { unsigned r; asm volatile("v_cvt_pk_bf16_f32 %0, %1, %2" : "=v"(r) : "v"(lo), "v"(hi)); return r; }
__device__ __forceinline__ float bf2f(unsigned short b) { return __uint_as_float(((unsigned)b) << 16); }
__device__ __forceinline__ float bflo(unsigned w) { return __uint_as_float(w << 16); }
__device__ __forceinline__ float bfhi(unsigned w) { return __uint_as_float(w & 0xffff0000u); }
__device__ __forceinline__ float silu_f(float x) { return x / (1.f + __expf(-x)); }
__device__ __forceinline__ float sigm_f(float x) { return 1.f / (1.f + __expf(-x)); }
__device__ __forceinline__ float wave_sum(float v) {
#pragma unroll
    for (int o = 1; o < 64; o <<= 1) v += __shfl_xor(v, o);
    return v;
}

namespace pg8 {
constexpr int BM = 256, BK = 64, HALF = 128, HTB = HALF * BK * 2, STAGE_BYTES = 8 * HTB, NXCD = 8, WGM = 8;
__host__ __device__ __forceinline__ int lds_byte(int r, int c) { const int st = (r >> 4) * 2 + (c >> 5), rr = r & 15, cc = c & 31, ob = rr * 64 + cc * 2; return st * 1024 + (ob ^ (((ob >> 9) & 1) << 5)); }
__host__ __device__ __forceinline__ void stage_rc(int b, int& R, int& C) { const int st = b / 1024, sb = b % 1024, swz = sb ^ (((sb >> 9) & 1) << 5); R = (st >> 1) * 16 + swz / 64; C = (st & 1) * 32 + (swz % 64) / 2; }
__host__ __device__ __forceinline__ int perm32(int rho) { const int n = rho >> 4, i = rho & 15; return 8 * (i >> 2) + 4 * n + (i & 3); }

struct Unit { const char* a; const char* b; int pm, pn, kind, aux; };

__device__ __forceinline__ void tile_order(int L, int nM, int nN, int& pm, int& pn) {
    const int nwg = nM * nN; int wgid = L; { const int q = nwg / NXCD, r = nwg % NXCD, xcd = wgid % NXCD, off = wgid / NXCD; wgid = (xcd < r ? xcd * (q + 1) : r * (q + 1) + (xcd - r) * q) + off; }
    const int nig = WGM * nN, gid = wgid / nig, fm = gid * WGM, gsz = (nM - fm) < WGM ? (nM - fm) : WGM;
    pm = fm + ((wgid % nig) % gsz); pn = (wgid % nig) / gsz;
}

template <class Epi, class Sched>
__device__ __forceinline__ void gemm_phase(LAS unsigned char* lds, const int tid, const int K, const int lda, const int ldb, const Sched& S, const Epi& E) {
    const int  wid = __builtin_amdgcn_readfirstlane(tid >> 6), lane = tid & 63, wr = wid >> 2, wc = wid & 3, fr = lane & 15, fq = lane >> 4;
    const int nt = K / BK;
    unsigned voffA[2], voffB[2];
#pragma unroll
    for (int i = 0; i < 2; ++i) { int R, C; stage_rc(tid * 16 + i * 8192, R, C); const int Rb = (R & ~31) + perm32(R & 31);
        voffA[i] = (unsigned)(R * lda + C) * 2u; voffB[i] = (unsigned)(Rb * ldb + C) * 2u; }
    const size_t kstep = (size_t)(BK * 2);
    const size_t hstepA = (size_t)HALF * lda * 2, hstepB = (size_t)HALF * ldb * 2;
    const unsigned ldsw = (unsigned)wid * 1024u;
    const int aoff = lds_byte(wr * 64 + fr, fq * 8), boff = lds_byte(wc * 32 + fr, fq * 8);
#define PG8_SA(b, h) (((b) * 2 + (h)) * HTB)
#define PG8_SB(b, h) ((4 + (b) * 2 + (h)) * HTB)
#define PG8_STAGE(bufoff, gbase, voff) do { _Pragma("unroll") for (int _i = 0; _i < 2; ++_i) \
        __builtin_amdgcn_global_load_lds((const unsigned*)((const char*)(gbase) + (voff)[_i]), (LAS unsigned*)(lds + (bufoff) + ldsw + _i * 8192), 16, 0, 0); } while (0)
#define PG8_LDA(dst, b, h) do { _Pragma("unroll") for (int m = 0; m < 4; ++m) _Pragma("unroll") for (int k = 0; k < 2; ++k) dst[m][k] = *(const LAS bf16x8*)(lds + PG8_SA(b, h) + aoff + m * 2048 + k * 1024); } while (0)
#define PG8_LDB(dst, b, h) do { _Pragma("unroll") for (int n = 0; n < 2; ++n) _Pragma("unroll") for (int k = 0; k < 2; ++k) dst[n][k] = *(const LAS bf16x8*)(lds + PG8_SB(b, h) + boff + n * 2048 + k * 1024); } while (0)
#define PG8_MMA(ai, bj, At, Bt) do { __builtin_amdgcn_s_setprio(1); _Pragma("unroll") for (int m = 0; m < 4; ++m) _Pragma("unroll") for (int n = 0; n < 2; ++n) _Pragma("unroll") for (int k = 0; k < 2; ++k) \
        acc[ai][bj][m][n] = __builtin_amdgcn_mfma_f32_16x16x32_bf16(Bt[n][k], At[m][k], acc[ai][bj][m][n], 0, 0, 0); __builtin_amdgcn_s_setprio(0); } while (0)
#define PG8_WAIT_V(n) asm volatile("s_waitcnt vmcnt(" #n ")" ::: "memory")
#define PG8_WAIT_L(n) asm volatile("s_waitcnt lgkmcnt(" #n ")" ::: "memory")
#define PG8_BAR __builtin_amdgcn_s_barrier()
#define PG8_SCHED __builtin_amdgcn_sched_barrier(0)
    Unit cur, nxt; int ui = 0;
    if (!S.next(0, cur)) return;
    f32x4 acc[2][2][4][2];
#pragma unroll
    for (int a = 0; a < 2; ++a)
#pragma unroll
        for (int b = 0; b < 2; ++b)
#pragma unroll
            for (int m = 0; m < 4; ++m)
#pragma unroll
                for (int n = 0; n < 2; ++n) acc[a][b][m][n] = (f32x4){0.f, 0.f, 0.f, 0.f};
    bf16x8 At[4][2], B0[2][2], B1[2][2];
    const char* cA = cur.a; const char* cB = cur.b;
    PG8_STAGE(PG8_SB(0, 0), cB, voffB); PG8_STAGE(PG8_SA(0, 0), cA, voffA); PG8_STAGE(PG8_SB(0, 1), cB + hstepB, voffB); PG8_STAGE(PG8_SA(0, 1), cA + hstepA, voffA);
    if (wr == 1) PG8_BAR;
    PG8_WAIT_V(4); PG8_BAR;
    PG8_STAGE(PG8_SB(1, 0), cB + kstep, voffB); PG8_STAGE(PG8_SA(1, 0), cA + kstep, voffA); PG8_STAGE(PG8_SB(1, 1), cB + hstepB + kstep, voffB);
    PG8_WAIT_V(6); PG8_BAR;
    for (;;) {
        const bool has_next = S.next(ui + 1, nxt);
        const char* nA = has_next ? nxt.a : cA; const char* nB = has_next ? nxt.b : cB;
        for (int t = 0; t < nt; t += 2) {
            const bool last = (t == nt - 2);
            const char* a1 = cA + (size_t)(t + 1) * kstep;
            const char* a2 = last ? nA : cA + (size_t)(t + 2) * kstep; const char* b2 = last ? nB : cB + (size_t)(t + 2) * kstep;
            const char* a3 = a2 + kstep; const char* b3 = b2 + kstep;
            PG8_LDB(B0, 0, 0); PG8_SCHED; PG8_LDA(At, 0, 0); PG8_STAGE(PG8_SA(1, 1), a1 + hstepA, voffA);
            PG8_WAIT_L(8); PG8_BAR; PG8_WAIT_L(0); PG8_MMA(0, 0, At, B0); PG8_BAR; PG8_SCHED;
            PG8_LDB(B1, 0, 1); PG8_STAGE(PG8_SB(0, 0), b2, voffB);
            PG8_BAR; PG8_WAIT_L(0); PG8_MMA(0, 1, At, B1); PG8_BAR;
            PG8_LDA(At, 0, 1); PG8_STAGE(PG8_SA(0, 0), a2, voffA);
            PG8_BAR; PG8_WAIT_L(0); PG8_MMA(1, 0, At, B0); PG8_BAR; PG8_SCHED;
            PG8_STAGE(PG8_SB(0, 1), b2 + hstepB, voffB);
            PG8_WAIT_V(6); PG8_BAR; PG8_MMA(1, 1, At, B1); PG8_BAR;
            PG8_LDB(B0, 1, 0); PG8_SCHED; PG8_LDA(At, 1, 0); PG8_STAGE(PG8_SA(0, 1), a2 + hstepA, voffA);
            PG8_WAIT_L(8); PG8_BAR; PG8_WAIT_L(0); PG8_MMA(0, 0, At, B0); PG8_BAR; PG8_SCHED;
            PG8_LDB(B1, 1, 1); PG8_STAGE(PG8_SB(1, 0), b3, voffB);
            PG8_BAR; PG8_WAIT_L(0); PG8_MMA(0, 1, At, B1); PG8_BAR;
            PG8_LDA(At, 1, 1); PG8_STAGE(PG8_SA(1, 0), a3, voffA);
            PG8_BAR; PG8_WAIT_L(0); PG8_MMA(1, 0, At, B0); PG8_BAR; PG8_SCHED;
            PG8_STAGE(PG8_SB(1, 1), b3 + hstepB, voffB);
            PG8_WAIT_V(6); PG8_BAR; PG8_MMA(1, 1, At, B1); PG8_BAR;
        }
        E(acc, cur, wr, wc, fr, fq);
        if (!has_next) break;
#pragma unroll
        for (int a = 0; a < 2; ++a)
#pragma unroll
            for (int b = 0; b < 2; ++b)
#pragma unroll
                for (int m = 0; m < 4; ++m)
#pragma unroll
                    for (int n = 0; n < 2; ++n) acc[a][b][m][n] = (f32x4){0.f, 0.f, 0.f, 0.f};
        cur = nxt; cA = nA; cB = nB; ++ui;
    }
    PG8_WAIT_V(0);
    if (wr == 0) PG8_BAR;
    PG8_BAR;
#undef PG8_SA
#undef PG8_SB
#undef PG8_STAGE
#undef PG8_LDA
#undef PG8_LDB
#undef PG8_MMA
#undef PG8_WAIT_V
#undef PG8_WAIT_L
#undef PG8_BAR
#undef PG8_SCHED
}
}
typedef const f32x4 (&AccRef)[2][2][4][2];
using pg8::Unit;
typedef const unsigned long long __attribute__((address_space(4)))* CPtr64;
struct InTab { CPtr64 p; __device__ __forceinline__ const float* operator[](int i) const { return (const float*)p[i]; } };
struct Ctx {
    unsigned char* ws; float* out; InTab in;
    int G, c, tid;
};
#define WSP(T_, off) ((T_*)(X.ws + (off)))

struct SchedZ {
    const char* h; const char* w; int G, c;
    __device__ __forceinline__ bool next(int i, Unit& u) const {
        const long Lx = (long)i * G + c; if (Lx >= 32 * 61) return false;
        int pm, pn; pg8::tile_order((int)Lx, 32, 61, pm, pn);
        const char* hp = h + (size_t)pm * 256 * 2048 * 2; const char* wp = w + (size_t)pn * 256 * 2048 * 2;
        const bool sw = (pn >= 12 && pn < 16) || (pn >= 28 && pn < 32);
        u.pm = pm; u.pn = pn; u.kind = sw ? 1 : 0; u.aux = 0; u.a = sw ? wp : hp; u.b = sw ? hp : wp; return true;
    }
};
struct EpiZ {
    bf16_t* z; bf16_t* vsT; bf16_t* rvT; float* rss;
    __device__ __forceinline__ void operator()(AccRef acc, const Unit& u, int wr, int wc, int fr, int fq) const {
        if (u.kind == 0) {
            const int pn = u.pn;
            const int act = (pn >= 36 && pn < 60) ? 2 : ((pn >= 4 && pn < 8) || (pn >= 16 && pn < 20) || (pn >= 32 && pn < 36)) ? 1 : (pn >= 24 && pn < 28) ? 3 : 0;
            const int row0 = u.pm * 256 + wr * 64 + fr, col0 = pn * 256 + wc * 32 + 8 * fq;
#pragma unroll
            for (int ai = 0; ai < 2; ++ai)
#pragma unroll
                for (int m = 0; m < 4; ++m) {
                    const int row = row0 + ai * 128 + m * 16; bf16_t* rowp = z + (size_t)row * ZW + col0; float ss = 0.f;
#pragma unroll
                    for (int bj = 0; bj < 2; ++bj) { f32x4 v0 = acc[ai][bj][m][0], v1 = acc[ai][bj][m][1];
                        if (act == 0) { ss += v0[0] * v0[0] + v0[1] * v0[1] + v0[2] * v0[2] + v0[3] * v0[3] + v1[0] * v1[0] + v1[1] * v1[1] + v1[2] * v1[2] + v1[3] * v1[3]; }
                        else if (act == 1) {
#pragma unroll
                            for (int j = 0; j < 4; ++j) { v0[j] = silu_f(v0[j]); v1[j] = silu_f(v1[j]); } }
                        else if (act == 2) {
#pragma unroll
                            for (int j = 0; j < 4; ++j) { v0[j] = sigm_f(v0[j]); v1[j] = sigm_f(v1[j]); } }
                        else { v0 = v0 * 0.08838834764831845f; v1 = v1 * 0.08838834764831845f; }
                        u32x4 w; w.x = cvt_pk(v0[0], v0[1]); w.y = cvt_pk(v0[2], v0[3]); w.z = cvt_pk(v1[0], v1[1]); w.w = cvt_pk(v1[2], v1[3]);
                        *(u32x4*)(rowp + bj * 128) = w; }
                    if (pn < 4) { ss += __shfl_xor(ss, 16); ss += __shfl_xor(ss, 32); if (fq == 0) atomicAdd(rss + (pn >> 1) * T + row, ss); }
                }
        } else {
            const bool isv = u.pn < 16; bf16_t* dst = isv ? vsT : rvT; const int f0 = (u.pn - (isv ? 12 : 28)) * 256 + wr * 64 + fr, tok0 = u.pm * 256 + wc * 32 + 8 * fq;
            float cs[2][2][4];
#pragma unroll
            for (int bj = 0; bj < 2; ++bj)
#pragma unroll
                for (int n = 0; n < 2; ++n)
#pragma unroll
                    for (int j = 0; j < 4; ++j) cs[bj][n][j] = 0.f;
#pragma unroll
            for (int ai = 0; ai < 2; ++ai)
#pragma unroll
                for (int m = 0; m < 4; ++m) { bf16_t* rowp = dst + (size_t)(f0 + ai * 128 + m * 16) * T + tok0;
#pragma unroll
                    for (int bj = 0; bj < 2; ++bj) { const f32x4 v0 = acc[ai][bj][m][0], v1 = acc[ai][bj][m][1];
#pragma unroll
                        for (int j = 0; j < 4; ++j) { cs[bj][0][j] += v0[j] * v0[j]; cs[bj][1][j] += v1[j] * v1[j]; }
                        u32x4 w; w.x = cvt_pk(v0[0], v0[1]); w.y = cvt_pk(v0[2], v0[3]); w.z = cvt_pk(v1[0], v1[1]); w.w = cvt_pk(v1[2], v1[3]);
                        *(u32x4*)(rowp + bj * 128) = w; } }
            if (isv) {
#pragma unroll
                for (int bj = 0; bj < 2; ++bj)
#pragma unroll
                    for (int n = 0; n < 2; ++n)
#pragma unroll
                        for (int j = 0; j < 4; ++j) { float s = cs[bj][n][j]; s += __shfl_xor(s, 1); s += __shfl_xor(s, 2); s += __shfl_xor(s, 4); s += __shfl_xor(s, 8);
                            if (fr == 0) atomicAdd(rss + 2 * T + tok0 + bj * 128 + n * 4 + j, s); }
            }
        }
    }
};

struct SchedQK {
    const char* z; const char* wq; const char* wk; int G, c;
    __device__ __forceinline__ bool next(int i, Unit& u) const {
        const int Lx = i * G + c; if (Lx >= 320) return false;
        if (Lx < 192) { u.pm = Lx / 6; u.pn = Lx % 6; u.kind = 0; u.a = z + (size_t)u.pm * 256 * ZW * 2 + Z_CQ * 2; u.b = wq + (size_t)u.pn * 256 * 512 * 2; }
        else { const int r = Lx - 192; u.pm = r / 4; u.pn = r % 4; u.kind = 1; u.a = z + (size_t)u.pm * 256 * ZW * 2 + Z_CKV * 2; u.b = wk + (size_t)u.pn * 256 * 512 * 2; }
        u.aux = 0; return true;
    }
};
constexpr float QSCALE = 0.07216878364870322f * 1.4426950408889634f;
struct EpiQK {
    bf16_t* q; bf16_t* kn; const float* rss; const float* rope;
    __device__ __forceinline__ void operator()(AccRef acc, const Unit& u, int wr, int wc, int fr, int fq) const {
        const int row0 = u.pm * 256 + wr * 64 + fr, col0 = u.pn * 256 + wc * 32 + 8 * fq;
        if (u.kind == 0) {
#pragma unroll
            for (int ai = 0; ai < 2; ++ai)
#pragma unroll
                for (int m = 0; m < 4; ++m) {
                    const int row = row0 + ai * 128 + m * 16; const float ri = rsqrtf(rss[row] * (1.f / 512.f) + EPSN) * QSCALE;
                    const int t = (row - 4096) & 2047;
#pragma unroll
                    for (int bj = 0; bj < 2; ++bj) { f32x4 v0 = acc[ai][bj][m][0] * ri, v1 = acc[ai][bj][m][1] * ri;
                        const int g0 = u.pn * 256 + bj * 128 + wc * 32, off = g0 % 192;
                        if (off >= 128 && row >= 4096) {
                            const int p = (off == 128) ? (t >> 6) : (t & 63); const float* tb = rope + (p * 16 + (fq & 1) * 8) * 2;
                            const float sg = (fq & 2) ? 1.f : -1.f;
#pragma unroll
                            for (int j = 0; j < 4; ++j) { const float p0 = __shfl_xor(v0[j], 32), p1 = __shfl_xor(v1[j], 32);
                                const float c0 = tb[2 * j], s0 = tb[2 * j + 1], c1 = tb[2 * (4 + j)], s1 = tb[2 * (4 + j) + 1];
                                v0[j] = v0[j] * c0 + sg * p0 * s0; v1[j] = v1[j] * c1 + sg * p1 * s1; }
                        }
                        u32x4 w; w.x = cvt_pk(v0[0], v0[1]); w.y = cvt_pk(v0[2], v0[3]); w.z = cvt_pk(v1[0], v1[1]); w.w = cvt_pk(v1[2], v1[3]);
                        *(u32x4*)(q + (size_t)row * 1536 + col0 + bj * 128) = w; }
                }
        } else {
#pragma unroll
            for (int ai = 0; ai < 2; ++ai)
#pragma unroll
                for (int m = 0; m < 4; ++m) {
                    const int row = row0 + ai * 128 + m * 16; const float ri = rsqrtf(rss[T + row] * (1.f / 512.f) + EPSN);
#pragma unroll
                    for (int bj = 0; bj < 2; ++bj) { const f32x4 v0 = acc[ai][bj][m][0] * ri, v1 = acc[ai][bj][m][1] * ri;
                        u32x4 w; w.x = cvt_pk(v0[0], v0[1]); w.y = cvt_pk(v0[2], v0[3]); w.z = cvt_pk(v1[0], v1[1]); w.w = cvt_pk(v1[2], v1[3]);
                        *(u32x4*)(kn + (size_t)row * 1024 + col0 + bj * 128) = w; }
                }
        }
    }
};

struct SchedVT {
    const char* z; const char* wv; int G, c;
    __device__ __forceinline__ bool next(int i, Unit& u) const {
        const int Lx = i * G + c; if (Lx >= 128) return false;
        u.pm = Lx & 3; u.pn = Lx >> 2; u.kind = 0; u.aux = 0; u.a = wv + (size_t)u.pm * 256 * 512 * 2; u.b = z + (size_t)u.pn * 256 * ZW * 2 + Z_CKV * 2; return true;
    }
};
struct EpiVT {
    bf16_t* vt; const float* rss;
    __device__ __forceinline__ void operator()(AccRef acc, const Unit& u, int wr, int wc, int fr, int fq) const {
        const int f0 = u.pm * 256 + wr * 64 + fr, tok0 = u.pn * 256 + wc * 32 + 8 * fq;
        f32x4 ri[2][2];
#pragma unroll
        for (int bj = 0; bj < 2; ++bj)
#pragma unroll
            for (int n = 0; n < 2; ++n)
#pragma unroll
                for (int j = 0; j < 4; ++j) ri[bj][n][j] = rsqrtf(rss[T + tok0 + bj * 128 + n * 4 + j] * (1.f / 512.f) + EPSN);
#pragma unroll
        for (int ai = 0; ai < 2; ++ai)
#pragma unroll
            for (int m = 0; m < 4; ++m) { bf16_t* rowp = vt + (size_t)(f0 + ai * 128 + m * 16) * T + tok0;
#pragma unroll
                for (int bj = 0; bj < 2; ++bj) { const f32x4 v0 = acc[ai][bj][m][0] * ri[bj][0], v1 = acc[ai][bj][m][1] * ri[bj][1];
                    u32x4 w; w.x = cvt_pk(v0[0], v0[1]); w.y = cvt_pk(v0[2], v0[3]); w.z = cvt_pk(v1[0], v1[1]); w.w = cvt_pk(v1[2], v1[3]);
                    *(u32x4*)(rowp + bj * 128) = w; } }
    }
};

struct SchedC {
    const char* cc; const char* wk; const char* wv; int G, c;
    __device__ __forceinline__ bool next(int i, Unit& u) const {
        const int Lx = i * G + c; if (Lx >= 64) return false;
        const int l = Lx >> 4, r = Lx & 15; u.aux = l;
        if (r < 8) { u.kind = 0; u.pm = r >> 2; u.pn = r & 3; u.a = cc + ((size_t)l * 512 + u.pm * 256) * 512 * 2; u.b = wk + ((size_t)l * 1024 + u.pn * 256) * 512 * 2; }
        else { const int s = r - 8; u.kind = 1; u.pm = s >> 1; u.pn = s & 1; u.a = wv + ((size_t)l * 1024 + u.pm * 256) * 512 * 2; u.b = cc + ((size_t)l * 512 + u.pn * 256) * 512 * 2; }
        return true;
    }
};
struct EpiC {
    bf16_t* kc; bf16_t* vtc;
    __device__ __forceinline__ void operator()(AccRef acc, const Unit& u, int wr, int wc, int fr, int fq) const {
        const int r0 = u.pm * 256 + wr * 64 + fr, c0 = u.pn * 256 + wc * 32 + 8 * fq;
        bf16_t* base = u.kind == 0 ? kc + (size_t)u.aux * 512 * 1024 : vtc + (size_t)u.aux * 1024 * 512; const int ld = u.kind == 0 ? 1024 : 512;
#pragma unroll
        for (int ai = 0; ai < 2; ++ai)
#pragma unroll
            for (int m = 0; m < 4; ++m) { bf16_t* rowp = base + (size_t)(r0 + ai * 128 + m * 16) * ld + c0;
#pragma unroll
                for (int bj = 0; bj < 2; ++bj) { const f32x4 v0 = acc[ai][bj][m][0], v1 = acc[ai][bj][m][1];
                    u32x4 w; w.x = cvt_pk(v0[0], v0[1]); w.y = cvt_pk(v0[2], v0[3]); w.z = cvt_pk(v1[0], v1[1]); w.w = cvt_pk(v1[2], v1[3]);
                    *(u32x4*)(rowp + bj * 128) = w; } }
    }
};

struct SchedBr {
    const char* am; const char* as; const char* ar; const char* w; int G, c;
    __device__ __forceinline__ bool next(int i, Unit& u) const {
        const int tile = (i / 3) * G + c; if (tile >= 256) return false;
        const int br = i % 3; pg8::tile_order(tile, 32, 8, u.pm, u.pn); u.kind = br; u.aux = 0;
        u.a = (br == 0 ? am : br == 1 ? as : ar) + (size_t)u.pm * 256 * 1024 * 2; u.b = w + ((size_t)br * 2048 + u.pn * 256) * 1024 * 2; return true;
    }
};
struct EpiBr {
    const bf16_t* z; float* ymf; bf16_t* ymb;
    __device__ __forceinline__ void operator()(AccRef acc, const Unit& u, int wr, int wc, int fr, int fq) const {
        const int row0 = u.pm * 256 + wr * 64 + fr, col0 = u.pn * 256 + wc * 32 + 8 * fq;
#pragma unroll
        for (int ai = 0; ai < 2; ++ai)
#pragma unroll
            for (int m = 0; m < 4; ++m) { const int row = row0 + ai * 128 + m * 16;
#pragma unroll
                for (int bj = 0; bj < 2; ++bj) { const int col = col0 + bj * 128;
                    const u32x4 mg = *(const u32x4*)(z + (size_t)row * ZW + Z_MRG + u.kind * 2048 + col);
                    f32x4 v0 = acc[ai][bj][m][0], v1 = acc[ai][bj][m][1];
                    v0[0] *= bflo(mg.x); v0[1] *= bfhi(mg.x); v0[2] *= bflo(mg.y); v0[3] *= bfhi(mg.y); v1[0] *= bflo(mg.z); v1[1] *= bfhi(mg.z); v1[2] *= bflo(mg.w); v1[3] *= bfhi(mg.w);
                    float* yp = ymf + (size_t)row * DM + col;
                    if (u.kind > 0) { v0 += *(const f32x4*)yp; v1 += *(const f32x4*)(yp + 4); }
                    if (u.kind < 2) { *(f32x4*)yp = v0; *(f32x4*)(yp + 4) = v1; }
                    else { u32x4 w; w.x = cvt_pk(v0[0], v0[1]); w.y = cvt_pk(v0[2], v0[3]); w.z = cvt_pk(v1[0], v1[1]); w.w = cvt_pk(v1[2], v1[3]);
                        *(u32x4*)(ymb + (size_t)row * DM + col) = w; }
                } }
    }
};

struct SchedOut {
    const char* a; const char* w; int G, c;
    __device__ __forceinline__ bool next(int i, Unit& u) const {
        const int tile = i * G + c; if (tile >= 256) return false;
        pg8::tile_order(tile, 32, 8, u.pm, u.pn); u.kind = 0; u.aux = 0; u.a = a + (size_t)u.pm * 256 * 2048 * 2; u.b = w + (size_t)u.pn * 256 * 2048 * 2; return true;
    }
};
struct EpiOut {
    float* y; float* rss;
    __device__ __forceinline__ void operator()(AccRef acc, const Unit& u, int wr, int wc, int fr, int fq) const {
        const int row0 = u.pm * 256 + wr * 64 + fr, col0 = u.pn * 256 + wc * 32 + 8 * fq;
#pragma unroll
        for (int ai = 0; ai < 2; ++ai)
#pragma unroll
            for (int m = 0; m < 4; ++m) { const int row = row0 + ai * 128 + m * 16; float ss = 0.f;
#pragma unroll
                for (int bj = 0; bj < 2; ++bj) { const f32x4 v0 = acc[ai][bj][m][0], v1 = acc[ai][bj][m][1]; float* yp = y + (size_t)row * DM + col0 + bj * 128;
                    ss += v0[0] * v0[0] + v0[1] * v0[1] + v0[2] * v0[2] + v0[3] * v0[3] + v1[0] * v1[0] + v1[1] * v1[1] + v1[2] * v1[2] + v1[3] * v1[3];
                    *(f32x4*)yp = v0; *(f32x4*)(yp + 4) = v1; }
                ss += __shfl_xor(ss, 16); ss += __shfl_xor(ss, 32); if (fq == 0) atomicAdd(rss + 3 * T + row, ss); }
    }
};
__device__ __forceinline__ void transpose_item(const float* W, int K, int N, int k0, int n0, bf16_t* dst0, const float* gk, LAS float* scr, int lane) {
#pragma unroll 8
    for (int i = 0; i < 32; ++i) { const int kk = 2 * i + (lane >> 5); float v = W[(size_t)(k0 + kk) * N + n0 + (lane & 31)]; if (gk) v *= gk[k0 + kk]; scr[kk * 33 + (lane & 31)] = v; }
    asm volatile("s_waitcnt lgkmcnt(0)" ::: "memory");
    const int c = lane & 7;
#pragma unroll
    for (int j = 0; j < 4; ++j) { const int n = (lane >> 3) + 8 * j; const LAS float* s = scr + (8 * c) * 33 + n;
        u32x4 o; o.x = cvt_pk(s[0 * 33], s[1 * 33]); o.y = cvt_pk(s[2 * 33], s[3 * 33]); o.z = cvt_pk(s[4 * 33], s[5 * 33]); o.w = cvt_pk(s[6 * 33], s[7 * 33]);
        *(u32x4*)(dst0 + (size_t)n * K + k0 + 8 * c) = o; }
    asm volatile("s_waitcnt lgkmcnt(0)" ::: "memory");
}

__device__ __forceinline__ void phase_prologue(const Ctx& X, LAS unsigned char* lds) {
    const int tid = X.tid, lane = tid & 63, wave = tid >> 6;
    const int gw = X.c * 8 + wave, NGW = X.G * 8;
    LAS float* scr = (LAS float*)(lds + wave * 8704);
    constexpr int I_IN = 32 * 482, I_UQ = 8 * 48, I_UKV = 8 * 64, I_BR = 16 * 64, I_OUT = 32 * 64;
    constexpr int PER_L = I_IN + I_UQ + 2 * I_UKV + 3 * I_BR + I_OUT;
    for (int it = gw; it < NL * PER_L; it += NGW) {
        const int l = it / PER_L; int r = it % PER_L;
        if (r < I_IN) { const int kb = r / 482, nb = r % 482, n0 = nb * 32; const int d0 = n0 < 1024 ? n0 : (n0 < 1088 ? Z_KR + (n0 - 1024) : n0 - 64);
            transpose_item(X.in[11] + (size_t)l * 2048 * INC, 2048, INC, kb * 64, n0, WSP(bf16_t, O_WIN) + ((size_t)l * ZW + d0) * 2048, nullptr, scr, lane); continue; }
        r -= I_IN;
        if (r < I_UQ) { const int kb = r / 48, nb = r % 48;
            transpose_item(X.in[14] + (size_t)l * 512 * 1536, 512, 1536, kb * 64, nb * 32, WSP(bf16_t, O_WUQ) + ((size_t)l * 1536 + nb * 32) * 512, X.in[12] + l * 512, scr, lane); continue; }
        r -= I_UQ;
        if (r < 2 * I_UKV) { const int gfold = r >= I_UKV; if (gfold) r -= I_UKV; const int kb = r / 64, nb = r % 64, n0 = nb * 32, hd = n0 >> 8, d = n0 & 255;
            bf16_t* dst = (d < 128 ? WSP(bf16_t, gfold ? O_WKG : O_WKP) : WSP(bf16_t, gfold ? O_WVG : O_WVP)) + ((size_t)l * 1024 + hd * 128 + (d & 127)) * 512;
            transpose_item(X.in[15] + (size_t)l * 512 * 2048, 512, 2048, kb * 64, n0, dst, gfold ? X.in[13] + l * 512 : nullptr, scr, lane); continue; }
        r -= 2 * I_UKV;
        if (r < 3 * I_BR) { const int br = r / I_BR; r %= I_BR; const int kb = r / 64, nb = r % 64;
            transpose_item(X.in[21 + br] + (size_t)l * 1024 * 2048, 1024, 2048, kb * 64, nb * 32, WSP(bf16_t, O_WBR) + (((size_t)l * 3 + br) * 2048 + nb * 32) * 1024, nullptr, scr, lane); continue; }
        r -= 3 * I_BR;
        { const int kb = r / 64, nb = r % 64;
            transpose_item(X.in[24] + (size_t)l * 2048 * 2048, 2048, 2048, kb * 64, nb * 32, WSP(bf16_t, O_WOUT) + ((size_t)l * 2048 + nb * 32) * 2048, nullptr, scr, lane); }
    }
    const int gt = X.c * NTHREADS + tid, NGT = X.G * NTHREADS;
    for (int i = gt; i < NL * 512 * 512 / 4; i += NGT) { const int e = i * 4, l = e / (512 * 512), rr = (e / 512) % 512, cidx = e % 512, b = rr >> 8, t = rr & 255;
        const f32x4 v = *(const f32x4*)(X.in[2] + (((size_t)b * NL + l) * 256 + t) * 512 + cidx);
        u32x2 w; w.x = cvt_pk(v[0], v[1]); w.y = cvt_pk(v[2], v[3]); *(u32x2*)(WSP(bf16_t, O_CKVC) + e) = w; }
    for (int i = gt; i < NL * 512 * 64 / 4; i += NGT) { const int e = i * 4, l = e / (512 * 64), rr = (e / 64) % 512, cidx = e % 64, b = rr >> 8, t = rr & 255;
        const f32x4 v = *(const f32x4*)(X.in[3] + (((size_t)b * NL + l) * 256 + t) * 64 + cidx);
        u32x2 w; w.x = cvt_pk(v[0], v[1]); w.y = cvt_pk(v[2], v[3]); *(u32x2*)(WSP(bf16_t, O_KRC) + e) = w; }
    for (int i = gt; i < 64 * 16; i += NGT) { const int p = i >> 4, f = i & 15; const float inv = powf(10000.f, -(float)f / 16.f); const float ang = (float)p * inv;
        WSP(float, O_ROPE)[2 * i] = cosf(ang); WSP(float, O_ROPE)[2 * i + 1] = sinf(ang); }
    for (int i = gt; i < 4 * T; i += NGT) WSP(float, O_RSS)[i] = 0.f;
    LAS float* sl = (LAS float*)(lds + 69632);
    LAS float* red = (LAS float*)(lds + 69632 + 24576);
    __syncthreads();
    for (int i = tid; i < 3 * 2048; i += NTHREADS) { const int cidx = i >> 11, k = i & 2047; const float v = cidx == 0 ? X.in[6][k] : X.in[5][(cidx - 1) * 2048 + k]; sl[i] = silu_f(v); }
    __syncthreads();
    for (int un = X.c; un < NL * 192; un += X.G) {
        const int l = un / 192, col0 = (un % 192) * 32, kg = tid >> 3, c4 = tid & 7;
        const float* wp = X.in[7] + (size_t)l * 2048 * 6144 + col0 + 4 * c4;
        f32x4 a0 = {0.f, 0.f, 0.f, 0.f}, a1 = a0, a2 = a0;
#pragma unroll 8
        for (int k = kg; k < 2048; k += 64) { const f32x4 w = *(const f32x4*)(wp + (size_t)k * 6144); a0 += w * sl[k]; a1 += w * sl[2048 + k]; a2 += w * sl[4096 + k]; }
        LAS float* rp = red + (kg * 8 + c4) * 12;
#pragma unroll
        for (int j = 0; j < 4; ++j) { rp[j] = a0[j]; rp[4 + j] = a1[j]; rp[8 + j] = a2[j]; }
        __syncthreads();
        if (tid < 96) { const int cc = tid / 12, jj = tid % 12; float s = 0.f; for (int g = 0; g < 64; ++g) s += red[(g * 8 + cc) * 12 + jj];
            const int cidx = jj >> 2, col = col0 + 4 * cc + (jj & 3); WSP(float, O_MOD)[((size_t)l * 3 + cidx) * 6144 + col] = s + X.in[8][l * 6144 + col]; }
        __syncthreads();
    }
}

__device__ __forceinline__ void phase_rows(const Ctx& X, int l, bool upd, int ln) {
    const int tid = X.tid, lane = tid & 63, wave = tid >> 6;
    const float* mod = WSP(float, O_MOD);
    for (int row = X.c * 8 + wave; row < T; row += X.G * 8) {
        const int cidx = row < 4096 ? 0 : 1 + ((row - 4096) >> 11);
        const float* xsrc = (upd && l > 0) || (!upd && ln > 0) ? WSP(float, O_X) + (size_t)row * DM : (row < 4096 ? X.in[0] + (size_t)row * DM : X.in[1] + (size_t)(row - 4096) * DM);
        f32x4 v[8];
#pragma unroll
        for (int j = 0; j < 8; ++j) v[j] = *(const f32x4*)(xsrc + j * 256 + lane * 4);
        if (upd) {
            const float ri = rsqrtf(WSP(float, O_RSS)[3 * T + row] * (1.f / 2048.f) + EPSN);
            const float* yp = WSP(float, O_Y) + (size_t)row * DM; const float* gate = mod + ((size_t)l * 3 + cidx) * 6144 + 4096; const float* gp = X.in[10] + l * 2048;
            float* xdst = (l == NL - 1) ? X.out + (row < 4096 ? OUT_YP + (size_t)row * DM : OUT_YS + (size_t)(row - 4096) * DM) : WSP(float, O_X) + (size_t)row * DM;
#pragma unroll
            for (int j = 0; j < 8; ++j) { const int c = j * 256 + lane * 4; const f32x4 y = *(const f32x4*)(yp + c), g = *(const f32x4*)(gate + c), gg = *(const f32x4*)(gp + c);
                v[j] += g * (y * ri) * gg; *(f32x4*)(xdst + c) = v[j]; }
        }
        if (ln < NL) {
            float ss = 0.f;
#pragma unroll
            for (int j = 0; j < 8; ++j) ss += v[j][0] * v[j][0] + v[j][1] * v[j][1] + v[j][2] * v[j][2] + v[j][3] * v[j][3];
            ss = wave_sum(ss); const float ri = rsqrtf(ss * (1.f / 2048.f) + EPSN);
            const float* sh = mod + ((size_t)ln * 3 + cidx) * 6144; const float* sc = sh + 2048; const float* gp = X.in[9] + ln * 2048;
            bf16_t* hp = WSP(bf16_t, O_H) + (size_t)row * DM;
#pragma unroll
            for (int j = 0; j < 8; ++j) { const int c = j * 256 + lane * 4; const f32x4 s = *(const f32x4*)(sc + c), b = *(const f32x4*)(sh + c), g = *(const f32x4*)(gp + c);
                const f32x4 hv = v[j] * ri * g * (s + 1.f) + b; u32x2 w; w.x = cvt_pk(hv[0], hv[1]); w.y = cvt_pk(hv[2], hv[3]); *(u32x2*)(hp + c) = w; }
        }
    }
}

__device__ __forceinline__ void phase_misc(const Ctx& X, int l) {
    const int tid = X.tid, lane = tid & 63, wave = tid >> 6;
    const bf16_t* z = WSP(bf16_t, O_Z); const float* rope = WSP(float, O_ROPE);
    for (int row = X.c * 8 + wave; row < T; row += X.G * 8) {
        const bf16_t* zr = z + (size_t)row * ZW;
        float kr = bf2f(zr[Z_KR + lane]);
        if (row < 4096) {
            const int b = row >> 8, t = row & 255;
            const float ri = rsqrtf(WSP(float, O_RSS)[T + row] * (1.f / 512.f) + EPSN);
            const u32x4 w = *(const u32x4*)(zr + Z_CKV + lane * 8); const float* g = X.in[13] + l * 512 + lane * 8;
            float* o = X.out + OUT_CKV + (((size_t)b * NL + l) * 256 + t) * 512 + lane * 8;
            f32x4 o0, o1; o0[0] = bflo(w.x) * ri * g[0]; o0[1] = bfhi(w.x) * ri * g[1]; o0[2] = bflo(w.y) * ri * g[2]; o0[3] = bfhi(w.y) * ri * g[3];
            o1[0] = bflo(w.z) * ri * g[4]; o1[1] = bfhi(w.z) * ri * g[5]; o1[2] = bflo(w.w) * ri * g[6]; o1[3] = bfhi(w.w) * ri * g[7];
            *(f32x4*)o = o0; *(f32x4*)(o + 4) = o1;
            X.out[OUT_KR + (((size_t)b * NL + l) * 256 + t) * 64 + lane] = kr;
        } else {
            const int t = (row - 4096) & 2047; const int p = lane < 32 ? (t >> 6) : (t & 63); const int f = lane & 15;
            const float cs = rope[(p * 16 + f) * 2], sn = rope[(p * 16 + f) * 2 + 1];
            const float pr = __shfl_xor(kr, 16);
            kr = (lane & 16) ? kr * cs + pr * sn : kr * cs - pr * sn;
        }
        const float nb = __shfl_down(kr, 1);
        if ((lane & 1) == 0) *(unsigned*)(WSP(bf16_t, O_KR) + (size_t)row * 64 + lane) = cvt_pk(kr, nb);
    }
}
constexpr int PB = 272;
constexpr int BUFB = 128 * PB;
constexpr int PO = 132;
__device__ __forceinline__ void mma128(const LAS unsigned char* As, const LAS unsigned char* Bs, f32x16 (&acc)[2], int wr, int wc, int lane) {
    const int r32 = lane & 31, hi = lane >> 5;
    const LAS unsigned char* ap = As + (32 * wr + r32) * PB + hi * 16;
    const LAS unsigned char* bp = Bs + (64 * wc + r32) * PB + hi * 16;
#pragma unroll 2
    for (int s = 0; s < 8; ++s) {
        const bf16x8 a = *(const LAS bf16x8*)(ap + s * 32);
        const bf16x8 b0 = *(const LAS bf16x8*)(bp + s * 32);
        const bf16x8 b1 = *(const LAS bf16x8*)(bp + 32 * PB + s * 32);
        acc[0] = __builtin_amdgcn_mfma_f32_32x32x16_bf16(a, b0, acc[0], 0, 0, 0);
        acc[1] = __builtin_amdgcn_mfma_f32_32x32x16_bf16(a, b1, acc[1], 0, 0, 0);
    }
}
__device__ __forceinline__ int crow(int r, int hi) { return (r & 3) + 8 * (r >> 2) + 4 * hi; }
__device__ __forceinline__ void stage_tile(LAS unsigned char* dst, const bf16_t* src, size_t ld, int tid) {
#pragma unroll
    for (int i = 0; i < 4; ++i) { const int c = tid + i * NTHREADS, r = c >> 4, ch = c & 15;
        *(LAS u32x4*)(dst + r * PB + ch * 16) = *(const u32x4*)(src + (size_t)r * ld + ch * 8); }
}
__device__ __forceinline__ float log_sigmoid_f(float x) { return -log1pf(expf(-x)); }

__device__ __forceinline__ void sgu_item(const Ctx& X, LAS unsigned char* lds, int l, int item) {
    int tid_ = X.tid; asm volatile("" : "+v"(tid_));
    const int tid = tid_, lane = tid & 63, wave = tid >> 6, wr = wave >> 1, wc = wave & 1;
    const int n = item >> 3, g = item & 7, tok0 = n * 128;
    LAS unsigned char* As = lds; LAS unsigned char* Bs = lds + BUFB; LAS float* Os = (LAS float*)(lds + 2 * BUFB);
    const float* ws = X.in[17] + ((size_t)l * 8 + g) * 16384; const float* rss = WSP(float, O_RSS) + 2 * T + tok0;
#pragma unroll
    for (int i = 0; i < 4; ++i) { const int c = tid + i * NTHREADS, r = c >> 4, ch = c & 15;
        const f32x4 w0 = *(const f32x4*)(ws + r * 128 + ch * 8), w1 = *(const f32x4*)(ws + r * 128 + ch * 8 + 4);
        const f32x4 s0 = *(const f32x4*)(rss + ch * 8), s1 = *(const f32x4*)(rss + ch * 8 + 4);
        u32x4 o; o.x = cvt_pk(w0[0] * rsqrtf(s0[0] * (1.f / 1024.f) + EPSN), w0[1] * rsqrtf(s0[1] * (1.f / 1024.f) + EPSN));
        o.y = cvt_pk(w0[2] * rsqrtf(s0[2] * (1.f / 1024.f) + EPSN), w0[3] * rsqrtf(s0[3] * (1.f / 1024.f) + EPSN));
        o.z = cvt_pk(w1[0] * rsqrtf(s1[0] * (1.f / 1024.f) + EPSN), w1[1] * rsqrtf(s1[1] * (1.f / 1024.f) + EPSN));
        o.w = cvt_pk(w1[2] * rsqrtf(s1[2] * (1.f / 1024.f) + EPSN), w1[3] * rsqrtf(s1[3] * (1.f / 1024.f) + EPSN));
        *(LAS u32x4*)(As + r * PB + ch * 16) = o; }
    stage_tile(Bs, WSP(bf16_t, O_VST) + (size_t)(g * 128) * T + tok0, T, tid);
    __syncthreads();
    f32x16 acc[2]; acc[0] = (f32x16)(0.f); acc[1] = (f32x16)(0.f);
    mma128(As, Bs, acc, wr, wc, lane);
    { const int hi = lane >> 5, cb = 64 * wc + (lane & 31);
#pragma unroll
      for (int t = 0; t < 2; ++t)
#pragma unroll
        for (int r = 0; r < 16; ++r) Os[(32 * wr + crow(r, hi)) * PO + cb + 32 * t] = acc[t][r]; }
    __syncthreads();
    { const int p = tid >> 2, cseg = (tid & 3) * 32; const bf16_t* zr = WSP(bf16_t, O_Z) + (size_t)(tok0 + p) * ZW;
      const float bs = X.in[18][((size_t)l * 128 + p) * 8 + g]; const float* gs = X.in[16] + l * 1024 + g * 128 + cseg;
      bf16_t* op = WSP(bf16_t, O_AS) + (size_t)(tok0 + p) * 1024 + g * 128 + cseg;
#pragma unroll
      for (int i = 0; i < 4; ++i) {
          const u32x4 uu = *(const u32x4*)(zr + Z_U + g * 128 + cseg + i * 8), gg = *(const u32x4*)(zr + Z_GPS + g * 128 + cseg + i * 8);
          const f32x4 s0 = *(const LAS f32x4*)(Os + p * PO + cseg + i * 8), s1 = *(const LAS f32x4*)(Os + p * PO + cseg + i * 8 + 4);
          const f32x4 g0 = *(const f32x4*)(gs + i * 8), g1 = *(const f32x4*)(gs + i * 8 + 4);
          u32x4 o; o.x = cvt_pk((s0[0] * g0[0] + bs) * bflo(uu.x) * bflo(gg.x), (s0[1] * g0[1] + bs) * bfhi(uu.x) * bfhi(gg.x));
          o.y = cvt_pk((s0[2] * g0[2] + bs) * bflo(uu.y) * bflo(gg.y), (s0[3] * g0[3] + bs) * bfhi(uu.y) * bfhi(gg.y));
          o.z = cvt_pk((s1[0] * g1[0] + bs) * bflo(uu.z) * bflo(gg.z), (s1[1] * g1[1] + bs) * bfhi(uu.z) * bfhi(gg.z));
          o.w = cvt_pk((s1[2] * g1[2] + bs) * bflo(uu.w) * bflo(gg.w), (s1[3] * g1[3] + bs) * bfhi(uu.w) * bfhi(gg.w));
          *(u32x4*)(op + i * 8) = o; } }
    __syncthreads();
}

__device__ __forceinline__ void retstate_item(const Ctx& X, LAS unsigned char* lds, int l, int item) {
    int tid_ = X.tid; asm volatile("" : "+v"(tid_));
    const int tid = tid_, lane = tid & 63, wave = tid >> 6, wr = wave >> 1, wc = wave & 1;
    const int n = item >> 3, hd = item & 7, tok0 = n * 128;
    LAS unsigned char* As = lds; LAS unsigned char* Bf = lds + BUFB; LAS unsigned char* Bb = lds + 2 * BUFB;
    const float lgf = log_sigmoid_f(X.in[19][(l * 2 + 0) * 8 + hd]) * 1.4426950408889634f, lgb = log_sigmoid_f(X.in[19][(l * 2 + 1) * 8 + hd]) * 1.4426950408889634f;
    stage_tile(As, WSP(bf16_t, O_RVT) + (size_t)(hd * 128) * T + tok0, T, tid);
    { const bf16_t* kz = WSP(bf16_t, O_Z) + (size_t)tok0 * ZW + Z_RK + hd * 128;
#pragma unroll
      for (int i = 0; i < 4; ++i) { const int combo = wave * 4 + i, j = (combo & 1) * 64 + lane, d0 = (combo >> 1) * 8;
          const u32x4 w = *(const u32x4*)(kz + (size_t)j * ZW + d0);
          const float wf = exp2f(lgf * (float)(127 - j)), wb = exp2f(lgb * (float)j);
          const float kv[8] = {bflo(w.x), bfhi(w.x), bflo(w.y), bfhi(w.y), bflo(w.z), bfhi(w.z), bflo(w.w), bfhi(w.w)};
#pragma unroll
          for (int e = 0; e < 8; ++e) { *(LAS bf16_t*)(Bf + (d0 + e) * PB + j * 2) = (bf16_t)(cvt_pk(kv[e] * wf, 0.f) & 0xffffu); *(LAS bf16_t*)(Bb + (d0 + e) * PB + j * 2) = (bf16_t)(cvt_pk(kv[e] * wb, 0.f) & 0xffffu); } } }
    __syncthreads();
    f32x16 af[2], ab[2]; af[0] = (f32x16)(0.f); af[1] = (f32x16)(0.f); ab[0] = (f32x16)(0.f); ab[1] = (f32x16)(0.f);
    mma128(As, Bf, af, wr, wc, lane); mma128(As, Bb, ab, wr, wc, lane);
    float* st = WSP(float, O_ST) + ((size_t)(n * 8 + hd) * 2) * 16384;
    { const int hi = lane >> 5, cb = 64 * wc + (lane & 31);
#pragma unroll
      for (int t = 0; t < 2; ++t)
#pragma unroll
        for (int r = 0; r < 16; ++r) { const int e = 32 * wr + crow(r, hi); st[e * 128 + cb + 32 * t] = af[t][r]; st[16384 + e * 128 + cb + 32 * t] = ab[t][r]; } }
    __syncthreads();
}

__device__ __forceinline__ void retout_item(const Ctx& X, LAS unsigned char* lds, int l, int item) {
    int tid_ = X.tid; asm volatile("" : "+v"(tid_));
    const int tid = tid_, lane = tid & 63, wave = tid >> 6, wr = wave >> 1, wc = wave & 1;
    const int n = item >> 3, hd = item & 7, tok0 = n * 128;
    const bool smp = n >= 32; const int nc = smp ? 16 : 2, jc = smp ? ((n - 32) & 15) : (n & 1), n0 = n - jc, bs = smp ? (n - 32) >> 4 : n >> 1;
    LAS unsigned char* B0 = lds; LAS unsigned char* B1 = lds + BUFB; LAS unsigned char* B2 = lds + 2 * BUFB; LAS unsigned char* B3 = lds + 3 * BUFB;
    const float lnf = log_sigmoid_f(X.in[19][(l * 2 + 0) * 8 + hd]), lnb = log_sigmoid_f(X.in[19][(l * 2 + 1) * 8 + hd]);
    const float lgf = lnf * 1.4426950408889634f, lgb = lnb * 1.4426950408889634f, gcf = exp2f(128.f * lgf), gcb = exp2f(128.f * lgb);
    const bf16_t* z = WSP(bf16_t, O_Z);
    stage_tile(B0, z + (size_t)tok0 * ZW + Z_RQ + hd * 128, ZW, tid);
    stage_tile(B1, z + (size_t)tok0 * ZW + Z_RK + hd * 128, ZW, tid);
    stage_tile(B3, WSP(bf16_t, O_RVT) + (size_t)(hd * 128) * T + tok0, T, tid);
    __syncthreads();
    const int hi = lane >> 5, cb = 64 * wc + (lane & 31);
    { f32x16 aw[2]; aw[0] = (f32x16)(0.f); aw[1] = (f32x16)(0.f);
      mma128(B0, B1, aw, wr, wc, lane);
#pragma unroll
      for (int t = 0; t < 2; ++t)
#pragma unroll
        for (int r = 0; r < 16; ++r) { const int i = 32 * wr + crow(r, hi), j = cb + 32 * t; const float dd = (float)(i - j);
            const float dec = (i >= j) ? exp2f(lgf * dd) : exp2f(-lgb * dd);
            *(LAS bf16_t*)(B2 + i * PB + j * 2) = (bf16_t)(cvt_pk(aw[t][r] * dec, 0.f) & 0xffffu); } }
    __syncthreads();
    const int e_ = tid >> 2, dseg = (tid & 3) * 32;
    const float* stb = WSP(float, O_ST);
    f32x4 R[8];
    if (smp) { const float* s0 = X.in[4] + ((((size_t)bs * NL + l) * 2 + 0) * 8 + hd) * 16384;
#pragma unroll
        for (int q = 0; q < 8; ++q)
#pragma unroll
            for (int k = 0; k < 4; ++k) R[q][k] = s0[(size_t)(dseg + q * 4 + k) * 128 + e_]; }
    else {
#pragma unroll
        for (int q = 0; q < 8; ++q) R[q] = (f32x4){0.f, 0.f, 0.f, 0.f}; }
#pragma unroll 1
    for (int jj = 0; jj < jc; ++jj) { const float* sp = stb + ((size_t)((n0 + jj) * 8 + hd) * 2 + 0) * 16384 + e_ * 128 + dseg;
#pragma unroll
        for (int q = 0; q < 8; ++q) R[q] = R[q] * gcf + *(const f32x4*)(sp + q * 4); }
#pragma unroll
    for (int q = 0; q < 4; ++q) { u32x4 o; o.x = cvt_pk(R[2 * q][0], R[2 * q][1]); o.y = cvt_pk(R[2 * q][2], R[2 * q][3]); o.z = cvt_pk(R[2 * q + 1][0], R[2 * q + 1][1]); o.w = cvt_pk(R[2 * q + 1][2], R[2 * q + 1][3]);
        *(LAS u32x4*)(B1 + e_ * PB + (dseg + q * 8) * 2) = o; }
    if (!smp && jc == 1) {
        const float* sp = stb + ((size_t)(n * 8 + hd) * 2 + 0) * 16384 + e_ * 128 + dseg; float* o = X.out + OUT_RET + ((((size_t)bs * NL + l) * 2 + 0) * 8 + hd) * 16384;
#pragma unroll
        for (int q = 0; q < 8; ++q) { const f32x4 f = R[q] * gcf + *(const f32x4*)(sp + q * 4);
#pragma unroll
            for (int k = 0; k < 4; ++k) o[(size_t)(dseg + q * 4 + k) * 128 + e_] = f[k]; } }
    f32x16 ao[2]; ao[0] = (f32x16)(0.f); ao[1] = (f32x16)(0.f);
    mma128(B2, B3, ao, wr, wc, lane);
    __syncthreads();
    f32x16 ac[2]; ac[0] = (f32x16)(0.f); ac[1] = (f32x16)(0.f);
    mma128(B0, B1, ac, wr, wc, lane);
#pragma unroll
    for (int t = 0; t < 2; ++t)
#pragma unroll
        for (int r = 0; r < 16; ++r) { const int i = 32 * wr + crow(r, hi); ao[t][r] += ac[t][r] * exp2f(lgf * (float)(i + 1)); }
    if (smp) { const float* s0 = X.in[4] + ((((size_t)bs * NL + l) * 2 + 1) * 8 + hd) * 16384;
#pragma unroll
        for (int q = 0; q < 8; ++q)
#pragma unroll
            for (int k = 0; k < 4; ++k) R[q][k] = s0[(size_t)(dseg + q * 4 + k) * 128 + e_]; }
    else {
#pragma unroll
        for (int q = 0; q < 8; ++q) R[q] = (f32x4){0.f, 0.f, 0.f, 0.f}; }
#pragma unroll 1
    for (int jj = nc - 1; jj > jc; --jj) { const float* sp = stb + ((size_t)((n0 + jj) * 8 + hd) * 2 + 1) * 16384 + e_ * 128 + dseg;
#pragma unroll
        for (int q = 0; q < 8; ++q) R[q] = R[q] * gcb + *(const f32x4*)(sp + q * 4); }
#pragma unroll
    for (int q = 0; q < 4; ++q) { u32x4 o; o.x = cvt_pk(R[2 * q][0], R[2 * q][1]); o.y = cvt_pk(R[2 * q][2], R[2 * q][3]); o.z = cvt_pk(R[2 * q + 1][0], R[2 * q + 1][1]); o.w = cvt_pk(R[2 * q + 1][2], R[2 * q + 1][3]);
        *(LAS u32x4*)(B3 + e_ * PB + (dseg + q * 8) * 2) = o; }
    if (!smp && jc == 0) {
        const float* sp = stb + ((size_t)(n * 8 + hd) * 2 + 1) * 16384 + e_ * 128 + dseg; float* o = X.out + OUT_RET + ((((size_t)bs * NL + l) * 2 + 1) * 8 + hd) * 16384;
#pragma unroll
        for (int q = 0; q < 8; ++q) { const f32x4 f = R[q] * gcb + *(const f32x4*)(sp + q * 4);
#pragma unroll
            for (int k = 0; k < 4; ++k) o[(size_t)(dseg + q * 4 + k) * 128 + e_] = f[k]; } }
    __syncthreads();
    ac[0] = (f32x16)(0.f); ac[1] = (f32x16)(0.f);
    mma128(B0, B3, ac, wr, wc, lane);
    LAS float* Os = (LAS float*)(lds + BUFB);
#pragma unroll
    for (int t = 0; t < 2; ++t)
#pragma unroll
        for (int r = 0; r < 16; ++r) { const int i = 32 * wr + crow(r, hi); Os[i * PO + cb + 32 * t] = ao[t][r] + ac[t][r] * exp2f(lgb * (float)(128 - i)); }
    __syncthreads();
    { const int p = tid >> 2, cseg = (tid & 3) * 32; f32x4 v[8]; float s = 0.f;
#pragma unroll
      for (int q = 0; q < 8; ++q) { v[q] = *(const LAS f32x4*)(Os + p * PO + cseg + q * 4); s += v[q][0] + v[q][1] + v[q][2] + v[q][3]; }
      s += __shfl_xor(s, 1); s += __shfl_xor(s, 2); const float mu = s * (1.f / 128.f); float s2 = 0.f;
#pragma unroll
      for (int q = 0; q < 8; ++q) { v[q] = v[q] - mu; s2 += v[q][0] * v[q][0] + v[q][1] * v[q][1] + v[q][2] * v[q][2] + v[q][3] * v[q][3]; }
      s2 += __shfl_xor(s2, 1); s2 += __shfl_xor(s2, 2); const float rs = rsqrtf(s2 * (1.f / 128.f) + EPSN);
      const bf16_t* gp = z + (size_t)(tok0 + p) * ZW + Z_GPR + hd * 128 + cseg; const float* gr = X.in[20] + l * 1024 + hd * 128 + cseg;
      bf16_t* op = WSP(bf16_t, O_AR) + (size_t)(tok0 + p) * 1024 + hd * 128 + cseg;
#pragma unroll
      for (int q = 0; q < 4; ++q) { const u32x4 gg = *(const u32x4*)(gp + q * 8); const f32x4 g0 = *(const f32x4*)(gr + q * 8), g1 = *(const f32x4*)(gr + q * 8 + 4); const f32x4 a = v[2 * q] * rs * g0, b = v[2 * q + 1] * rs * g1;
          u32x4 o; o.x = cvt_pk(a[0] * bflo(gg.x), a[1] * bfhi(gg.x)); o.y = cvt_pk(a[2] * bflo(gg.y), a[3] * bfhi(gg.y)); o.z = cvt_pk(b[0] * bflo(gg.z), b[1] * bfhi(gg.z)); o.w = cvt_pk(b[2] * bflo(gg.w), b[3] * bfhi(gg.w));
          *(u32x4*)(op + q * 8) = o; } }
    __syncthreads();
}
constexpr int KPB = 400;
constexpr int VPB = 144;
constexpr int ATT_KB = 64 * KPB;
constexpr int ATT_BUF = ATT_KB + 128 * VPB;
__device__ __forceinline__ void attn_unit(const Ctx& X, LAS unsigned char* lds, int l, int unit) {
    int tid_ = X.tid; asm volatile("" : "+v"(tid_));
    const int tid = tid_, lane = tid & 63, wave = tid >> 6, qi = lane & 15, g = lane >> 4;
    int tokb, ncache, nnew, hd, qb, bc = 0;
    if (unit < 256) { bc = unit >> 7; hd = (unit >> 4) & 7; qb = unit & 15; tokb = 4096 + bc * 2048; ncache = 256; nnew = 2048; }
    else { const int r = unit - 256; const int s = r >> 4; hd = (r >> 1) & 7; qb = r & 1; tokb = s * 256; ncache = 0; nnew = 256; }
    const int nct = ncache >> 6, ntile = (ncache + nnew) >> 6;
    const bf16_t* KN = WSP(bf16_t, O_KN); const bf16_t* KR = WSP(bf16_t, O_KR); const bf16_t* VT = WSP(bf16_t, O_VT);
    const bf16_t* KC = WSP(bf16_t, O_KC) + (size_t)l * 512 * 1024; const bf16_t* KRC = WSP(bf16_t, O_KRC) + (size_t)l * 512 * 64; const bf16_t* VTC = WSP(bf16_t, O_VTC) + (size_t)l * 1024 * 512;
    const int tokq = tokb + qb * 128 + wave * 16 + qi;
    bf16x8 qf[6];
    { const bf16_t* qp = WSP(bf16_t, O_Q) + (size_t)tokq * 1536 + hd * 192 + g * 8;
#pragma unroll
      for (int s = 0; s < 6; ++s) qf[s] = *(const bf16x8*)(qp + s * 32); }
    u32x4 sk[2], sr, sv[2];
#define ATT_LOAD(j) do { const int _j = (j); const bf16_t *kn_, *kr_, *vt_; size_t ldv_; \
        if (_j < nct) { const int r0 = bc * 256 + _j * 64; kn_ = KC + (size_t)r0 * 1024 + hd * 128; kr_ = KRC + (size_t)r0 * 64; vt_ = VTC + (size_t)(hd * 128) * 512 + r0; ldv_ = 512; } \
        else { const int r0 = tokb + (_j - nct) * 64; kn_ = KN + (size_t)r0 * 1024 + hd * 128; kr_ = KR + (size_t)r0 * 64; vt_ = VT + (size_t)(hd * 128) * T + r0; ldv_ = T; } \
        _Pragma("unroll") for (int i = 0; i < 2; ++i) { const int c = tid + i * NTHREADS; sk[i] = *(const u32x4*)(kn_ + (size_t)(c >> 4) * 1024 + (c & 15) * 8); sv[i] = *(const u32x4*)(vt_ + (size_t)(c >> 3) * ldv_ + (c & 7) * 8); } \
        sr = *(const u32x4*)(kr_ + (size_t)(tid >> 3) * 64 + (tid & 7) * 8); } while (0)
#define ATT_STORE(buf) do { LAS unsigned char* kb_ = lds + (buf) * ATT_BUF; LAS unsigned char* vb_ = kb_ + ATT_KB; \
        _Pragma("unroll") for (int i = 0; i < 2; ++i) { const int c = tid + i * NTHREADS; *(LAS u32x4*)(kb_ + (c >> 4) * KPB + (c & 15) * 16) = sk[i]; *(LAS u32x4*)(vb_ + (c >> 3) * VPB + (c & 7) * 16) = sv[i]; } \
        *(LAS u32x4*)(kb_ + (tid >> 3) * KPB + 256 + (tid & 7) * 16) = sr; } while (0)
    f32x4 O[8];
#pragma unroll
    for (int u = 0; u < 8; ++u) O[u] = (f32x4){0.f, 0.f, 0.f, 0.f};
    float mrun = -INFINITY, lrun = 0.f;
    ATT_LOAD(0); ATT_STORE(0);
    __syncthreads();
    for (int j = 0; j < ntile; ++j) {
        const int buf = j & 1;
        if (j + 1 < ntile) ATT_LOAD(j + 1);
        const LAS unsigned char* kb = lds + buf * ATT_BUF; const LAS unsigned char* vb = kb + ATT_KB;
        f32x4 S[4];
#pragma unroll
        for (int t = 0; t < 4; ++t) { S[t] = (f32x4){0.f, 0.f, 0.f, 0.f};
#pragma unroll
            for (int s = 0; s < 6; ++s) { const bf16x8 a = *(const LAS bf16x8*)(kb + (16 * t + qi) * KPB + (32 * s + 8 * g) * 2);
                S[t] = __builtin_amdgcn_mfma_f32_16x16x32_bf16(a, qf[s], S[t], 0, 0, 0); } }
        float mx = S[0][0];
#pragma unroll
        for (int t = 0; t < 4; ++t)
#pragma unroll
            for (int i = 0; i < 4; ++i) mx = fmaxf(mx, S[t][i]);
        mx = fmaxf(mx, __shfl_xor(mx, 16)); mx = fmaxf(mx, __shfl_xor(mx, 32));
        const float mnew = fmaxf(mrun, mx), alpha = exp2f(mrun - mnew); mrun = mnew;
        float ps = 0.f;
#pragma unroll
        for (int t = 0; t < 4; ++t)
#pragma unroll
            for (int i = 0; i < 4; ++i) { S[t][i] = exp2f(S[t][i] - mnew); ps += S[t][i]; }
        ps += __shfl_xor(ps, 16); ps += __shfl_xor(ps, 32);
        lrun = lrun * alpha + ps;
#pragma unroll
        for (int u = 0; u < 8; ++u) O[u] = O[u] * alpha;
#pragma unroll
        for (int c = 0; c < 2; ++c) {
            u32x4 pw; pw.x = cvt_pk(S[2 * c][0], S[2 * c][1]); pw.y = cvt_pk(S[2 * c][2], S[2 * c][3]); pw.z = cvt_pk(S[2 * c + 1][0], S[2 * c + 1][1]); pw.w = cvt_pk(S[2 * c + 1][2], S[2 * c + 1][3]);
            const bf16x8 pb = __builtin_bit_cast(bf16x8, pw);
#pragma unroll
            for (int u = 0; u < 8; ++u) { const LAS unsigned char* vp = vb + (16 * u + qi) * VPB + (32 * c + 4 * g) * 2;
                const u32x2 lo = *(const LAS u32x2*)vp, hi2 = *(const LAS u32x2*)(vp + 32);
                u32x4 aw; aw.x = lo.x; aw.y = lo.y; aw.z = hi2.x; aw.w = hi2.y;
                O[u] = __builtin_amdgcn_mfma_f32_16x16x32_bf16(__builtin_bit_cast(bf16x8, aw), pb, O[u], 0, 0, 0); } }
        if (j + 1 < ntile) ATT_STORE(buf ^ 1);
        __syncthreads();
    }
    { const float il = 1.f / lrun; const bf16_t* gp = WSP(bf16_t, O_Z) + (size_t)tokq * ZW + Z_GPM + hd * 128 + 4 * g; bf16_t* op = WSP(bf16_t, O_AM) + (size_t)tokq * 1024 + hd * 128 + 4 * g;
#pragma unroll
      for (int u = 0; u < 8; ++u) { const u32x2 gg = *(const u32x2*)(gp + 16 * u); u32x2 o;
          o.x = cvt_pk(O[u][0] * il * bflo(gg.x), O[u][1] * il * bfhi(gg.x)); o.y = cvt_pk(O[u][2] * il * bflo(gg.y), O[u][3] * il * bfhi(gg.y));
          *(u32x2*)(op + 16 * u) = o; } }
#undef ATT_LOAD
#undef ATT_STORE
}
constexpr int NPHASE = 2 + 6 * NL;
#define REOPAQUE(X) do { unsigned long long w_ = (unsigned long long)args.ws, o_ = (unsigned long long)args.out, i_ = (unsigned long long)__builtin_amdgcn_kernarg_segment_ptr(); int t_ = threadIdx.x, c_ = blockIdx.x, g_ = gridDim.x; \
    asm volatile("" : "+s"(w_), "+s"(o_), "+s"(i_), "+v"(t_), "+s"(c_), "+s"(g_)); X.ws = (unsigned char*)w_; X.out = (float*)o_; X.in.p = (CPtr64)i_; X.tid = t_; X.c = c_; X.G = g_; } while (0)
#ifndef PHM
#define PHM 0xffff
#endif
__global__ void __launch_bounds__(NTHREADS, 2) mk_fwd(Args args) {
    extern __shared__ __attribute__((aligned(16))) unsigned char lds_raw[];
    LAS unsigned char* lds = (LAS unsigned char*)lds_raw;
    cg::grid_group grid = cg::this_grid();
    for (int ph = args.ph_lo; ph < args.ph_hi; ++ph) {
        Ctx X; REOPAQUE(X);
        const int tid = X.tid;
        const char* ws = (const char*)X.ws;
        if (ph == 0) { if (PHM & 1) phase_prologue(X, lds); }
        else if (ph == 1) {
            SchedC S{ws + O_CKVC, ws + O_WKP, ws + O_WVP, X.G, X.c}; EpiC E{WSP(bf16_t, O_KC), WSP(bf16_t, O_VTC)};
            if (PHM & 2) pg8::gemm_phase(lds, tid, 512, 512, 512, S, E);
            REOPAQUE(X); if (PHM & 4) phase_rows(X, 0, false, 0);
        } else {
            const int l = (ph - 2) / 6, sp = (ph - 2) % 6;
            if (sp == 0) {
                SchedZ S{ws + O_H, ws + O_WIN + (size_t)l * ZW * 2048 * 2, X.G, X.c}; EpiZ E{WSP(bf16_t, O_Z), WSP(bf16_t, O_VST), WSP(bf16_t, O_RVT), WSP(float, O_RSS)};
                if (PHM & 8) pg8::gemm_phase(lds, tid, 2048, 2048, 2048, S, E);
            } else if (sp == 1) {
                { SchedQK S{ws + O_Z, ws + O_WUQ + (size_t)l * 1536 * 512 * 2, ws + O_WKG + (size_t)l * 1024 * 512 * 2, X.G, X.c}; EpiQK E{WSP(bf16_t, O_Q), WSP(bf16_t, O_KN), WSP(float, O_RSS), WSP(float, O_ROPE)};
                  if (PHM & 16) pg8::gemm_phase(lds, tid, 512, ZW, 512, S, E); }
                { SchedVT S{ws + O_Z, ws + O_WVG + (size_t)l * 1024 * 512 * 2, X.G, X.c}; EpiVT E{WSP(bf16_t, O_VT), WSP(float, O_RSS)};
                  if (PHM & 32) pg8::gemm_phase(lds, tid, 512, 512, ZW, S, E); }
                REOPAQUE(X); if (PHM & 64) phase_misc(X, l);
                REOPAQUE(X);
                for (int it = X.G - 1 - X.c; it < 512; it += X.G) if (PHM & 128) sgu_item(X, lds, l, it);
                REOPAQUE(X);
                for (int it = X.G - 1 - X.c; it < 512; it += X.G) if (PHM & 256) retstate_item(X, lds, l, it);
            } else if (sp == 2) {
                for (int i = X.c * NTHREADS + tid; i < T; i += X.G * NTHREADS) WSP(float, O_RSS)[3 * T + i] = 0.f;
                for (int it = X.c; it < 512; it += X.G) if (PHM & 512) attn_unit(X, lds, l, it);
                REOPAQUE(X);
                for (int it = X.c; it < 512; it += X.G) if (PHM & 1024) retout_item(X, lds, l, (it < 256) ? 256 + it : it - 256);
            } else if (sp == 3) {
                SchedBr S{ws + O_AM, ws + O_AS, ws + O_AR, ws + O_WBR + (size_t)l * 3 * 2048 * 1024 * 2, X.G, X.c}; EpiBr E{WSP(bf16_t, O_Z), WSP(float, O_YMF), WSP(bf16_t, O_YMB)};
                if (PHM & 2048) pg8::gemm_phase(lds, tid, 1024, 1024, 1024, S, E);
            } else if (sp == 4) {
                for (int i = X.c * NTHREADS + tid; i < 3 * T; i += X.G * NTHREADS) WSP(float, O_RSS)[i] = 0.f;
                SchedOut S{ws + O_YMB, ws + O_WOUT + (size_t)l * 2048 * 2048 * 2, X.G, X.c}; EpiOut E{WSP(float, O_Y), WSP(float, O_RSS)};
                if (PHM & 4096) pg8::gemm_phase(lds, tid, 2048, 2048, 2048, S, E);
            } else {
                if (PHM & 8192) phase_rows(X, l, true, l + 1);
            }
        }
        if (ph + 1 < args.ph_hi) { __syncthreads(); grid.sync(); }
    }
}

extern "C" void kernel_launch(void* const* d_in, const int* in_sizes, int n_in, void* d_out, int out_size, void* d_ws, size_t ws_size, hipStream_t stream) {
    static int grid = 0;
    if (grid == 0) {
        if (n_in != 25 || ws_size < WS_END) { fprintf(stderr, "kernel_launch: unexpected n_in %d / ws %zu (need %zu)\n", n_in, ws_size, (size_t)WS_END); grid = -1; return; }
        int dev = 0, cus = 0, per_cu = 0;
        (void)hipGetDevice(&dev); (void)hipDeviceGetAttribute(&cus, hipDeviceAttributeMultiprocessorCount, dev);
        (void)hipFuncSetAttribute((const void*)mk_fwd, hipFuncAttributeMaxDynamicSharedMemorySize, LDS_BYTES);
        (void)hipOccupancyMaxActiveBlocksPerMultiprocessor(&per_cu, (const void*)mk_fwd, NTHREADS, LDS_BYTES);
        if (per_cu < 1) { fprintf(stderr, "kernel_launch: occupancy query says %d blocks per CU\n", per_cu); per_cu = 1; }
        grid = cus * per_cu;
    }
    if (grid < 0) return;
    Args a{};
    for (int i = 0; i < 25; ++i) a.in[i] = (const float*)d_in[i];
    a.out = (float*)d_out; a.ws = (unsigned char*)d_ws;
#if MK_MULTI
    for (int ph = 0; ph < NPHASE; ++ph) { a.ph_lo = ph; a.ph_hi = ph + 1; hipLaunchKernelGGL(mk_fwd, dim3(grid), dim3(NTHREADS), LDS_BYTES, stream, a); }
#else
    a.ph_lo = 0; a.ph_hi = NPHASE;
    void* kargs[] = {&a};
    hipError_t e = hipLaunchCooperativeKernel((const void*)mk_fwd, dim3(grid), dim3(NTHREADS), kargs, LDS_BYTES, stream);
    if (e != hipSuccess) fprintf(stderr, "cooperative launch failed: %s (grid %d)\n", hipGetErrorString(e), grid);
#endif
}
```

```cpp
#define MK_MULTI 0
#define RPTM 0
#include <hip/hip_runtime.h>
#include <hip/hip_cooperative_groups.h>
#include <cstdio>
namespace cg = cooperative_groups;

#define LAS __attribute__((address_space(3)))
typedef unsigned short bf16_t;
typedef short bf16x8 __attribute__((ext_vector_type(8)));
typedef float f32x4 __attribute__((ext_vector_type(4)));
typedef float f32x16 __attribute__((ext_vector_type(16)));
typedef unsigned u32x4 __attribute__((ext_vector_type(4)));
typedef unsigned u32x2 __attribute__((ext_vector_type(2)));

constexpr int NTHREADS = 512;
constexpr int LDS_BYTES = 147456;
constexpr int T = 8192, DM = 2048, ZW = 15616, NL = 4, INC = 15424;
constexpr float EPSN = 1e-6f;
constexpr int Z_CQ = 0, Z_CKV = 512, Z_GPM = 1024, Z_U = 2048, Z_VS = 3072, Z_GPS = 4096, Z_RQ = 5120, Z_RK = 6144, Z_RV = 7168, Z_GPR = 8192, Z_MRG = 9216, Z_KR = 15360;
constexpr size_t OUT_YP = 0, OUT_YS = 8388608, OUT_CKV = 16777216, OUT_KR = 25165824, OUT_RET = 26214400;

constexpr size_t O_WIN = 0,                         S_WIN = (size_t)NL * ZW * 2048 * 2;
constexpr size_t O_WUQ = O_WIN + S_WIN,             S_WUQ = (size_t)NL * 1536 * 512 * 2;
constexpr size_t O_WKG = O_WUQ + S_WUQ,             S_WK = (size_t)NL * 1024 * 512 * 2;
constexpr size_t O_WVG = O_WKG + S_WK;
constexpr size_t O_WKP = O_WVG + S_WK;
constexpr size_t O_WVP = O_WKP + S_WK;
constexpr size_t O_WBR = O_WVP + S_WK,              S_WBR = (size_t)NL * 3 * 2048 * 1024 * 2;
constexpr size_t O_WOUT = O_WBR + S_WBR,            S_WOUT = (size_t)NL * 2048 * 2048 * 2;
constexpr size_t O_CKVC = O_WOUT + S_WOUT,          S_CKVC = (size_t)NL * 512 * 512 * 2;
constexpr size_t O_KRC = O_CKVC + S_CKVC,           S_KRC = (size_t)NL * 512 * 64 * 2;
constexpr size_t O_KC = O_KRC + S_KRC,              S_KC = (size_t)NL * 512 * 1024 * 2;
constexpr size_t O_VTC = O_KC + S_KC;
constexpr size_t O_MOD = O_VTC + S_KC,              S_MOD = (size_t)NL * 3 * 6144 * 4;
constexpr size_t O_ROPE = O_MOD + S_MOD,            S_ROPE = 64 * 16 * 8;
constexpr size_t O_RSS = O_ROPE + S_ROPE,           S_RSS = (size_t)4 * T * 4;
constexpr size_t O_H = O_RSS + S_RSS,               S_H = (size_t)T * DM * 2;
constexpr size_t O_X = O_H + S_H,                   S_X = (size_t)T * DM * 4;
constexpr size_t O_Z = O_X + S_X,                   S_Z = (size_t)T * ZW * 2;
constexpr size_t O_VST = O_Z + S_Z,                 S_T16 = (size_t)1024 * T * 2;
constexpr size_t O_RVT = O_VST + S_T16;
constexpr size_t O_VT = O_RVT + S_T16;
constexpr size_t O_KN = O_VT + S_T16;
constexpr size_t O_AM = O_KN + S_T16;
constexpr size_t O_AS = O_AM + S_T16;
constexpr size_t O_AR = O_AS + S_T16;
constexpr size_t O_Q = O_AR + S_T16,                S_Q = (size_t)T * 1536 * 2;
constexpr size_t O_KR = O_Q + S_Q,                  S_KR = (size_t)T * 64 * 2;
constexpr size_t O_ST = O_KR + S_KR,                S_ST = (size_t)64 * 8 * 2 * 16384 * 4;
constexpr size_t O_YMF = O_ST + S_ST;
constexpr size_t O_YMB = O_YMF + S_X;
constexpr size_t O_Y = O_YMB + S_H;
constexpr size_t O_BAR = O_Y + S_X;
constexpr size_t WS_END = O_BAR + 16384;

struct Args { const float* in[25]; float* out; unsigned char* ws; int ph_lo, ph_hi; };

__device__ __forceinline__ unsigned cvt_pk(float lo, float hi) { unsigned r; asm volatile("v_cvt_pk_bf16_f32 %0, %1, %2" : "=v"(r) : "v"(lo), "v"(hi)); return r; }
__device__ __forceinline__ float bf2f(unsigned short b) { return __uint_as_float(((unsigned)b) << 16); }
__device__ __forceinline__ float bflo(unsigned w) { return __uint_as_float(w << 16); }
__device__ __forceinline__ float bfhi(unsigned w) { return __uint_as_float(w & 0xffff0000u); }
__device__ __forceinline__ float sigm_f(float x) { return __builtin_amdgcn_rcpf(1.f + __builtin_amdgcn_exp2f(x * -1.4426950408889634f)); }
__device__ __forceinline__ float silu_f(float x) { return x * sigm_f(x); }
__device__ __forceinline__ float wave_sum(float v) {
#pragma unroll
    for (int o = 1; o < 64; o <<= 1) v += __shfl_xor(v, o);
    return v;
}

namespace pg8 {
constexpr int BM = 256, BK = 64, HALF = 128, HTB = HALF * BK * 2, STAGE_BYTES = 8 * HTB, NXCD = 8, WGM = 8;
__host__ __device__ __forceinline__ int lds_byte(int r, int c) { const int st = (r >> 4) * 2 + (c >> 5), rr = r & 15, cc = c & 31, ob = rr * 64 + cc * 2; return st * 1024 + (ob ^ (((ob >> 9) & 1) << 5)); }
__host__ __device__ __forceinline__ void stage_rc(int b, int& R, int& C) { const int st = b / 1024, sb = b % 1024, swz = sb ^ (((sb >> 9) & 1) << 5); R = (st >> 1) * 16 + swz / 64; C = (st & 1) * 32 + (swz % 64) / 2; }
__host__ __device__ __forceinline__ int perm32(int rho) { const int n = rho >> 4, i = rho & 15; return 8 * (i >> 2) + 4 * n + (i & 3); }

struct Unit { const char* a; const char* b; int pm, pn, kind, aux; };

__device__ __forceinline__ void tile_order(int L, int nM, int nN, int& pm, int& pn) {
    const int nwg = nM * nN; int wgid = L; { const int q = nwg / NXCD, r = nwg % NXCD, xcd = wgid % NXCD, off = wgid / NXCD; wgid = (xcd < r ? xcd * (q + 1) : r * (q + 1) + (xcd - r) * q) + off; }
    const int nig = WGM * nN, gid = wgid / nig, fm = gid * WGM, gsz = (nM - fm) < WGM ? (nM - fm) : WGM;
    pm = fm + ((wgid % nig) % gsz); pn = (wgid % nig) / gsz;
}

template <class Epi, class Sched>
__device__ __forceinline__ void gemm_phase(LAS unsigned char* lds, const int tid, const int K, const int lda, const int ldb, const Sched& S, const Epi& E) {
    const int  wid = __builtin_amdgcn_readfirstlane(tid >> 6), lane = tid & 63, wr = wid >> 2, wc = wid & 3, fr = lane & 15, fq = lane >> 4;
    const int nt = K / BK;
    unsigned voffA[2], voffB[2];
#pragma unroll
    for (int i = 0; i < 2; ++i) { int R, C; stage_rc(tid * 16 + i * 8192, R, C); const int Rb = (R & ~31) + perm32(R & 31);
        voffA[i] = (unsigned)(R * lda + C) * 2u; voffB[i] = (unsigned)(Rb * ldb + C) * 2u; }
    const size_t kstep = (size_t)(BK * 2);
    const size_t hstepA = (size_t)HALF * lda * 2, hstepB = (size_t)HALF * ldb * 2;
    const unsigned ldsw = (unsigned)wid * 1024u;
    const int aoff = lds_byte(wr * 64 + fr, fq * 8), boff = lds_byte(wc * 32 + fr, fq * 8);
#define PG8_SA(b, h) (((b) * 2 + (h)) * HTB)
#define PG8_SB(b, h) ((4 + (b) * 2 + (h)) * HTB)
#define PG8_STAGE(bufoff, gbase, voff) do { _Pragma("unroll") for (int _i = 0; _i < 2; ++_i) \
        __builtin_amdgcn_global_load_lds((const unsigned*)((const char*)(gbase) + (voff)[_i]), (LAS unsigned*)(lds + (bufoff) + ldsw + _i * 8192), 16, 0, 0); } while (0)
#define PG8_LDA(dst, b, h) do { _Pragma("unroll") for (int m = 0; m < 4; ++m) _Pragma("unroll") for (int k = 0; k < 2; ++k) dst[m][k] = *(const LAS bf16x8*)(lds + PG8_SA(b, h) + aoff + m * 2048 + k * 1024); } while (0)
#define PG8_LDB(dst, b, h) do { _Pragma("unroll") for (int n = 0; n < 2; ++n) _Pragma("unroll") for (int k = 0; k < 2; ++k) dst[n][k] = *(const LAS bf16x8*)(lds + PG8_SB(b, h) + boff + n * 2048 + k * 1024); } while (0)
#define PG8_MMA(ai, bj, At, Bt) do { __builtin_amdgcn_s_setprio(1); _Pragma("unroll") for (int m = 0; m < 4; ++m) _Pragma("unroll") for (int n = 0; n < 2; ++n) _Pragma("unroll") for (int k = 0; k < 2; ++k) \
        acc[ai][bj][m][n] = __builtin_amdgcn_mfma_f32_16x16x32_bf16(Bt[n][k], At[m][k], acc[ai][bj][m][n], 0, 0, 0); __builtin_amdgcn_s_setprio(0); } while (0)
#define PG8_WAIT_V(n) asm volatile("s_waitcnt vmcnt(" #n ")" ::: "memory")
#define PG8_WAIT_L(n) asm volatile("s_waitcnt lgkmcnt(" #n ")" ::: "memory")
#define PG8_BAR __builtin_amdgcn_s_barrier()
#define PG8_SCHED __builtin_amdgcn_sched_barrier(0)
    Unit cur, nxt; int ui = 0;
    if (!S.next(0, cur)) return;
    f32x4 acc[2][2][4][2];
#pragma unroll
    for (int a = 0; a < 2; ++a)
#pragma unroll
        for (int b = 0; b < 2; ++b)
#pragma unroll
            for (int m = 0; m < 4; ++m)
#pragma unroll
                for (int n = 0; n < 2; ++n) acc[a][b][m][n] = (f32x4){0.f, 0.f, 0.f, 0.f};
    bf16x8 At[4][2], B0[2][2], B1[2][2];
    const char* cA = cur.a; const char* cB = cur.b;
    PG8_STAGE(PG8_SB(0, 0), cB, voffB); PG8_STAGE(PG8_SA(0, 0), cA, voffA); PG8_STAGE(PG8_SB(0, 1), cB + hstepB, voffB); PG8_STAGE(PG8_SA(0, 1), cA + hstepA, voffA);
    if (wr == 1) PG8_BAR;
    PG8_WAIT_V(4); PG8_BAR;
    PG8_STAGE(PG8_SB(1, 0), cB + kstep, voffB); PG8_STAGE(PG8_SA(1, 0), cA + kstep, voffA); PG8_STAGE(PG8_SB(1, 1), cB + hstepB + kstep, voffB);
    PG8_WAIT_V(6); PG8_BAR;
    for (;;) {
        const bool has_next = S.next(ui + 1, nxt);
        const char* nA = has_next ? nxt.a : cA; const char* nB = has_next ? nxt.b : cB;
        for (int t = 0; t < nt; t += 2) {
            const bool last = (t == nt - 2);
            const char* a1 = cA + (size_t)(t + 1) * kstep;
            const char* a2 = last ? nA : cA + (size_t)(t + 2) * kstep; const char* b2 = last ? nB : cB + (size_t)(t + 2) * kstep;
            const char* a3 = a2 + kstep; const char* b3 = b2 + kstep;
            PG8_LDB(B0, 0, 0); PG8_SCHED; PG8_LDA(At, 0, 0); PG8_STAGE(PG8_SA(1, 1), a1 + hstepA, voffA);
            PG8_WAIT_L(8); PG8_BAR; PG8_WAIT_L(0); PG8_MMA(0, 0, At, B0); PG8_BAR; PG8_SCHED;
            PG8_LDB(B1, 0, 1); PG8_STAGE(PG8_SB(0, 0), b2, voffB);
            PG8_BAR; PG8_WAIT_L(0); PG8_MMA(0, 1, At, B1); PG8_BAR;
            PG8_LDA(At, 0, 1); PG8_STAGE(PG8_SA(0, 0), a2, voffA);
            PG8_BAR; PG8_WAIT_L(0); PG8_MMA(1, 0, At, B0); PG8_BAR; PG8_SCHED;
            PG8_STAGE(PG8_SB(0, 1), b2 + hstepB, voffB);
            PG8_WAIT_V(6); PG8_BAR; PG8_MMA(1, 1, At, B1); PG8_BAR;
            PG8_LDB(B0, 1, 0); PG8_SCHED; PG8_LDA(At, 1, 0); PG8_STAGE(PG8_SA(0, 1), a2 + hstepA, voffA);
            PG8_WAIT_L(8); PG8_BAR; PG8_WAIT_L(0); PG8_MMA(0, 0, At, B0); PG8_BAR; PG8_SCHED;
            PG8_LDB(B1, 1, 1); PG8_STAGE(PG8_SB(1, 0), b3, voffB);
            PG8_BAR; PG8_WAIT_L(0); PG8_MMA(0, 1, At, B1); PG8_BAR;
            PG8_LDA(At, 1, 1); PG8_STAGE(PG8_SA(1, 0), a3, voffA);
            PG8_BAR; PG8_WAIT_L(0); PG8_MMA(1, 0, At, B0); PG8_BAR; PG8_SCHED;
            PG8_STAGE(PG8_SB(1, 1), b3 + hstepB, voffB);
            PG8_WAIT_V(6); PG8_BAR; PG8_MMA(1, 1, At, B1); PG8_BAR;
        }
        E(acc, cur, wr, wc, fr, fq);
        if (!has_next) break;
        if (cur.aux != 1)
#pragma unroll
        for (int a = 0; a < 2; ++a)
#pragma unroll
            for (int b = 0; b < 2; ++b)
#pragma unroll
                for (int m = 0; m < 4; ++m)
#pragma unroll
                    for (int n = 0; n < 2; ++n) acc[a][b][m][n] = (f32x4){0.f, 0.f, 0.f, 0.f};
        cur = nxt; cA = nA; cB = nB; ++ui;
    }
    PG8_WAIT_V(0);
    if (wr == 0) PG8_BAR;
    PG8_BAR;
#undef PG8_SA
#undef PG8_SB
#undef PG8_STAGE
#undef PG8_LDA
#undef PG8_LDB
#undef PG8_MMA
#undef PG8_WAIT_V
#undef PG8_WAIT_L
#undef PG8_BAR
#undef PG8_SCHED
}
}
typedef f32x4 (&AccRef)[2][2][4][2];

#define XB_TMO      128
#define XB_XCNT(j)  (256  + 64 * (j))
#define XB_XSUB(j)  (1280 + 64 * (j))
#define XB_XGEN(j)  (2304 + 64 * (j))
#define XB_TOP      3328
#define XB_TOPGEN   3392
#define XCD_BAR_WORDS 3456
#define XB_SPIN_CAP (1u << 22)
__device__ __forceinline__ unsigned xb_ld(unsigned* p)              { return __hip_atomic_load(p, __ATOMIC_RELAXED, __HIP_MEMORY_SCOPE_AGENT); }
__device__ __forceinline__ unsigned xb_add(unsigned* p, unsigned v) { return __hip_atomic_fetch_add(p, v, __ATOMIC_RELAXED, __HIP_MEMORY_SCOPE_AGENT); }
__device__ __forceinline__ unsigned xb_xcc_id() { return (unsigned)__builtin_amdgcn_s_getreg((3 << 11) | 20) & 0xFu; }
#define XB_SPIN(cond, bar) do { unsigned _sp = 0; while (cond) { __builtin_amdgcn_s_sleep(1); \
    if ((++_sp & 255u) == 0u) { if (xb_ld(&(bar)[XB_TMO])) break; if (_sp > XB_SPIN_CAP) { atomicAdd(&(bar)[XB_TMO], 1u); break; } } } } while (0)
struct XcdBarrier { unsigned* bar; unsigned x; volatile LAS unsigned* st; };
__device__ __forceinline__ XcdBarrier xcd_barrier_post(unsigned* bar, volatile LAS unsigned* st) {
    XcdBarrier b; b.bar = bar; b.x = xb_xcc_id(); b.st = st;
    if (threadIdx.x == 0) (void)xb_add(&bar[XB_XCNT(b.x)], 1u);
    return b;
}
__device__ __forceinline__ void xcd_barrier_complete(unsigned* bar, unsigned x, unsigned& nloc, unsigned& nx) {
    const unsigned G = gridDim.x * gridDim.y * gridDim.z;
    unsigned sum, cnt, mine, sp = 0u;
    for (;;) {
        sum = 0u; cnt = 0u; mine = 0u;
#pragma unroll
        for (unsigned j = 0; j < 16; ++j) { const unsigned c = xb_ld(&bar[XB_XCNT(j)]); sum += c; cnt += (c > 0u) ? 1u : 0u; mine = (j == x) ? c : mine; }
        if (sum == G) break;
        __builtin_amdgcn_s_sleep(1);
        if ((++sp & 255u) == 0u) { if (xb_ld(&bar[XB_TMO])) break; if (sp > XB_SPIN_CAP) { atomicAdd(&bar[XB_TMO], 1u); break; } }
    }
    nloc = mine > 0u ? mine : 1u; nx = cnt > 0u ? cnt : 1u;
}
__device__ __forceinline__ void xcd_barrier(const XcdBarrier& b) {
    asm volatile("s_waitcnt vmcnt(0)" ::: "memory");
    __syncthreads();
    if (threadIdx.x == 0) {
        unsigned* bar = b.bar;
        __builtin_amdgcn_s_waitcnt(0);
        unsigned nloc = b.st[0], nx = b.st[1];
        if (nloc == 0u) { xcd_barrier_complete(bar, b.x, nloc, nx); b.st[0] = nloc; b.st[1] = nx; }
        const unsigned old = xb_add(&bar[XB_XSUB(b.x)], 1u);
        const unsigned gen = old / nloc;
        if (old + 1u == (gen + 1u) * nloc) {
            __builtin_amdgcn_fence(__ATOMIC_RELEASE, "agent");
            asm volatile("s_waitcnt vmcnt(0)" ::: "memory");
            const unsigned og = xb_add(&bar[XB_TOP], 1u);
            const unsigned tg = og / nx;
            if (og + 1u == (tg + 1u) * nx) xb_add(&bar[XB_TOPGEN], 1u);
            else XB_SPIN(xb_ld(&bar[XB_TOPGEN]) == tg, bar);
            __builtin_amdgcn_fence(__ATOMIC_ACQUIRE, "agent");
            xb_add(&bar[XB_XGEN(b.x)], 1u);
            asm volatile("s_waitcnt vmcnt(0)" ::: "memory");
        } else {
            XB_SPIN(xb_ld(&bar[XB_XGEN(b.x)]) == gen, bar);
            __builtin_amdgcn_fence(__ATOMIC_ACQUIRE, "agent");
            asm volatile("s_waitcnt vmcnt(0)" ::: "memory");
        }
    }
    __syncthreads();
}
using pg8::Unit;
typedef const unsigned long long __attribute__((address_space(4)))* CPtr64;
struct InTab { CPtr64 p; __device__ __forceinline__ const float* operator[](int i) const { return (const float*)p[i]; } };
struct Ctx {
    unsigned char* ws; float* out; InTab in;
    int G, c, tid;
};
#define WSP(T_, off) ((T_*)(X.ws + (off)))

struct SchedZ {
    const char* h; const char* w; int G, c;
    __device__ __forceinline__ bool next(int i, Unit& u) const {
        const long Lx = (long)i * G + c; if (Lx >= 32 * 61) return false;
        int pm, pn; pg8::tile_order((int)Lx, 32, 61, pm, pn);
        const char* hp = h + (size_t)pm * 256 * 2048 * 2; const char* wp = w + (size_t)pn * 256 * 2048 * 2;
        const bool sw = (pn >= 12 && pn < 16) || (pn >= 28 && pn < 32);
        u.pm = pm; u.pn = pn; u.kind = sw ? 1 : 0; u.aux = 0; u.a = sw ? wp : hp; u.b = sw ? hp : wp; return true;
    }
};
struct EpiZ {
    bf16_t* z; bf16_t* vsT; bf16_t* rvT; float* rss; bool doss;
    __device__ __forceinline__ void operator()(AccRef acc, const Unit& u, int wr, int wc, int fr, int fq) const {
        if (u.kind == 0) {
            const int pn = u.pn;
            const int act = (pn >= 36 && pn < 60) ? 2 : ((pn >= 4 && pn < 8) || (pn >= 16 && pn < 20) || (pn >= 32 && pn < 36)) ? 1 : (pn >= 24 && pn < 28) ? 3 : 0;
            const int row0 = u.pm * 256 + wr * 64 + fr, col0 = pn * 256 + wc * 32 + 8 * fq;
#pragma unroll
            for (int ai = 0; ai < 2; ++ai)
#pragma unroll
                for (int m = 0; m < 4; ++m) {
                    const int row = row0 + ai * 128 + m * 16; bf16_t* rowp = z + (size_t)row * ZW + col0; float ss = 0.f;
#pragma unroll
                    for (int bj = 0; bj < 2; ++bj) { f32x4 v0 = acc[ai][bj][m][0], v1 = acc[ai][bj][m][1];
                        if (act == 0) { ss += v0[0] * v0[0] + v0[1] * v0[1] + v0[2] * v0[2] + v0[3] * v0[3] + v1[0] * v1[0] + v1[1] * v1[1] + v1[2] * v1[2] + v1[3] * v1[3]; }
                        else if (act == 1) {
#pragma unroll
                            for (int j = 0; j < 4; ++j) { v0[j] = silu_f(v0[j]); v1[j] = silu_f(v1[j]); } }
                        else if (act == 2) {
#pragma unroll
                            for (int j = 0; j < 4; ++j) { v0[j] = fmaxf(sigm_f(v0[j]), 1e-20f); v1[j] = fmaxf(sigm_f(v1[j]), 1e-20f); } }
                        else { v0 = v0 * 0.08838834764831845f; v1 = v1 * 0.08838834764831845f; }
                        u32x4 w; w.x = cvt_pk(v0[0], v0[1]); w.y = cvt_pk(v0[2], v0[3]); w.z = cvt_pk(v1[0], v1[1]); w.w = cvt_pk(v1[2], v1[3]);
                        *(u32x4*)(rowp + bj * 128) = w; }
                    if (pn < 4 && doss) { ss += __shfl_xor(ss, 16); ss += __shfl_xor(ss, 32); if (fq == 0) atomicAdd(rss + (pn >> 1) * T + row, ss); }
                }
        } else {
            const bool isv = u.pn < 16; bf16_t* dst = isv ? vsT : rvT; const int f0 = (u.pn - (isv ? 12 : 28)) * 256 + wr * 64 + fr, tok0 = u.pm * 256 + wc * 32 + 8 * fq;
            float cs[2][2][4];
#pragma unroll
            for (int bj = 0; bj < 2; ++bj)
#pragma unroll
                for (int n = 0; n < 2; ++n)
#pragma unroll
                    for (int j = 0; j < 4; ++j) cs[bj][n][j] = 0.f;
#pragma unroll
            for (int ai = 0; ai < 2; ++ai)
#pragma unroll
                for (int m = 0; m < 4; ++m) { bf16_t* rowp = dst + (size_t)(f0 + ai * 128 + m * 16) * T + tok0;
#pragma unroll
                    for (int bj = 0; bj < 2; ++bj) { const f32x4 v0 = acc[ai][bj][m][0], v1 = acc[ai][bj][m][1];
#pragma unroll
                        for (int j = 0; j < 4; ++j) { cs[bj][0][j] += v0[j] * v0[j]; cs[bj][1][j] += v1[j] * v1[j]; }
                        u32x4 w; w.x = cvt_pk(v0[0], v0[1]); w.y = cvt_pk(v0[2], v0[3]); w.z = cvt_pk(v1[0], v1[1]); w.w = cvt_pk(v1[2], v1[3]);
                        *(u32x4*)(rowp + bj * 128) = w; } }
            if (isv && doss) {
#pragma unroll
                for (int bj = 0; bj < 2; ++bj)
#pragma unroll
                    for (int n = 0; n < 2; ++n)
#pragma unroll
                        for (int j = 0; j < 4; ++j) { float s = cs[bj][n][j]; s += __shfl_xor(s, 1); s += __shfl_xor(s, 2); s += __shfl_xor(s, 4); s += __shfl_xor(s, 8);
                            if (fr == 0) atomicAdd(rss + 2 * T + tok0 + bj * 128 + n * 4 + j, s); }
            }
        }
    }
};

struct SchedQK {
    const char* z; const char* wq; const char* wk; int G, c;
    __device__ __forceinline__ bool next(int i, Unit& u) const {
        const int Lx = i * G + c; if (Lx >= 320) return false;
        if (Lx < 192) { u.pm = Lx / 6; u.pn = Lx % 6; u.kind = 0; u.a = z + (size_t)u.pm * 256 * ZW * 2 + Z_CQ * 2; u.b = wq + (size_t)u.pn * 256 * 512 * 2; }
        else { const int r = Lx - 192; u.pm = r / 4; u.pn = r % 4; u.kind = 1; u.a = z + (size_t)u.pm * 256 * ZW * 2 + Z_CKV * 2; u.b = wk + (size_t)u.pn * 256 * 512 * 2; }
        u.aux = 0; return true;
    }
};
constexpr float QSCALE = 0.07216878364870322f * 1.4426950408889634f;
struct EpiQK {
    bf16_t* q; bf16_t* kn; const float* rss; const float* rope;
    __device__ __forceinline__ void operator()(AccRef acc, const Unit& u, int wr, int wc, int fr, int fq) const {
        const int row0 = u.pm * 256 + wr * 64 + fr, col0 = u.pn * 256 + wc * 32 + 8 * fq;
        if (u.kind == 0) {
#pragma unroll
            for (int ai = 0; ai < 2; ++ai)
#pragma unroll
                for (int m = 0; m < 4; ++m) {
                    const int row = row0 + ai * 128 + m * 16; const float ri = rsqrtf(rss[row] * (1.f / 512.f) + EPSN) * QSCALE;
                    const int t = (row - 4096) & 2047;
#pragma unroll
                    for (int bj = 0; bj < 2; ++bj) { f32x4 v0 = acc[ai][bj][m][0] * ri, v1 = acc[ai][bj][m][1] * ri;
                        const int g0 = u.pn * 256 + bj * 128 + wc * 32, off = g0 % 192;
                        if (off >= 128 && row >= 4096) {
                            const int p = (off == 128) ? (t >> 6) : (t & 63); const float* tb = rope + (p * 16 + (fq & 1) * 8) * 2;
                            const float sg = (fq & 2) ? 1.f : -1.f;
#pragma unroll
                            for (int j = 0; j < 4; ++j) { const float p0 = __shfl_xor(v0[j], 32), p1 = __shfl_xor(v1[j], 32);
                                const float c0 = tb[2 * j], s0 = tb[2 * j + 1], c1 = tb[2 * (4 + j)], s1 = tb[2 * (4 + j) + 1];
                                v0[j] = v0[j] * c0 + sg * p0 * s0; v1[j] = v1[j] * c1 + sg * p1 * s1; }
                        }
                        u32x4 w; w.x = cvt_pk(v0[0], v0[1]); w.y = cvt_pk(v0[2], v0[3]); w.z = cvt_pk(v1[0], v1[1]); w.w = cvt_pk(v1[2], v1[3]);
                        *(u32x4*)(q + (size_t)row * 1536 + col0 + bj * 128) = w; }
                }
        } else {
#pragma unroll
            for (int ai = 0; ai < 2; ++ai)
#pragma unroll
                for (int m = 0; m < 4; ++m) {
                    const int row = row0 + ai * 128 + m * 16; const float ri = rsqrtf(rss[T + row] * (1.f / 512.f) + EPSN);
#pragma unroll
                    for (int bj = 0; bj < 2; ++bj) { const f32x4 v0 = acc[ai][bj][m][0] * ri, v1 = acc[ai][bj][m][1] * ri;
                        u32x4 w; w.x = cvt_pk(v0[0], v0[1]); w.y = cvt_pk(v0[2], v0[3]); w.z = cvt_pk(v1[0], v1[1]); w.w = cvt_pk(v1[2], v1[3]);
                        *(u32x4*)(kn + (size_t)row * 1024 + col0 + bj * 128) = w; }
                }
        }
    }
};

struct SchedVT {
    const char* z; const char* wv; int G, c;
    __device__ __forceinline__ bool next(int i, Unit& u) const {
        const int Lx = i * G + c; if (Lx >= 128) return false;
        u.pm = Lx & 3; u.pn = Lx >> 2; u.kind = 0; u.aux = 0; u.a = wv + (size_t)u.pm * 256 * 512 * 2; u.b = z + (size_t)u.pn * 256 * ZW * 2 + Z_CKV * 2; return true;
    }
};
struct EpiVT {
    bf16_t* vt; const float* rss;
    __device__ __forceinline__ void operator()(AccRef acc, const Unit& u, int wr, int wc, int fr, int fq) const {
        const int f0 = u.pm * 256 + wr * 64 + fr, tok0 = u.pn * 256 + wc * 32 + 8 * fq;
        f32x4 ri[2][2];
#pragma unroll
        for (int bj = 0; bj < 2; ++bj)
#pragma unroll
            for (int n = 0; n < 2; ++n)
#pragma unroll
                for (int j = 0; j < 4; ++j) ri[bj][n][j] = rsqrtf(rss[T + tok0 + bj * 128 + n * 4 + j] * (1.f / 512.f) + EPSN);
#pragma unroll
        for (int ai = 0; ai < 2; ++ai)
#pragma unroll
            for (int m = 0; m < 4; ++m) { bf16_t* rowp = vt + (size_t)(f0 + ai * 128 + m * 16) * T + tok0;
#pragma unroll
                for (int bj = 0; bj < 2; ++bj) { const f32x4 v0 = acc[ai][bj][m][0] * ri[bj][0], v1 = acc[ai][bj][m][1] * ri[bj][1];
                    u32x4 w; w.x = cvt_pk(v0[0], v0[1]); w.y = cvt_pk(v0[2], v0[3]); w.z = cvt_pk(v1[0], v1[1]); w.w = cvt_pk(v1[2], v1[3]);
                    *(u32x4*)(rowp + bj * 128) = w; } }
    }
};

struct SchedC {
    const char* cc; const char* wk; const char* wv; int G, c;
    __device__ __forceinline__ bool next(int i, Unit& u) const {
        const int Lx = i * G + c; if (Lx >= 64) return false;
        const int l = Lx >> 4, r = Lx & 15; u.aux = l;
        if (r < 8) { u.kind = 0; u.pm = r >> 2; u.pn = r & 3; u.a = cc + ((size_t)l * 512 + u.pm * 256) * 512 * 2; u.b = wk + ((size_t)l * 1024 + u.pn * 256) * 512 * 2; }
        else { const int s = r - 8; u.kind = 1; u.pm = s >> 1; u.pn = s & 1; u.a = wv + ((size_t)l * 1024 + u.pm * 256) * 512 * 2; u.b = cc + ((size_t)l * 512 + u.pn * 256) * 512 * 2; }
        return true;
    }
};
struct EpiC {
    bf16_t* kc; bf16_t* vtc;
    __device__ __forceinline__ void operator()(AccRef acc, const Unit& u, int wr, int wc, int fr, int fq) const {
        const int r0 = u.pm * 256 + wr * 64 + fr, c0 = u.pn * 256 + wc * 32 + 8 * fq;
        bf16_t* base = u.kind == 0 ? kc + (size_t)u.aux * 512 * 1024 : vtc + (size_t)u.aux * 1024 * 512; const int ld = u.kind == 0 ? 1024 : 512;
#pragma unroll
        for (int ai = 0; ai < 2; ++ai)
#pragma unroll
            for (int m = 0; m < 4; ++m) { bf16_t* rowp = base + (size_t)(r0 + ai * 128 + m * 16) * ld + c0;
#pragma unroll
                for (int bj = 0; bj < 2; ++bj) { const f32x4 v0 = acc[ai][bj][m][0], v1 = acc[ai][bj][m][1];
                    u32x4 w; w.x = cvt_pk(v0[0], v0[1]); w.y = cvt_pk(v0[2], v0[3]); w.z = cvt_pk(v1[0], v1[1]); w.w = cvt_pk(v1[2], v1[3]);
                    *(u32x4*)(rowp + bj * 128) = w; } }
    }
};

struct SchedBr {
    const char* am; const char* as; const char* ar; const char* w; int G, c;
    __device__ __forceinline__ bool next(int i, Unit& u) const {
        const int tile = (i / 3) * G + c; if (tile >= 256) return false;
        const int br = i % 3; pg8::tile_order(tile, 32, 8, u.pm, u.pn); u.kind = br; u.aux = br < 2 ? 1 : 0;
        u.a = (br == 0 ? am : br == 1 ? as : ar) + (size_t)u.pm * 256 * 1024 * 2; u.b = w + ((size_t)br * 2048 + u.pn * 256) * 1024 * 2; return true;
    }
};
struct EpiBr {
    const bf16_t* z; bf16_t* ymb;
    __device__ __forceinline__ void operator()(AccRef acc, const Unit& u, int wr, int wc, int fr, int fq) const {
        const int row0 = u.pm * 256 + wr * 64 + fr, col0 = u.pn * 256 + wc * 32 + 8 * fq;
#pragma unroll
        for (int ai = 0; ai < 2; ++ai)
#pragma unroll
            for (int m = 0; m < 4; ++m) { const int row = row0 + ai * 128 + m * 16;
#pragma unroll
                for (int bj = 0; bj < 2; ++bj) { const int col = col0 + bj * 128;
                    const bf16_t* mp = z + (size_t)row * ZW + Z_MRG + u.kind * 2048 + col;
                    const u32x4 mg = *(const u32x4*)mp;
                    f32x4 s0, s1; s0[0] = bflo(mg.x); s0[1] = bfhi(mg.x); s0[2] = bflo(mg.y); s0[3] = bfhi(mg.y); s1[0] = bflo(mg.z); s1[1] = bfhi(mg.z); s1[2] = bflo(mg.w); s1[3] = bfhi(mg.w);
                    if (u.kind < 2) { const u32x4 mn = *(const u32x4*)(mp + 2048);
                        s0[0] *= __builtin_amdgcn_rcpf(bflo(mn.x)); s0[1] *= __builtin_amdgcn_rcpf(bfhi(mn.x)); s0[2] *= __builtin_amdgcn_rcpf(bflo(mn.y)); s0[3] *= __builtin_amdgcn_rcpf(bfhi(mn.y));
                        s1[0] *= __builtin_amdgcn_rcpf(bflo(mn.z)); s1[1] *= __builtin_amdgcn_rcpf(bfhi(mn.z)); s1[2] *= __builtin_amdgcn_rcpf(bflo(mn.w)); s1[3] *= __builtin_amdgcn_rcpf(bfhi(mn.w));
                        acc[ai][bj][m][0] *= s0; acc[ai][bj][m][1] *= s1; }
                    else { const f32x4 v0 = acc[ai][bj][m][0] * s0, v1 = acc[ai][bj][m][1] * s1;
                        u32x4 w; w.x = cvt_pk(v0[0], v0[1]); w.y = cvt_pk(v0[2], v0[3]); w.z = cvt_pk(v1[0], v1[1]); w.w = cvt_pk(v1[2], v1[3]);
                        *(u32x4*)(ymb + (size_t)row * DM + col) = w; }
                } }
    }
};

struct SchedOut {
    const char* a; const char* w; int G, c;
    __device__ __forceinline__ bool next(int i, Unit& u) const {
        const int tile = i * G + c; if (tile >= 256) return false;
        pg8::tile_order(tile, 32, 8, u.pm, u.pn); u.kind = 0; u.aux = 0; u.a = a + (size_t)u.pm * 256 * 2048 * 2; u.b = w + (size_t)u.pn * 256 * 2048 * 2; return true;
    }
};
struct EpiOut {
    float* y; float* rss; bool doss;
    __device__ __forceinline__ void operator()(AccRef acc, const Unit& u, int wr, int wc, int fr, int fq) const {
        const int row0 = u.pm * 256 + wr * 64 + fr, col0 = u.pn * 256 + wc * 32 + 8 * fq;
#pragma unroll
        for (int ai = 0; ai < 2; ++ai)
#pragma unroll
            for (int m = 0; m < 4; ++m) { const int row = row0 + ai * 128 + m * 16; float ss = 0.f;
#pragma unroll
                for (int bj = 0; bj < 2; ++bj) { const f32x4 v0 = acc[ai][bj][m][0], v1 = acc[ai][bj][m][1]; float* yp = y + (size_t)row * DM + col0 + bj * 128;
                    ss += v0[0] * v0[0] + v0[1] * v0[1] + v0[2] * v0[2] + v0[3] * v0[3] + v1[0] * v1[0] + v1[1] * v1[1] + v1[2] * v1[2] + v1[3] * v1[3];
                    *(f32x4*)yp = v0; *(f32x4*)(yp + 4) = v1; }
                ss += __shfl_xor(ss, 16); ss += __shfl_xor(ss, 32); if (fq == 0 && doss) atomicAdd(rss + 3 * T + row, ss); }
    }
};
__device__ __forceinline__ void transpose_item(const float* W, int K, int N, int k0, int n0, bf16_t* dst0, const float* gk, LAS float* scr, int lane) {
    const int kr = lane >> 3, c4 = (lane & 7) * 4;
    f32x4 v[8];
#pragma unroll
    for (int i = 0; i < 8; ++i) v[i] = __builtin_nontemporal_load((const f32x4*)(W + (size_t)(k0 + 8 * i + kr) * N + n0 + c4));
    if (gk) {
#pragma unroll
        for (int i = 0; i < 8; ++i) v[i] = v[i] * gk[k0 + 8 * i + kr]; }
#pragma unroll
    for (int i = 0; i < 8; ++i) { LAS float* sp = scr + (8 * i + kr) * 33 + c4; sp[0] = v[i][0]; sp[1] = v[i][1]; sp[2] = v[i][2]; sp[3] = v[i][3]; }
    asm volatile("s_waitcnt lgkmcnt(0)" ::: "memory");
    const int c = lane & 7;
#pragma unroll
    for (int j = 0; j < 4; ++j) { const int n = (lane >> 3) + 8 * j; const LAS float* s = scr + (8 * c) * 33 + n;
        u32x4 o; o.x = cvt_pk(s[0 * 33], s[1 * 33]); o.y = cvt_pk(s[2 * 33], s[3 * 33]); o.z = cvt_pk(s[4 * 33], s[5 * 33]); o.w = cvt_pk(s[6 * 33], s[7 * 33]);
        *(u32x4*)(dst0 + (size_t)n * K + k0 + 8 * c) = o; }
    asm volatile("s_waitcnt lgkmcnt(0)" ::: "memory");
}

__device__ __forceinline__ void phase_prologue(const Ctx& X, LAS unsigned char* lds) {
    const int tid = X.tid, lane = tid & 63, wave = tid >> 6;
    const int gw = X.c * 8 + wave, NGW = X.G * 8;
    LAS float* scr = (LAS float*)(lds + wave * 8704);
    constexpr int I_IN = 32 * 482, I_UQ = 8 * 48, I_UKV = 8 * 64, I_BR = 16 * 64, I_OUT = 32 * 64;
    constexpr int PER_L = I_IN + I_UQ + 2 * I_UKV + 3 * I_BR + I_OUT;
    for (int it = gw; it < NL * PER_L; it += NGW) {
        const int l = it / PER_L; int r = it % PER_L;
        if (r < I_IN) { const int kb = r / 482, nb = r % 482, n0 = nb * 32; const int d0 = n0 < 1024 ? n0 : (n0 < 1088 ? Z_KR + (n0 - 1024) : n0 - 64);
            transpose_item(X.in[11] + (size_t)l * 2048 * INC, 2048, INC, kb * 64, n0, WSP(bf16_t, O_WIN) + ((size_t)l * ZW + d0) * 2048, nullptr, scr, lane); continue; }
        r -= I_IN;
        if (r < I_UQ) { const int kb = r / 48, nb = r % 48;
            transpose_item(X.in[14] + (size_t)l * 512 * 1536, 512, 1536, kb * 64, nb * 32, WSP(bf16_t, O_WUQ) + ((size_t)l * 1536 + nb * 32) * 512, X.in[12] + l * 512, scr, lane); continue; }
        r -= I_UQ;
        if (r < 2 * I_UKV) { const int gfold = r >= I_UKV; if (gfold) r -= I_UKV; const int kb = r / 64, nb = r % 64, n0 = nb * 32, hd = n0 >> 8, d = n0 & 255;
            bf16_t* dst = (d < 128 ? WSP(bf16_t, gfold ? O_WKG : O_WKP) : WSP(bf16_t, gfold ? O_WVG : O_WVP)) + ((size_t)l * 1024 + hd * 128 + (d & 127)) * 512;
            transpose_item(X.in[15] + (size_t)l * 512 * 2048, 512, 2048, kb * 64, n0, dst, gfold ? X.in[13] + l * 512 : nullptr, scr, lane); continue; }
        r -= 2 * I_UKV;
        if (r < 3 * I_BR) { const int br = r / I_BR; r %= I_BR; const int kb = r / 64, nb = r % 64;
            transpose_item(X.in[21 + br] + (size_t)l * 1024 * 2048, 1024, 2048, kb * 64, nb * 32, WSP(bf16_t, O_WBR) + (((size_t)l * 3 + br) * 2048 + nb * 32) * 1024, nullptr, scr, lane); continue; }
        r -= 3 * I_BR;
        { const int kb = r / 64, nb = r % 64;
            transpose_item(X.in[24] + (size_t)l * 2048 * 2048, 2048, 2048, kb * 64, nb * 32, WSP(bf16_t, O_WOUT) + ((size_t)l * 2048 + nb * 32) * 2048, nullptr, scr, lane); }
    }
    const int gt = X.c * NTHREADS + tid, NGT = X.G * NTHREADS;
    for (int i = gt; i < NL * 512 * 512 / 4; i += NGT) { const int e = i * 4, l = e / (512 * 512), rr = (e / 512) % 512, cidx = e % 512, b = rr >> 8, t = rr & 255;
        const f32x4 v = *(const f32x4*)(X.in[2] + (((size_t)b * NL + l) * 256 + t) * 512 + cidx);
        u32x2 w; w.x = cvt_pk(v[0], v[1]); w.y = cvt_pk(v[2], v[3]); *(u32x2*)(WSP(bf16_t, O_CKVC) + e) = w; }
    for (int i = gt; i < NL * 512 * 64 / 4; i += NGT) { const int e = i * 4, l = e / (512 * 64), rr = (e / 64) % 512, cidx = e % 64, b = rr >> 8, t = rr & 255;
        const f32x4 v = *(const f32x4*)(X.in[3] + (((size_t)b * NL + l) * 256 + t) * 64 + cidx);
        u32x2 w; w.x = cvt_pk(v[0], v[1]); w.y = cvt_pk(v[2], v[3]); *(u32x2*)(WSP(bf16_t, O_KRC) + e) = w; }
    for (int i = gt; i < 64 * 16; i += NGT) { const int p = i >> 4, f = i & 15; const float inv = powf(10000.f, -(float)f / 16.f); const float ang = (float)p * inv;
        WSP(float, O_ROPE)[2 * i] = cosf(ang); WSP(float, O_ROPE)[2 * i + 1] = sinf(ang); }
    for (int i = gt; i < 4 * T; i += NGT) WSP(float, O_RSS)[i] = 0.f;
    LAS float* sl = (LAS float*)(lds + 69632);
    LAS float* red = (LAS float*)(lds + 69632 + 24576);
    __syncthreads();
    for (int i = tid; i < 3 * 2048; i += NTHREADS) { const int cidx = i >> 11, k = i & 2047; const float v = cidx == 0 ? X.in[6][k] : X.in[5][(cidx - 1) * 2048 + k]; sl[i] = silu_f(v); }
    __syncthreads();
    for (int un = X.c; un < NL * 192; un += X.G) {
        const int l = un / 192, col0 = (un % 192) * 32, kg = tid >> 3, c4 = tid & 7;
        const float* wp = X.in[7] + (size_t)l * 2048 * 6144 + col0 + 4 * c4;
        f32x4 a0 = {0.f, 0.f, 0.f, 0.f}, a1 = a0, a2 = a0;
#pragma unroll 8
        for (int k = kg; k < 2048; k += 64) { const f32x4 w = *(const f32x4*)(wp + (size_t)k * 6144); a0 += w * sl[k]; a1 += w * sl[2048 + k]; a2 += w * sl[4096 + k]; }
        LAS float* rp = red + (kg * 8 + c4) * 12;
#pragma unroll
        for (int j = 0; j < 4; ++j) { rp[j] = a0[j]; rp[4 + j] = a1[j]; rp[8 + j] = a2[j]; }
        __syncthreads();
        if (tid < 96) { const int cc = tid / 12, jj = tid % 12; float s = 0.f; for (int g = 0; g < 64; ++g) s += red[(g * 8 + cc) * 12 + jj];
            const int cidx = jj >> 2, col = col0 + 4 * cc + (jj & 3); WSP(float, O_MOD)[((size_t)l * 3 + cidx) * 6144 + col] = s + X.in[8][l * 6144 + col]; }
        __syncthreads();
    }
}

__device__ __forceinline__ void phase_rows(const Ctx& X, int l, bool upd, int ln) {
    const int tid = X.tid, lane = tid & 63, wave = tid >> 6;
    const float* mod = WSP(float, O_MOD);
    for (int row = X.c * 8 + wave; row < T; row += X.G * 8) {
        const int cidx = row < 4096 ? 0 : 1 + ((row - 4096) >> 11);
        const float* xsrc = (upd && l > 0) || (!upd && ln > 0) ? WSP(float, O_X) + (size_t)row * DM : (row < 4096 ? X.in[0] + (size_t)row * DM : X.in[1] + (size_t)(row - 4096) * DM);
        f32x4 v[8];
#pragma unroll
        for (int j = 0; j < 8; ++j) v[j] = *(const f32x4*)(xsrc + j * 256 + lane * 4);
        if (upd) {
            const float ri = rsqrtf(WSP(float, O_RSS)[3 * T + row] * (1.f / 2048.f) + EPSN);
            const float* yp = WSP(float, O_Y) + (size_t)row * DM; const float* gate = mod + ((size_t)l * 3 + cidx) * 6144 + 4096; const float* gp = X.in[10] + l * 2048;
            float* xdst = (l == NL - 1) ? X.out + (row < 4096 ? OUT_YP + (size_t)row * DM : OUT_YS + (size_t)(row - 4096) * DM) : WSP(float, O_X) + (size_t)row * DM;
#pragma unroll
            for (int j = 0; j < 8; ++j) { const int c = j * 256 + lane * 4; const f32x4 y = *(const f32x4*)(yp + c), g = *(const f32x4*)(gate + c), gg = *(const f32x4*)(gp + c);
                v[j] += g * (y * ri) * gg; *(f32x4*)(xdst + c) = v[j]; }
        }
        if (ln < NL) {
            float ss = 0.f;
#pragma unroll
            for (int j = 0; j < 8; ++j) ss += v[j][0] * v[j][0] + v[j][1] * v[j][1] + v[j][2] * v[j][2] + v[j][3] * v[j][3];
            ss = wave_sum(ss); const float ri = rsqrtf(ss * (1.f / 2048.f) + EPSN);
            const float* sh = mod + ((size_t)ln * 3 + cidx) * 6144; const float* sc = sh + 2048; const float* gp = X.in[9] + ln * 2048;
            bf16_t* hp = WSP(bf16_t, O_H) + (size_t)row * DM;
#pragma unroll
            for (int j = 0; j < 8; ++j) { const int c = j * 256 + lane * 4; const f32x4 s = *(const f32x4*)(sc + c), b = *(const f32x4*)(sh + c), g = *(const f32x4*)(gp + c);
                const f32x4 hv = v[j] * ri * g * (s + 1.f) + b; u32x2 w; w.x = cvt_pk(hv[0], hv[1]); w.y = cvt_pk(hv[2], hv[3]); *(u32x2*)(hp + c) = w; }
        }
    }
}

__device__ __forceinline__ void phase_misc(const Ctx& X, int l) {
    const int tid = X.tid, lane = tid & 63, wave = tid >> 6;
    const bf16_t* z = WSP(bf16_t, O_Z); const float* rope = WSP(float, O_ROPE);
    for (int row = X.c * 8 + wave; row < T; row += X.G * 8) {
        const bf16_t* zr = z + (size_t)row * ZW;
        float kr = bf2f(zr[Z_KR + lane]);
        if (row < 4096) {
            const int b = row >> 8, t = row & 255;
            const float ri = rsqrtf(WSP(float, O_RSS)[T + row] * (1.f / 512.f) + EPSN);
            const u32x4 w = *(const u32x4*)(zr + Z_CKV + lane * 8); const float* g = X.in[13] + l * 512 + lane * 8;
            float* o = X.out + OUT_CKV + (((size_t)b * NL + l) * 256 + t) * 512 + lane * 8;
            f32x4 o0, o1; o0[0] = bflo(w.x) * ri * g[0]; o0[1] = bfhi(w.x) * ri * g[1]; o0[2] = bflo(w.y) * ri * g[2]; o0[3] = bfhi(w.y) * ri * g[3];
            o1[0] = bflo(w.z) * ri * g[4]; o1[1] = bfhi(w.z) * ri * g[5]; o1[2] = bflo(w.w) * ri * g[6]; o1[3] = bfhi(w.w) * ri * g[7];
            *(f32x4*)o = o0; *(f32x4*)(o + 4) = o1;
            X.out[OUT_KR + (((size_t)b * NL + l) * 256 + t) * 64 + lane] = kr;
        } else {
            const int t = (row - 4096) & 2047; const int p = lane < 32 ? (t >> 6) : (t & 63); const int f = lane & 15;
            const float cs = rope[(p * 16 + f) * 2], sn = rope[(p * 16 + f) * 2 + 1];
            const float pr = __shfl_xor(kr, 16);
            kr = (lane & 16) ? kr * cs + pr * sn : kr * cs - pr * sn;
        }
        const float nb = __shfl_down(kr, 1);
        if ((lane & 1) == 0) *(unsigned*)(WSP(bf16_t, O_KR) + (size_t)row * 64 + lane) = cvt_pk(kr, nb);
    }
}
constexpr int PB = 272;
constexpr int BUFB = 128 * PB;
constexpr int PO = 132;
__device__ __forceinline__ void mma128(const LAS unsigned char* As, const LAS unsigned char* Bs, f32x16 (&acc)[2], int wr, int wc, int lane) {
    const int r32 = lane & 31, hi = lane >> 5;
    const LAS unsigned char* ap = As + (32 * wr + r32) * PB + hi * 16;
    const LAS unsigned char* bp = Bs + (64 * wc + r32) * PB + hi * 16;
#pragma unroll 2
    for (int s = 0; s < 8; ++s) {
        const bf16x8 a = *(const LAS bf16x8*)(ap + s * 32);
        const bf16x8 b0 = *(const LAS bf16x8*)(bp + s * 32);
        const bf16x8 b1 = *(const LAS bf16x8*)(bp + 32 * PB + s * 32);
        acc[0] = __builtin_amdgcn_mfma_f32_32x32x16_bf16(a, b0, acc[0], 0, 0, 0);
        acc[1] = __builtin_amdgcn_mfma_f32_32x32x16_bf16(a, b1, acc[1], 0, 0, 0);
    }
}
__device__ __forceinline__ int crow(int r, int hi) { return (r & 3) + 8 * (r >> 2) + 4 * hi; }
__device__ __forceinline__ void stage_tile(LAS unsigned char* dst, const bf16_t* src, size_t ld, int tid) {
#pragma unroll
    for (int i = 0; i < 4; ++i) { const int c = tid + i * NTHREADS, r = c >> 4, ch = c & 15;
        *(LAS u32x4*)(dst + r * PB + ch * 16) = *(const u32x4*)(src + (size_t)r * ld + ch * 8); }
}
__device__ __forceinline__ float log_sigmoid_f(float x) { return -log1pf(expf(-x)); }

__device__ __forceinline__ void sgu_item(const Ctx& X, LAS unsigned char* lds, int l, int item) {
    int tid_ = X.tid; asm volatile("" : "+v"(tid_));
    const int tid = tid_, lane = tid & 63, wave = tid >> 6, wr = wave >> 1, wc = wave & 1;
    const int n = item >> 3, g = item & 7, tok0 = n * 128;
    LAS unsigned char* As = lds; LAS unsigned char* Bs = lds + BUFB; LAS float* Os = (LAS float*)(lds + 2 * BUFB);
    const float* ws = X.in[17] + ((size_t)l * 8 + g) * 16384; const float* rss = WSP(float, O_RSS) + 2 * T + tok0;
#pragma unroll
    for (int i = 0; i < 4; ++i) { const int c = tid + i * NTHREADS, r = c >> 4, ch = c & 15;
        const f32x4 w0 = *(const f32x4*)(ws + r * 128 + ch * 8), w1 = *(const f32x4*)(ws + r * 128 + ch * 8 + 4);
        const f32x4 s0 = *(const f32x4*)(rss + ch * 8), s1 = *(const f32x4*)(rss + ch * 8 + 4);
        u32x4 o; o.x = cvt_pk(w0[0] * rsqrtf(s0[0] * (1.f / 1024.f) + EPSN), w0[1] * rsqrtf(s0[1] * (1.f / 1024.f) + EPSN));
        o.y = cvt_pk(w0[2] * rsqrtf(s0[2] * (1.f / 1024.f) + EPSN), w0[3] * rsqrtf(s0[3] * (1.f / 1024.f) + EPSN));
        o.z = cvt_pk(w1[0] * rsqrtf(s1[0] * (1.f / 1024.f) + EPSN), w1[1] * rsqrtf(s1[1] * (1.f / 1024.f) + EPSN));
        o.w = cvt_pk(w1[2] * rsqrtf(s1[2] * (1.f / 1024.f) + EPSN), w1[3] * rsqrtf(s1[3] * (1.f / 1024.f) + EPSN));
        *(LAS u32x4*)(As + r * PB + ch * 16) = o; }
    stage_tile(Bs, WSP(bf16_t, O_VST) + (size_t)(g * 128) * T + tok0, T, tid);
    __syncthreads();
    f32x16 acc[2]; acc[0] = (f32x16)(0.f); acc[1] = (f32x16)(0.f);
    mma128(As, Bs, acc, wr, wc, lane);
    { const int hi = lane >> 5, cb = 64 * wc + (lane & 31);
#pragma unroll
      for (int t = 0; t < 2; ++t)
#pragma unroll
        for (int r = 0; r < 16; ++r) Os[(32 * wr + crow(r, hi)) * PO + cb + 32 * t] = acc[t][r]; }
    __syncthreads();
    { const int p = tid >> 2, cseg = (tid & 3) * 32; const bf16_t* zr = WSP(bf16_t, O_Z) + (size_t)(tok0 + p) * ZW;
      const float bs = X.in[18][((size_t)l * 128 + p) * 8 + g]; const float* gs = X.in[16] + l * 1024 + g * 128 + cseg;
      bf16_t* op = WSP(bf16_t, O_AS) + (size_t)(tok0 + p) * 1024 + g * 128 + cseg;
#pragma unroll
      for (int i = 0; i < 4; ++i) {
          const u32x4 uu = *(const u32x4*)(zr + Z_U + g * 128 + cseg + i * 8), gg = *(const u32x4*)(zr + Z_GPS + g * 128 + cseg + i * 8);
          const f32x4 s0 = *(const LAS f32x4*)(Os + p * PO + cseg + i * 8), s1 = *(const LAS f32x4*)(Os + p * PO + cseg + i * 8 + 4);
          const f32x4 g0 = *(const f32x4*)(gs + i * 8), g1 = *(const f32x4*)(gs + i * 8 + 4);
          u32x4 o; o.x = cvt_pk((s0[0] * g0[0] + bs) * bflo(uu.x) * bflo(gg.x), (s0[1] * g0[1] + bs) * bfhi(uu.x) * bfhi(gg.x));
          o.y = cvt_pk((s0[2] * g0[2] + bs) * bflo(uu.y) * bflo(gg.y), (s0[3] * g0[3] + bs) * bfhi(uu.y) * bfhi(gg.y));
          o.z = cvt_pk((s1[0] * g1[0] + bs) * bflo(uu.z) * bflo(gg.z), (s1[1] * g1[1] + bs) * bfhi(uu.z) * bfhi(gg.z));
          o.w = cvt_pk((s1[2] * g1[2] + bs) * bflo(uu.w) * bflo(gg.w), (s1[3] * g1[3] + bs) * bfhi(uu.w) * bfhi(gg.w));
          *(u32x4*)(op + i * 8) = o; } }
    __syncthreads();
}

__device__ __forceinline__ void retstate_item(const Ctx& X, LAS unsigned char* lds, int l, int item) {
    int tid_ = X.tid; asm volatile("" : "+v"(tid_));
    const int tid = tid_, lane = tid & 63, wave = tid >> 6, wr = wave >> 1, wc = wave & 1;
    const int n = item >> 3, hd = item & 7, tok0 = n * 128;
    LAS unsigned char* As = lds; LAS unsigned char* Bf = lds + BUFB; LAS unsigned char* Bb = lds + 2 * BUFB;
    const float lgf = log_sigmoid_f(X.in[19][(l * 2 + 0) * 8 + hd]) * 1.4426950408889634f, lgb = log_sigmoid_f(X.in[19][(l * 2 + 1) * 8 + hd]) * 1.4426950408889634f;
    stage_tile(As, WSP(bf16_t, O_RVT) + (size_t)(hd * 128) * T + tok0, T, tid);
    { const bf16_t* kz = WSP(bf16_t, O_Z) + (size_t)tok0 * ZW + Z_RK + hd * 128;
#pragma unroll
      for (int i = 0; i < 4; ++i) { const int combo = wave * 4 + i, j = (combo & 1) * 64 + lane, d0 = (combo >> 1) * 8;
          const u32x4 w = *(const u32x4*)(kz + (size_t)j * ZW + d0);
          const float wf = exp2f(lgf * (float)(127 - j)), wb = exp2f(lgb * (float)j);
          const float kv[8] = {bflo(w.x), bfhi(w.x), bflo(w.y), bfhi(w.y), bflo(w.z), bfhi(w.z), bflo(w.w), bfhi(w.w)};
#pragma unroll
          for (int e = 0; e < 8; ++e) { *(LAS bf16_t*)(Bf + (d0 + e) * PB + j * 2) = (bf16_t)(cvt_pk(kv[e] * wf, 0.f) & 0xffffu); *(LAS bf16_t*)(Bb + (d0 + e) * PB + j * 2) = (bf16_t)(cvt_pk(kv[e] * wb, 0.f) & 0xffffu); } } }
    __syncthreads();
    f32x16 af[2], ab[2]; af[0] = (f32x16)(0.f); af[1] = (f32x16)(0.f); ab[0] = (f32x16)(0.f); ab[1] = (f32x16)(0.f);
    mma128(As, Bf, af, wr, wc, lane); mma128(As, Bb, ab, wr, wc, lane);
    float* st = WSP(float, O_ST) + ((size_t)(n * 8 + hd) * 2) * 16384;
    { const int hi = lane >> 5, cb = 64 * wc + (lane & 31);
#pragma unroll
      for (int t = 0; t < 2; ++t)
#pragma unroll
        for (int r = 0; r < 16; ++r) { const int e = 32 * wr + crow(r, hi); st[e * 128 + cb + 32 * t] = af[t][r]; st[16384 + e * 128 + cb + 32 * t] = ab[t][r]; } }
    __syncthreads();
}

__device__ __forceinline__ void retout_item(const Ctx& X, LAS unsigned char* lds, int l, int item) {
    int tid_ = X.tid; asm volatile("" : "+v"(tid_));
    const int tid = tid_, lane = tid & 63, wave = tid >> 6, wr = wave >> 1, wc = wave & 1;
    const int n = item >> 3, hd = item & 7, tok0 = n * 128;
    const bool smp = n >= 32; const int nc = smp ? 16 : 2, jc = smp ? ((n - 32) & 15) : (n & 1), n0 = n - jc, bs = smp ? (n - 32) >> 4 : n >> 1;
    LAS unsigned char* B0 = lds; LAS unsigned char* B1 = lds + BUFB; LAS unsigned char* B2 = lds + 2 * BUFB; LAS unsigned char* B3 = lds + 3 * BUFB;
    const float lnf = log_sigmoid_f(X.in[19][(l * 2 + 0) * 8 + hd]), lnb = log_sigmoid_f(X.in[19][(l * 2 + 1) * 8 + hd]);
    const float lgf = lnf * 1.4426950408889634f, lgb = lnb * 1.4426950408889634f, gcf = exp2f(128.f * lgf), gcb = exp2f(128.f * lgb);
    const bf16_t* z = WSP(bf16_t, O_Z);
    stage_tile(B0, z + (size_t)tok0 * ZW + Z_RQ + hd * 128, ZW, tid);
    stage_tile(B1, z + (size_t)tok0 * ZW + Z_RK + hd * 128, ZW, tid);
    stage_tile(B3, WSP(bf16_t, O_RVT) + (size_t)(hd * 128) * T + tok0, T, tid);
    __syncthreads();
    const int hi = lane >> 5, cb = 64 * wc + (lane & 31);
    { f32x16 aw[2]; aw[0] = (f32x16)(0.f); aw[1] = (f32x16)(0.f);
      mma128(B0, B1, aw, wr, wc, lane);
#pragma unroll
      for (int t = 0; t < 2; ++t)
#pragma unroll
        for (int r = 0; r < 16; ++r) { const int i = 32 * wr + crow(r, hi), j = cb + 32 * t; const float dd = (float)(i - j);
            const float dec = (i >= j) ? exp2f(lgf * dd) : exp2f(-lgb * dd);
            *(LAS bf16_t*)(B2 + i * PB + j * 2) = (bf16_t)(cvt_pk(aw[t][r] * dec, 0.f) & 0xffffu); } }
    __syncthreads();
    const int e_ = tid >> 2, dseg = (tid & 3) * 32;
    const float* stb = WSP(float, O_ST);
    f32x4 R[8];
    if (smp) { const float* s0 = X.in[4] + ((((size_t)bs * NL + l) * 2 + 0) * 8 + hd) * 16384;
#pragma unroll
        for (int q = 0; q < 8; ++q)
#pragma unroll
            for (int k = 0; k < 4; ++k) R[q][k] = s0[(size_t)(dseg + q * 4 + k) * 128 + e_]; }
    else {
#pragma unroll
        for (int q = 0; q < 8; ++q) R[q] = (f32x4){0.f, 0.f, 0.f, 0.f}; }
#pragma unroll 1
    for (int jj = 0; jj < jc; ++jj) { const float* sp = stb + ((size_t)((n0 + jj) * 8 + hd) * 2 + 0) * 16384 + e_ * 128 + dseg;
#pragma unroll
        for (int q = 0; q < 8; ++q) R[q] = R[q] * gcf + *(const f32x4*)(sp + q * 4); }
#pragma unroll
    for (int q = 0; q < 4; ++q) { u32x4 o; o.x = cvt_pk(R[2 * q][0], R[2 * q][1]); o.y = cvt_pk(R[2 * q][2], R[2 * q][3]); o.z = cvt_pk(R[2 * q + 1][0], R[2 * q + 1][1]); o.w = cvt_pk(R[2 * q + 1][2], R[2 * q + 1][3]);
        *(LAS u32x4*)(B1 + e_ * PB + (dseg + q * 8) * 2) = o; }
    if (!smp && jc == 1) {
        const float* sp = stb + ((size_t)(n * 8 + hd) * 2 + 0) * 16384 + e_ * 128 + dseg; float* o = X.out + OUT_RET + ((((size_t)bs * NL + l) * 2 + 0) * 8 + hd) * 16384;
#pragma unroll
        for (int q = 0; q < 8; ++q) { const f32x4 f = R[q] * gcf + *(const f32x4*)(sp + q * 4);
#pragma unroll
            for (int k = 0; k < 4; ++k) o[(size_t)(dseg + q * 4 + k) * 128 + e_] = f[k]; } }
    f32x16 ao[2]; ao[0] = (f32x16)(0.f); ao[1] = (f32x16)(0.f);
    mma128(B2, B3, ao, wr, wc, lane);
    __syncthreads();
    f32x16 ac[2]; ac[0] = (f32x16)(0.f); ac[1] = (f32x16)(0.f);
    mma128(B0, B1, ac, wr, wc, lane);
#pragma unroll
    for (int t = 0; t < 2; ++t)
#pragma unroll
        for (int r = 0; r < 16; ++r) { const int i = 32 * wr + crow(r, hi); ao[t][r] += ac[t][r] * exp2f(lgf * (float)(i + 1)); }
    if (smp) { const float* s0 = X.in[4] + ((((size_t)bs * NL + l) * 2 + 1) * 8 + hd) * 16384;
#pragma unroll
        for (int q = 0; q < 8; ++q)
#pragma unroll
            for (int k = 0; k < 4; ++k) R[q][k] = s0[(size_t)(dseg + q * 4 + k) * 128 + e_]; }
    else {
#pragma unroll
        for (int q = 0; q < 8; ++q) R[q] = (f32x4){0.f, 0.f, 0.f, 0.f}; }
#pragma unroll 1
    for (int jj = nc - 1; jj > jc; --jj) { const float* sp = stb + ((size_t)((n0 + jj) * 8 + hd) * 2 + 1) * 16384 + e_ * 128 + dseg;
#pragma unroll
        for (int q = 0; q < 8; ++q) R[q] = R[q] * gcb + *(const f32x4*)(sp + q * 4); }
#pragma unroll
    for (int q = 0; q < 4; ++q) { u32x4 o; o.x = cvt_pk(R[2 * q][0], R[2 * q][1]); o.y = cvt_pk(R[2 * q][2], R[2 * q][3]); o.z = cvt_pk(R[2 * q + 1][0], R[2 * q + 1][1]); o.w = cvt_pk(R[2 * q + 1][2], R[2 * q + 1][3]);
        *(LAS u32x4*)(B3 + e_ * PB + (dseg + q * 8) * 2) = o; }
    if (!smp && jc == 0) {
        const float* sp = stb + ((size_t)(n * 8 + hd) * 2 + 1) * 16384 + e_ * 128 + dseg; float* o = X.out + OUT_RET + ((((size_t)bs * NL + l) * 2 + 1) * 8 + hd) * 16384;
#pragma unroll
        for (int q = 0; q < 8; ++q) { const f32x4 f = R[q] * gcb + *(const f32x4*)(sp + q * 4);
#pragma unroll
            for (int k = 0; k < 4; ++k) o[(size_t)(dseg + q * 4 + k) * 128 + e_] = f[k]; } }
    __syncthreads();
    ac[0] = (f32x16)(0.f); ac[1] = (f32x16)(0.f);
    mma128(B0, B3, ac, wr, wc, lane);
    LAS float* Os = (LAS float*)(lds + BUFB);
#pragma unroll
    for (int t = 0; t < 2; ++t)
#pragma unroll
        for (int r = 0; r < 16; ++r) { const int i = 32 * wr + crow(r, hi); Os[i * PO + cb + 32 * t] = ao[t][r] + ac[t][r] * exp2f(lgb * (float)(128 - i)); }
    __syncthreads();
    { const int p = tid >> 2, cseg = (tid & 3) * 32; f32x4 v[8]; float s = 0.f;
#pragma unroll
      for (int q = 0; q < 8; ++q) { v[q] = *(const LAS f32x4*)(Os + p * PO + cseg + q * 4); s += v[q][0] + v[q][1] + v[q][2] + v[q][3]; }
      s += __shfl_xor(s, 1); s += __shfl_xor(s, 2); const float mu = s * (1.f / 128.f); float s2 = 0.f;
#pragma unroll
      for (int q = 0; q < 8; ++q) { v[q] = v[q] - mu; s2 += v[q][0] * v[q][0] + v[q][1] * v[q][1] + v[q][2] * v[q][2] + v[q][3] * v[q][3]; }
      s2 += __shfl_xor(s2, 1); s2 += __shfl_xor(s2, 2); const float rs = rsqrtf(s2 * (1.f / 128.f) + EPSN);
      const bf16_t* gp = z + (size_t)(tok0 + p) * ZW + Z_GPR + hd * 128 + cseg; const float* gr = X.in[20] + l * 1024 + hd * 128 + cseg;
      bf16_t* op = WSP(bf16_t, O_AR) + (size_t)(tok0 + p) * 1024 + hd * 128 + cseg;
#pragma unroll
      for (int q = 0; q < 4; ++q) { const u32x4 gg = *(const u32x4*)(gp + q * 8); const f32x4 g0 = *(const f32x4*)(gr + q * 8), g1 = *(const f32x4*)(gr + q * 8 + 4); const f32x4 a = v[2 * q] * rs * g0, b = v[2 * q + 1] * rs * g1;
          u32x4 o; o.x = cvt_pk(a[0] * bflo(gg.x), a[1] * bfhi(gg.x)); o.y = cvt_pk(a[2] * bflo(gg.y), a[3] * bfhi(gg.y)); o.z = cvt_pk(b[0] * bflo(gg.z), b[1] * bfhi(gg.z)); o.w = cvt_pk(b[2] * bflo(gg.w), b[3] * bfhi(gg.w));
          *(u32x4*)(op + q * 8) = o; } }
    __syncthreads();
}
constexpr int KPB = 400;
constexpr int VPB = 144;
constexpr int ATT_KB = 64 * KPB;
constexpr int ATT_BUF = ATT_KB + 128 * VPB;
__device__ __forceinline__ void attn_unit(const Ctx& X, LAS unsigned char* lds, int l, int unit) {
    int tid_ = X.tid; asm volatile("" : "+v"(tid_));
    const int tid = tid_, lane = tid & 63, wave = tid >> 6, qi = lane & 15, g = lane >> 4;
    int tokb, ncache, nnew, hd, qb, bc = 0;
    if (unit < 256) { bc = unit >> 7; hd = (unit >> 4) & 7; qb = unit & 15; tokb = 4096 + bc * 2048; ncache = 256; nnew = 2048; }
    else { const int r = unit - 256; const int s = r >> 4; hd = (r >> 1) & 7; qb = r & 1; tokb = s * 256; ncache = 0; nnew = 256; }
    const int nct = ncache >> 6, ntile = (ncache + nnew) >> 6;
    const bf16_t* KN = WSP(bf16_t, O_KN); const bf16_t* KR = WSP(bf16_t, O_KR); const bf16_t* VT = WSP(bf16_t, O_VT);
    const bf16_t* KC = WSP(bf16_t, O_KC) + (size_t)l * 512 * 1024; const bf16_t* KRC = WSP(bf16_t, O_KRC) + (size_t)l * 512 * 64; const bf16_t* VTC = WSP(bf16_t, O_VTC) + (size_t)l * 1024 * 512;
    const int tokq = tokb + qb * 128 + wave * 16 + qi;
    bf16x8 qf[6];
    { const bf16_t* qp = WSP(bf16_t, O_Q) + (size_t)tokq * 1536 + hd * 192 + g * 8;
#pragma unroll
      for (int s = 0; s < 6; ++s) qf[s] = *(const bf16x8*)(qp + s * 32); }
    u32x4 sk[2], sr, sv[2];
#define ATT_LOAD(j) do { const int _j = (j); const bf16_t *kn_, *kr_, *vt_; size_t ldv_; \
        if (_j < nct) { const int r0 = bc * 256 + _j * 64; kn_ = KC + (size_t)r0 * 1024 + hd * 128; kr_ = KRC + (size_t)r0 * 64; vt_ = VTC + (size_t)(hd * 128) * 512 + r0; ldv_ = 512; } \
        else { const int r0 = tokb + (_j - nct) * 64; kn_ = KN + (size_t)r0 * 1024 + hd * 128; kr_ = KR + (size_t)r0 * 64; vt_ = VT + (size_t)(hd * 128) * T + r0; ldv_ = T; } \
        _Pragma("unroll") for (int i = 0; i < 2; ++i) { const int c = tid + i * NTHREADS; sk[i] = *(const u32x4*)(kn_ + (size_t)(c >> 4) * 1024 + (c & 15) * 8); sv[i] = *(const u32x4*)(vt_ + (size_t)(c >> 3) * ldv_ + (c & 7) * 8); } \
        sr = *(const u32x4*)(kr_ + (size_t)(tid >> 3) * 64 + (tid & 7) * 8); } while (0)
#define ATT_STORE(buf) do { LAS unsigned char* kb_ = lds + (buf) * ATT_BUF; LAS unsigned char* vb_ = kb_ + ATT_KB; \
        _Pragma("unroll") for (int i = 0; i < 2; ++i) { const int c = tid + i * NTHREADS; *(LAS u32x4*)(kb_ + (c >> 4) * KPB + (c & 15) * 16) = sk[i]; *(LAS u32x4*)(vb_ + (c >> 3) * VPB + (c & 7) * 16) = sv[i]; } \
        *(LAS u32x4*)(kb_ + (tid >> 3) * KPB + 256 + (tid & 7) * 16) = sr; } while (0)
    f32x4 O[8];
#pragma unroll
    for (int u = 0; u < 8; ++u) O[u] = (f32x4){0.f, 0.f, 0.f, 0.f};
    float mrun = -INFINITY, lrun = 0.f;
    ATT_LOAD(0); ATT_STORE(0);
    __syncthreads();
    for (int j = 0; j < ntile; ++j) {
        const int buf = j & 1;
        if (j + 1 < ntile) ATT_LOAD(j + 1);
        const LAS unsigned char* kb = lds + buf * ATT_BUF; const LAS unsigned char* vb = kb + ATT_KB;
        f32x4 S[4];
#pragma unroll
        for (int t = 0; t < 4; ++t) { S[t] = (f32x4){0.f, 0.f, 0.f, 0.f};
#pragma unroll
            for (int s = 0; s < 6; ++s) { const bf16x8 a = *(const LAS bf16x8*)(kb + (16 * t + qi) * KPB + (32 * s + 8 * g) * 2);
                S[t] = __builtin_amdgcn_mfma_f32_16x16x32_bf16(a, qf[s], S[t], 0, 0, 0); } }
        float mx = S[0][0];
#pragma unroll
        for (int t = 0; t < 4; ++t)
#pragma unroll
            for (int i = 0; i < 4; ++i) mx = fmaxf(mx, S[t][i]);
        mx = fmaxf(mx, __shfl_xor(mx, 16)); mx = fmaxf(mx, __shfl_xor(mx, 32));
        const float mnew = fmaxf(mrun, mx), alpha = exp2f(mrun - mnew); mrun = mnew;
        float ps = 0.f;
#pragma unroll
        for (int t = 0; t < 4; ++t)
#pragma unroll
            for (int i = 0; i < 4; ++i) { S[t][i] = exp2f(S[t][i] - mnew); ps += S[t][i]; }
        ps += __shfl_xor(ps, 16); ps += __shfl_xor(ps, 32);
        lrun = lrun * alpha + ps;
#pragma unroll
        for (int u = 0; u < 8; ++u) O[u] = O[u] * alpha;
#pragma unroll
        for (int c = 0; c < 2; ++c) {
            u32x4 pw; pw.x = cvt_pk(S[2 * c][0], S[2 * c][1]); pw.y = cvt_pk(S[2 * c][2], S[2 * c][3]); pw.z = cvt_pk(S[2 * c + 1][0], S[2 * c + 1][1]); pw.w = cvt_pk(S[2 * c + 1][2], S[2 * c + 1][3]);
            const bf16x8 pb = __builtin_bit_cast(bf16x8, pw);
#pragma unroll
            for (int u = 0; u < 8; ++u) { const LAS unsigned char* vp = vb + (16 * u + qi) * VPB + (32 * c + 4 * g) * 2;
                const u32x2 lo = *(const LAS u32x2*)vp, hi2 = *(const LAS u32x2*)(vp + 32);
                u32x4 aw; aw.x = lo.x; aw.y = lo.y; aw.z = hi2.x; aw.w = hi2.y;
                O[u] = __builtin_amdgcn_mfma_f32_16x16x32_bf16(__builtin_bit_cast(bf16x8, aw), pb, O[u], 0, 0, 0); } }
        if (j + 1 < ntile) ATT_STORE(buf ^ 1);
        __syncthreads();
    }
    { const float il = 1.f / lrun; const bf16_t* gp = WSP(bf16_t, O_Z) + (size_t)tokq * ZW + Z_GPM + hd * 128 + 4 * g; bf16_t* op = WSP(bf16_t, O_AM) + (size_t)tokq * 1024 + hd * 128 + 4 * g;
#pragma unroll
      for (int u = 0; u < 8; ++u) { const u32x2 gg = *(const u32x2*)(gp + 16 * u); u32x2 o;
          o.x = cvt_pk(O[u][0] * il * bflo(gg.x), O[u][1] * il * bfhi(gg.x)); o.y = cvt_pk(O[u][2] * il * bflo(gg.y), O[u][3] * il * bfhi(gg.y));
          *(u32x2*)(op + 16 * u) = o; } }
#undef ATT_LOAD
#undef ATT_STORE
}
constexpr int NPHASE = 2 + 6 * NL;
#define REOPAQUE(X) do { unsigned long long w_ = (unsigned long long)args.ws, o_ = (unsigned long long)args.out, i_ = (unsigned long long)__builtin_amdgcn_kernarg_segment_ptr(); int t_ = threadIdx.x, c_ = blockIdx.x, g_ = gridDim.x; \
    asm volatile("" : "+s"(w_), "+s"(o_), "+s"(i_), "+v"(t_), "+s"(c_), "+s"(g_)); X.ws = (unsigned char*)w_; X.out = (float*)o_; X.in.p = (CPtr64)i_; X.tid = t_; X.c = c_; X.G = g_; } while (0)
#ifndef RPTM
#define RPTM 0
#endif
#define NREP(k) ((((RPTM) >> (k)) & 1) + 1)
#ifndef PHM
#define PHM 0xffff
#endif
__global__ void __launch_bounds__(NTHREADS, 2) mk_fwd(Args args) {
    extern __shared__ __attribute__((aligned(16))) unsigned char lds_raw[];
    LAS unsigned char* lds = (LAS unsigned char*)lds_raw;
    cg::grid_group grid = cg::this_grid();
    volatile LAS unsigned* bst = (volatile LAS unsigned*)(lds + LDS_BYTES - 64);
    if (threadIdx.x < 16) bst[threadIdx.x] = 0u;
    __syncthreads();
    XcdBarrier xbar = xcd_barrier_post((unsigned*)(args.ws + O_BAR), bst);
    for (int ph = args.ph_lo; ph < args.ph_hi; ++ph) {
        Ctx X; REOPAQUE(X);
        const int tid = X.tid;
        const char* ws = (const char*)X.ws;
        if (ph == 0) { for (int rep = 0; rep < NREP(0); ++rep) if (PHM & 1) phase_prologue(X, lds); }
        else if (ph == 1) { for (int rep = 0; rep < NREP(1); ++rep) {
            SchedC S{ws + O_CKVC, ws + O_WKP, ws + O_WVP, X.G, X.c}; EpiC E{WSP(bf16_t, O_KC), WSP(bf16_t, O_VTC)};
            if (PHM & 2) pg8::gemm_phase(lds, tid, 512, 512, 512, S, E);
            REOPAQUE(X); if (PHM & 4) phase_rows(X, 0, false, 0); }
        } else {
            const int l = (ph - 2) / 6, sp = (ph - 2) % 6;
            if (sp == 0) { for (int rep = 0; rep < NREP(2); ++rep) {
                SchedZ S{ws + O_H, ws + O_WIN + (size_t)l * ZW * 2048 * 2, X.G, X.c}; EpiZ E{WSP(bf16_t, O_Z), WSP(bf16_t, O_VST), WSP(bf16_t, O_RVT), WSP(float, O_RSS), rep == 0};
                if (PHM & 8) pg8::gemm_phase(lds, tid, 2048, 2048, 2048, S, E); }
            } else if (sp == 1) { for (int rep = 0; rep < NREP(3); ++rep) {
                { SchedQK S{ws + O_Z, ws + O_WUQ + (size_t)l * 1536 * 512 * 2, ws + O_WKG + (size_t)l * 1024 * 512 * 2, X.G, X.c}; EpiQK E{WSP(bf16_t, O_Q), WSP(bf16_t, O_KN), WSP(float, O_RSS), WSP(float, O_ROPE)};
                  if (PHM & 16) pg8::gemm_phase(lds, tid, 512, ZW, 512, S, E); }
                { SchedVT S{ws + O_Z, ws + O_WVG + (size_t)l * 1024 * 512 * 2, X.G, X.c}; EpiVT E{WSP(bf16_t, O_VT), WSP(float, O_RSS)};
                  if (PHM & 32) pg8::gemm_phase(lds, tid, 512, 512, ZW, S, E); }
                REOPAQUE(X); if (PHM & 64) phase_misc(X, l);
                REOPAQUE(X);
                for (int it = X.G - 1 - X.c; it < 512; it += X.G) if (PHM & 128) sgu_item(X, lds, l, it);
                REOPAQUE(X);
                for (int it = X.G - 1 - X.c; it < 512; it += X.G) if (PHM & 256) retstate_item(X, lds, l, it); }
            } else if (sp == 2) { for (int rep = 0; rep < NREP(4); ++rep) {
                for (int i = X.c * NTHREADS + tid; i < T; i += X.G * NTHREADS) WSP(float, O_RSS)[3 * T + i] = 0.f;
                for (int it = X.c; it < 512; it += X.G) if (PHM & 512) attn_unit(X, lds, l, it);
                REOPAQUE(X);
                for (int it = X.c; it < 512; it += X.G) if (PHM & 1024) retout_item(X, lds, l, (it < 256) ? 256 + it : it - 256); }
            } else if (sp == 3) { for (int rep = 0; rep < NREP(5); ++rep) {
                SchedBr S{ws + O_AM, ws + O_AS, ws + O_AR, ws + O_WBR + (size_t)l * 3 * 2048 * 1024 * 2, X.G, X.c}; EpiBr E{WSP(bf16_t, O_Z), WSP(bf16_t, O_YMB)};
                if (PHM & 2048) pg8::gemm_phase(lds, tid, 1024, 1024, 1024, S, E); }
            } else if (sp == 4) { for (int rep = 0; rep < NREP(6); ++rep) {
                for (int i = X.c * NTHREADS + tid; i < 3 * T; i += X.G * NTHREADS) WSP(float, O_RSS)[i] = 0.f;
                SchedOut S{ws + O_YMB, ws + O_WOUT + (size_t)l * 2048 * 2048 * 2, X.G, X.c}; EpiOut E{WSP(float, O_Y), WSP(float, O_RSS), rep == 0};
                if (PHM & 4096) pg8::gemm_phase(lds, tid, 2048, 2048, 2048, S, E); }
            } else {
                if (PHM & 8192) phase_rows(X, l, true, l + 1);
            }
        }
        if (ph + 1 < args.ph_hi) { if (ph == 0) { __syncthreads(); grid.sync(); } else xcd_barrier(xbar); }
    }
}

extern "C" void kernel_launch(void* const* d_in, const int* in_sizes, int n_in, void* d_out, int out_size, void* d_ws, size_t ws_size, hipStream_t stream) {
    static int grid = 0;
    if (grid == 0) {
        if (n_in != 25 || ws_size < WS_END) { fprintf(stderr, "kernel_launch: unexpected n_in %d / ws %zu (need %zu)\n", n_in, ws_size, (size_t)WS_END); grid = -1; return; }
        int dev = 0, cus = 0, per_cu = 0;
        (void)hipGetDevice(&dev); (void)hipDeviceGetAttribute(&cus, hipDeviceAttributeMultiprocessorCount, dev);
        (void)hipFuncSetAttribute((const void*)mk_fwd, hipFuncAttributeMaxDynamicSharedMemorySize, LDS_BYTES);
        (void)hipOccupancyMaxActiveBlocksPerMultiprocessor(&per_cu, (const void*)mk_fwd, NTHREADS, LDS_BYTES);
        if (per_cu < 1) { fprintf(stderr, "kernel_launch: occupancy query says %d blocks per CU\n", per_cu); per_cu = 1; }
        grid = cus * per_cu;
    }
    if (grid < 0) return;
    Args a{};
    for (int i = 0; i < 25; ++i) a.in[i] = (const float*)d_in[i];
    a.out = (float*)d_out; a.ws = (unsigned char*)d_ws;
#if MK_MULTI
    for (int ph = 0; ph < NPHASE; ++ph) { a.ph_lo = ph; a.ph_hi = ph + 1; hipLaunchKernelGGL(mk_fwd, dim3(grid), dim3(NTHREADS), LDS_BYTES, stream, a); }
#else
    a.ph_lo = 0; a.ph_hi = NPHASE;
    (void)hipMemsetAsync((unsigned char*)d_ws + O_BAR, 0, 16384, stream);
    void* kargs[] = {&a};
    hipError_t e = hipLaunchCooperativeKernel((const void*)mk_fwd, dim3(grid), dim3(NTHREADS), kargs, LDS_BYTES, stream);
    if (e != hipSuccess) fprintf(stderr, "cooperative launch failed: %s (grid %d)\n", hipGetErrorString(e), grid);
#endif
}
```

```cpp
#define MK_MULTI 0
#define RPTM 0
#include <hip/hip_runtime.h>
#include <hip/hip_cooperative_groups.h>
#include <cstdio>
namespace cg = cooperative_groups;

#define LAS __attribute__((address_space(3)))
#define GAS __attribute__((address_space(1)))
typedef unsigned short bf16_t;
typedef short bf16x8 __attribute__((ext_vector_type(8)));
typedef float f32x4 __attribute__((ext_vector_type(4)));
typedef float f32x16 __attribute__((ext_vector_type(16)));
typedef unsigned u32x4 __attribute__((ext_vector_type(4)));
typedef unsigned u32x2 __attribute__((ext_vector_type(2)));

constexpr int NTHREADS = 512;
constexpr int LDS_BYTES = 147456;
constexpr int T = 8192, DM = 2048, ZW = 15616, NL = 4, INC = 15424;
constexpr float EPSN = 1e-6f;
constexpr int Z_CQ = 0, Z_CKV = 512, Z_GPM = 1024, Z_U = 2048, Z_VS = 3072, Z_GPS = 4096, Z_RQ = 5120, Z_RK = 6144, Z_RV = 7168, Z_GPR = 8192, Z_MRG = 9216, Z_KR = 15360;
constexpr size_t OUT_YP = 0, OUT_YS = 8388608, OUT_CKV = 16777216, OUT_KR = 25165824, OUT_RET = 26214400;

constexpr size_t O_WIN = 0,                         S_WIN = (size_t)NL * ZW * 2048 * 2;
constexpr size_t O_WUQ = O_WIN + S_WIN,             S_WUQ = (size_t)NL * 1536 * 512 * 2;
constexpr size_t O_WKG = O_WUQ + S_WUQ,             S_WK = (size_t)NL * 1024 * 512 * 2;
constexpr size_t O_WVG = O_WKG + S_WK;
constexpr size_t O_WKP = O_WVG + S_WK;
constexpr size_t O_WVP = O_WKP + S_WK;
constexpr size_t O_WBR = O_WVP + S_WK,              S_WBR = (size_t)NL * 3 * 2048 * 1024 * 2;
constexpr size_t O_WOUT = O_WBR + S_WBR,            S_WOUT = (size_t)NL * 2048 * 2048 * 2;
constexpr size_t O_CKVC = O_WOUT + S_WOUT,          S_CKVC = (size_t)NL * 512 * 512 * 2;
constexpr size_t O_KRC = O_CKVC + S_CKVC,           S_KRC = (size_t)NL * 512 * 64 * 2;
constexpr size_t O_KC = O_KRC + S_KRC,              S_KC = (size_t)NL * 512 * 1024 * 2;
constexpr size_t O_VTC = O_KC + S_KC;
constexpr size_t O_MOD = O_VTC + S_KC,              S_MOD = (size_t)NL * 3 * 6144 * 4;
constexpr size_t O_ROPE = O_MOD + S_MOD,            S_ROPE = 64 * 16 * 8;
constexpr size_t O_RSS = O_ROPE + S_ROPE,           S_RSS = (size_t)4 * T * 4;
constexpr size_t O_H = O_RSS + S_RSS,               S_H = (size_t)T * DM * 2;
constexpr size_t O_X = O_H + S_H,                   S_X = (size_t)T * DM * 4;
constexpr size_t O_Z = O_X + S_X,                   S_Z = (size_t)T * ZW * 2;
constexpr size_t O_VST = O_Z + S_Z,                 S_T16 = (size_t)1024 * T * 2;
constexpr size_t O_RVT = O_VST + S_T16;
constexpr size_t O_VT = O_RVT + S_T16;
constexpr size_t O_KN = O_VT + S_T16;
constexpr size_t O_AM = O_KN + S_T16;
constexpr size_t O_AS = O_AM + S_T16;
constexpr size_t O_AR = O_AS + S_T16;
constexpr size_t O_Q = O_AR + S_T16,                S_Q = (size_t)T * 1536 * 2;
constexpr size_t O_KR = O_Q + S_Q,                  S_KR = (size_t)T * 64 * 2;
constexpr size_t O_ST = O_KR + S_KR,                S_ST = (size_t)64 * 8 * 2 * 16384 * 4;
constexpr size_t O_YMF = O_ST + S_ST;
constexpr size_t O_YMB = O_YMF + S_X;
constexpr size_t O_Y = O_YMB + S_H;
constexpr size_t O_BAR = O_Y + S_X;
constexpr size_t WS_END = O_BAR + 16384;

struct Args { const float* in[25]; float* out; unsigned char* ws; int ph_lo, ph_hi; };

__device__ __forceinline__ unsigned cvt_pk(float lo, float hi) { unsigned r; asm volatile("v_cvt_pk_bf16_f32 %0, %1, %2" : "=v"(r) : "v"(lo), "v"(hi)); return r; }
__device__ __forceinline__ float bf2f(unsigned short b) { return __uint_as_float(((unsigned)b) << 16); }
__device__ __forceinline__ float bflo(unsigned w) { return __uint_as_float(w << 16); }
__device__ __forceinline__ float bfhi(unsigned w) { return __uint_as_float(w & 0xffff0000u); }
__device__ __forceinline__ float sigm_f(float x) { return __builtin_amdgcn_rcpf(1.f + __builtin_amdgcn_exp2f(x * -1.4426950408889634f)); }
__device__ __forceinline__ float silu_f(float x) { return x * sigm_f(x); }
__device__ __forceinline__ float wave_sum(float v) {
#pragma unroll
    for (int o = 1; o < 64; o <<= 1) v += __shfl_xor(v, o);
    return v;
}

namespace pg8 {
constexpr int BM = 256, BK = 64, HALF = 128, HTB = HALF * BK * 2, STAGE_BYTES = 8 * HTB, NXCD = 8, WGM = 8;
__host__ __device__ __forceinline__ int lds_byte(int r, int c) { const int st = (r >> 4) * 2 + (c >> 5), rr = r & 15, cc = c & 31, ob = rr * 64 + cc * 2; return st * 1024 + (ob ^ (((ob >> 9) & 1) << 5)); }
__host__ __device__ __forceinline__ void stage_rc(int b, int& R, int& C) { const int st = b / 1024, sb = b % 1024, swz = sb ^ (((sb >> 9) & 1) << 5); R = (st >> 1) * 16 + swz / 64; C = (st & 1) * 32 + (swz % 64) / 2; }
__host__ __device__ __forceinline__ int perm32(int rho) { const int n = rho >> 4, i = rho & 15; return 8 * (i >> 2) + 4 * n + (i & 3); }

struct Unit { const char* a; const char* b; int pm, pn, kind, aux; };

__device__ __forceinline__ void tile_order(int L, int nM, int nN, int& pm, int& pn) {
    const int nwg = nM * nN; int wgid = L; { const int q = nwg / NXCD, r = nwg % NXCD, xcd = wgid % NXCD, off = wgid / NXCD; wgid = (xcd < r ? xcd * (q + 1) : r * (q + 1) + (xcd - r) * q) + off; }
    const int nig = WGM * nN, gid = wgid / nig, fm = gid * WGM, gsz = (nM - fm) < WGM ? (nM - fm) : WGM;
    pm = fm + ((wgid % nig) % gsz); pn = (wgid % nig) / gsz;
}

template <class Epi, class Sched>
__device__ __forceinline__ void gemm_phase(LAS unsigned char* lds, const int tid, const int K, const int lda, const int ldb, const Sched& S, const Epi& E) {
    const int  wid = __builtin_amdgcn_readfirstlane(tid >> 6), lane = tid & 63, wr = wid >> 2, wc = wid & 3, fr = lane & 15, fq = lane >> 4;
    const int nt = K / BK;
    unsigned voffA[2], voffB[2];
#pragma unroll
    for (int i = 0; i < 2; ++i) { int R, C; stage_rc(tid * 16 + i * 8192, R, C); const int Rb = (R & ~31) + perm32(R & 31);
        voffA[i] = (unsigned)(R * lda + C) * 2u; voffB[i] = (unsigned)(Rb * ldb + C) * 2u; }
    const size_t kstep = (size_t)(BK * 2);
    const size_t hstepA = (size_t)HALF * lda * 2, hstepB = (size_t)HALF * ldb * 2;
    const unsigned ldsw = (unsigned)wid * 1024u;
    const int aoff = lds_byte(wr * 64 + fr, fq * 8), boff = lds_byte(wc * 32 + fr, fq * 8);
#define PG8_SA(b, h) (((b) * 2 + (h)) * HTB)
#define PG8_SB(b, h) ((4 + (b) * 2 + (h)) * HTB)
#define PG8_STAGE(bufoff, gbase, voff) do { _Pragma("unroll") for (int _i = 0; _i < 2; ++_i) \
        __builtin_amdgcn_global_load_lds((const unsigned*)((const char*)(gbase) + (voff)[_i]), (LAS unsigned*)(lds + (bufoff) + ldsw + _i * 8192), 16, 0, 0); } while (0)
#define PG8_LDA(dst, b, h) do { _Pragma("unroll") for (int m = 0; m < 4; ++m) _Pragma("unroll") for (int k = 0; k < 2; ++k) dst[m][k] = *(const LAS bf16x8*)(lds + PG8_SA(b, h) + aoff + m * 2048 + k * 1024); } while (0)
#define PG8_LDB(dst, b, h) do { _Pragma("unroll") for (int n = 0; n < 2; ++n) _Pragma("unroll") for (int k = 0; k < 2; ++k) dst[n][k] = *(const LAS bf16x8*)(lds + PG8_SB(b, h) + boff + n * 2048 + k * 1024); } while (0)
#define PG8_MMA(ai, bj, At, Bt) do { __builtin_amdgcn_s_setprio(1); _Pragma("unroll") for (int m = 0; m < 4; ++m) _Pragma("unroll") for (int n = 0; n < 2; ++n) _Pragma("unroll") for (int k = 0; k < 2; ++k) \
        acc[ai][bj][m][n] = __builtin_amdgcn_mfma_f32_16x16x32_bf16(Bt[n][k], At[m][k], acc[ai][bj][m][n], 0, 0, 0); __builtin_amdgcn_s_setprio(0); } while (0)
#define PG8_WAIT_V(n) asm volatile("s_waitcnt vmcnt(" #n ")" ::: "memory")
#define PG8_WAIT_L(n) asm volatile("s_waitcnt lgkmcnt(" #n ")" ::: "memory")
#define PG8_BAR __builtin_amdgcn_s_barrier()
#define PG8_SCHED __builtin_amdgcn_sched_barrier(0)
    Unit cur, nxt; int ui = 0;
    if (!S.next(0, cur)) return;
    f32x4 acc[2][2][4][2];
#pragma unroll
    for (int a = 0; a < 2; ++a)
#pragma unroll
        for (int b = 0; b < 2; ++b)
#pragma unroll
            for (int m = 0; m < 4; ++m)
#pragma unroll
                for (int n = 0; n < 2; ++n) acc[a][b][m][n] = (f32x4){0.f, 0.f, 0.f, 0.f};
    bf16x8 At[4][2], B0[2][2], B1[2][2];
    const char* cA = cur.a; const char* cB = cur.b;
    PG8_STAGE(PG8_SB(0, 0), cB, voffB); PG8_STAGE(PG8_SA(0, 0), cA, voffA); PG8_STAGE(PG8_SB(0, 1), cB + hstepB, voffB); PG8_STAGE(PG8_SA(0, 1), cA + hstepA, voffA);
    if (wr == 1) PG8_BAR;
    PG8_WAIT_V(4); PG8_BAR;
    PG8_STAGE(PG8_SB(1, 0), cB + kstep, voffB); PG8_STAGE(PG8_SA(1, 0), cA + kstep, voffA); PG8_STAGE(PG8_SB(1, 1), cB + hstepB + kstep, voffB);
    PG8_WAIT_V(6); PG8_BAR;
    for (;;) {
        const bool has_next = S.next(ui + 1, nxt);
        const char* nA = has_next ? nxt.a : cA; const char* nB = has_next ? nxt.b : cB;
        for (int t = 0; t < nt; t += 2) {
            const bool last = (t == nt - 2);
            const char* a1 = cA + (size_t)(t + 1) * kstep;
            const char* a2 = last ? nA : cA + (size_t)(t + 2) * kstep; const char* b2 = last ? nB : cB + (size_t)(t + 2) * kstep;
            const char* a3 = a2 + kstep; const char* b3 = b2 + kstep;
            PG8_LDB(B0, 0, 0); PG8_SCHED; PG8_LDA(At, 0, 0); PG8_STAGE(PG8_SA(1, 1), a1 + hstepA, voffA);
            PG8_WAIT_L(8); PG8_BAR; PG8_WAIT_L(0); PG8_MMA(0, 0, At, B0); PG8_BAR; PG8_SCHED;
            PG8_LDB(B1, 0, 1); PG8_STAGE(PG8_SB(0, 0), b2, voffB);
            PG8_BAR; PG8_WAIT_L(0); PG8_MMA(0, 1, At, B1); PG8_BAR;
            PG8_LDA(At, 0, 1); PG8_STAGE(PG8_SA(0, 0), a2, voffA);
            PG8_BAR; PG8_WAIT_L(0); PG8_MMA(1, 0, At, B0); PG8_BAR; PG8_SCHED;
            PG8_STAGE(PG8_SB(0, 1), b2 + hstepB, voffB);
            PG8_WAIT_V(6); PG8_BAR; PG8_MMA(1, 1, At, B1); PG8_BAR;
            PG8_LDB(B0, 1, 0); PG8_SCHED; PG8_LDA(At, 1, 0); PG8_STAGE(PG8_SA(0, 1), a2 + hstepA, voffA);
            PG8_WAIT_L(8); PG8_BAR; PG8_WAIT_L(0); PG8_MMA(0, 0, At, B0); PG8_BAR; PG8_SCHED;
            PG8_LDB(B1, 1, 1); PG8_STAGE(PG8_SB(1, 0), b3, voffB);
            PG8_BAR; PG8_WAIT_L(0); PG8_MMA(0, 1, At, B1); PG8_BAR;
            PG8_LDA(At, 1, 1); PG8_STAGE(PG8_SA(1, 0), a3, voffA);
            PG8_BAR; PG8_WAIT_L(0); PG8_MMA(1, 0, At, B0); PG8_BAR; PG8_SCHED;
            PG8_STAGE(PG8_SB(1, 1), b3 + hstepB, voffB);
            PG8_WAIT_V(6); PG8_BAR; PG8_MMA(1, 1, At, B1); PG8_BAR;
        }
        E(acc, cur, wr, wc, fr, fq);
        if (!has_next) break;
        if (cur.aux != 1)
#pragma unroll
        for (int a = 0; a < 2; ++a)
#pragma unroll
            for (int b = 0; b < 2; ++b)
#pragma unroll
                for (int m = 0; m < 4; ++m)
#pragma unroll
                    for (int n = 0; n < 2; ++n) acc[a][b][m][n] = (f32x4){0.f, 0.f, 0.f, 0.f};
        cur = nxt; cA = nA; cB = nB; ++ui;
    }
    PG8_WAIT_V(0);
    if (wr == 0) PG8_BAR;
    PG8_BAR;
#undef PG8_SA
#undef PG8_SB
#undef PG8_STAGE
#undef PG8_LDA
#undef PG8_LDB
#undef PG8_MMA
#undef PG8_WAIT_V
#undef PG8_WAIT_L
#undef PG8_BAR
#undef PG8_SCHED
}
}
typedef f32x4 (&AccRef)[2][2][4][2];

#define XB_TMO      128
#define XB_XCNT(j)  (256  + 64 * (j))
#define XB_XSUB(j)  (1280 + 64 * (j))
#define XB_XGEN(j)  (2304 + 64 * (j))
#define XB_TOP      3328
#define XB_TOPGEN   3392
#define XCD_BAR_WORDS 3456
#define XB_SPIN_CAP (1u << 22)
__device__ __forceinline__ unsigned xb_ld(unsigned* p)              { return __hip_atomic_load(p, __ATOMIC_RELAXED, __HIP_MEMORY_SCOPE_AGENT); }
__device__ __forceinline__ unsigned xb_add(unsigned* p, unsigned v) { return __hip_atomic_fetch_add(p, v, __ATOMIC_RELAXED, __HIP_MEMORY_SCOPE_AGENT); }
__device__ __forceinline__ unsigned xb_xcc_id() { return (unsigned)__builtin_amdgcn_s_getreg((3 << 11) | 20) & 0xFu; }
#define XB_SPIN(cond, bar) do { unsigned _sp = 0; while (cond) { __builtin_amdgcn_s_sleep(1); \
    if ((++_sp & 255u) == 0u) { if (xb_ld(&(bar)[XB_TMO])) break; if (_sp > XB_SPIN_CAP) { atomicAdd(&(bar)[XB_TMO], 1u); break; } } } } while (0)
struct XcdBarrier { unsigned* bar; unsigned x; volatile LAS unsigned* st; };
__device__ __forceinline__ XcdBarrier xcd_barrier_post(unsigned* bar, volatile LAS unsigned* st) {
    XcdBarrier b; b.bar = bar; b.x = xb_xcc_id(); b.st = st;
    if (threadIdx.x == 0) (void)xb_add(&bar[XB_XCNT(b.x)], 1u);
    return b;
}
__device__ __forceinline__ void xcd_barrier_complete(unsigned* bar, unsigned x, unsigned& nloc, unsigned& nx) {
    const unsigned G = gridDim.x * gridDim.y * gridDim.z;
    unsigned sum, cnt, mine, sp = 0u;
    for (;;) {
        sum = 0u; cnt = 0u; mine = 0u;
#pragma unroll
        for (unsigned j = 0; j < 16; ++j) { const unsigned c = xb_ld(&bar[XB_XCNT(j)]); sum += c; cnt += (c > 0u) ? 1u : 0u; }
        mine = xb_ld(&bar[XB_XCNT(x)]);
        if (sum == G) break;
        __builtin_amdgcn_s_sleep(1);
        if ((++sp & 255u) == 0u) { if (xb_ld(&bar[XB_TMO])) break; if (sp > XB_SPIN_CAP) { atomicAdd(&bar[XB_TMO], 1u); break; } }
    }
    nloc = mine > 0u ? mine : 1u; nx = cnt > 0u ? cnt : 1u;
}
__device__ __forceinline__ void xcd_barrier(const XcdBarrier& b) {
    asm volatile("s_waitcnt vmcnt(0)" ::: "memory");
    __syncthreads();
    if (threadIdx.x == 0) {
        unsigned* bar = b.bar;
        __builtin_amdgcn_s_waitcnt(0);
        unsigned nloc = b.st[0], nx = b.st[1];
        if (nloc == 0u) { xcd_barrier_complete(bar, b.x, nloc, nx); b.st[0] = nloc; b.st[1] = nx; }
        const unsigned old = xb_add(&bar[XB_XSUB(b.x)], 1u);
        const unsigned gen = old / nloc;
        if (old + 1u == (gen + 1u) * nloc) {
            __builtin_amdgcn_fence(__ATOMIC_RELEASE, "agent");
            asm volatile("s_waitcnt vmcnt(0)" ::: "memory");
            const unsigned og = xb_add(&bar[XB_TOP], 1u);
            const unsigned tg = og / nx;
            if (og + 1u == (tg + 1u) * nx) xb_add(&bar[XB_TOPGEN], 1u);
            else XB_SPIN(xb_ld(&bar[XB_TOPGEN]) == tg, bar);
            __builtin_amdgcn_fence(__ATOMIC_ACQUIRE, "agent");
            xb_add(&bar[XB_XGEN(b.x)], 1u);
            asm volatile("s_waitcnt vmcnt(0)" ::: "memory");
        } else {
            XB_SPIN(xb_ld(&bar[XB_XGEN(b.x)]) == gen, bar);
            __builtin_amdgcn_fence(__ATOMIC_ACQUIRE, "agent");
            asm volatile("s_waitcnt vmcnt(0)" ::: "memory");
        }
    }
    __syncthreads();
}
using pg8::Unit;
typedef const unsigned long long __attribute__((address_space(4)))* CPtr64;
struct InTab { CPtr64 p; __device__ __forceinline__ const float* operator[](int i) const { return (const float*)(GAS const float*)p[i]; } };
struct Ctx {
    unsigned char* ws; float* out; InTab in;
    int G, c, tid;
};
#define WSP(T_, off) ((T_*)(X.ws + (off)))

struct SchedZ {
    const char* h; const char* w; int G, c;
    __device__ __forceinline__ bool next(int i, Unit& u) const {
        const long Lx = (long)i * G + c; if (Lx >= 32 * 61) return false;
        int pm, pn; pg8::tile_order((int)Lx, 32, 61, pm, pn);
        const char* hp = h + (size_t)pm * 256 * 2048 * 2; const char* wp = w + (size_t)pn * 256 * 2048 * 2;
        const bool sw = (pn >= 12 && pn < 16) || (pn >= 28 && pn < 32);
        u.pm = pm; u.pn = pn; u.kind = sw ? 1 : 0; u.aux = 0; u.a = sw ? wp : hp; u.b = sw ? hp : wp; return true;
    }
};
struct EpiZ {
    bf16_t* z; bf16_t* vsT; bf16_t* rvT; float* rss; bool doss;
    __device__ __forceinline__ void operator()(AccRef acc, const Unit& u, int wr, int wc, int fr, int fq) const {
        if (u.kind == 0) {
            const int pn = u.pn;
            const int act = (pn >= 36 && pn < 60) ? 2 : ((pn >= 4 && pn < 8) || (pn >= 16 && pn < 20) || (pn >= 32 && pn < 36)) ? 1 : (pn >= 24 && pn < 28) ? 3 : 0;
            const int row0 = u.pm * 256 + wr * 64 + fr, col0 = pn * 256 + wc * 32 + 8 * fq;
#pragma unroll
            for (int ai = 0; ai < 2; ++ai)
#pragma unroll
                for (int m = 0; m < 4; ++m) {
                    const int row = row0 + ai * 128 + m * 16; bf16_t* rowp = z + (size_t)row * ZW + col0; float ss = 0.f;
#pragma unroll
                    for (int bj = 0; bj < 2; ++bj) { f32x4 v0 = acc[ai][bj][m][0], v1 = acc[ai][bj][m][1];
                        if (act == 0) { ss += v0[0] * v0[0] + v0[1] * v0[1] + v0[2] * v0[2] + v0[3] * v0[3] + v1[0] * v1[0] + v1[1] * v1[1] + v1[2] * v1[2] + v1[3] * v1[3]; }
                        else if (act == 1) {
#pragma unroll
                            for (int j = 0; j < 4; ++j) { v0[j] = silu_f(v0[j]); v1[j] = silu_f(v1[j]); } }
                        else if (act == 2) {
#pragma unroll
                            for (int j = 0; j < 4; ++j) { v0[j] = fmaxf(sigm_f(v0[j]), 1e-20f); v1[j] = fmaxf(sigm_f(v1[j]), 1e-20f); } }
                        else { v0 = v0 * 0.08838834764831845f; v1 = v1 * 0.08838834764831845f; }
                        u32x4 w; w.x = cvt_pk(v0[0], v0[1]); w.y = cvt_pk(v0[2], v0[3]); w.z = cvt_pk(v1[0], v1[1]); w.w = cvt_pk(v1[2], v1[3]);
                        *(u32x4*)(rowp + bj * 128) = w; }
                    if (pn < 4 && doss) { ss += __shfl_xor(ss, 16); ss += __shfl_xor(ss, 32); if (fq == 0) atomicAdd(rss + (pn >> 1) * T + row, ss); }
                }
        } else {
            const bool isv = u.pn < 16; bf16_t* dst = isv ? vsT : rvT; const int f0 = (u.pn - (isv ? 12 : 28)) * 256 + wr * 64 + fr, tok0 = u.pm * 256 + wc * 32 + 8 * fq;
            float cs[2][2][4];
#pragma unroll
            for (int bj = 0; bj < 2; ++bj)
#pragma unroll
                for (int n = 0; n < 2; ++n)
#pragma unroll
                    for (int j = 0; j < 4; ++j) cs[bj][n][j] = 0.f;
#pragma unroll
            for (int ai = 0; ai < 2; ++ai)
#pragma unroll
                for (int m = 0; m < 4; ++m) { bf16_t* rowp = dst + (size_t)(f0 + ai * 128 + m * 16) * T + tok0;
#pragma unroll
                    for (int bj = 0; bj < 2; ++bj) { const f32x4 v0 = acc[ai][bj][m][0], v1 = acc[ai][bj][m][1];
#pragma unroll
                        for (int j = 0; j < 4; ++j) { cs[bj][0][j] += v0[j] * v0[j]; cs[bj][1][j] += v1[j] * v1[j]; }
                        u32x4 w; w.x = cvt_pk(v0[0], v0[1]); w.y = cvt_pk(v0[2], v0[3]); w.z = cvt_pk(v1[0], v1[1]); w.w = cvt_pk(v1[2], v1[3]);
                        *(u32x4*)(rowp + bj * 128) = w; } }
            if (isv && doss) {
#pragma unroll
                for (int bj = 0; bj < 2; ++bj)
#pragma unroll
                    for (int n = 0; n < 2; ++n)
#pragma unroll
                        for (int j = 0; j < 4; ++j) { float s = cs[bj][n][j]; s += __shfl_xor(s, 1); s += __shfl_xor(s, 2); s += __shfl_xor(s, 4); s += __shfl_xor(s, 8);
                            if (fr == 0) atomicAdd(rss + 2 * T + tok0 + bj * 128 + n * 4 + j, s); }
            }
        }
    }
};

struct SchedQK {
    const char* z; const char* wq; const char* wk; int G, c;
    __device__ __forceinline__ bool next(int i, Unit& u) const {
        const int Lx = i * G + c; if (Lx >= 320) return false;
        if (Lx < 192) { u.pm = Lx / 6; u.pn = Lx % 6; u.kind = 0; u.a = z + (size_t)u.pm * 256 * ZW * 2 + Z_CQ * 2; u.b = wq + (size_t)u.pn * 256 * 512 * 2; }
        else { const int r = Lx - 192; u.pm = r / 4; u.pn = r % 4; u.kind = 1; u.a = z + (size_t)u.pm * 256 * ZW * 2 + Z_CKV * 2; u.b = wk + (size_t)u.pn * 256 * 512 * 2; }
        u.aux = 0; return true;
    }
};
constexpr float QSCALE = 0.07216878364870322f * 1.4426950408889634f;
struct EpiQK {
    bf16_t* q; bf16_t* kn; const float* rss; const float* rope;
    __device__ __forceinline__ void operator()(AccRef acc, const Unit& u, int wr, int wc, int fr, int fq) const {
        const int row0 = u.pm * 256 + wr * 64 + fr, col0 = u.pn * 256 + wc * 32 + 8 * fq;
        if (u.kind == 0) {
#pragma unroll
            for (int ai = 0; ai < 2; ++ai)
#pragma unroll
                for (int m = 0; m < 4; ++m) {
                    const int row = row0 + ai * 128 + m * 16; const float ri = rsqrtf(rss[row] * (1.f / 512.f) + EPSN) * QSCALE;
                    const int t = (row - 4096) & 2047;
#pragma unroll
                    for (int bj = 0; bj < 2; ++bj) { f32x4 v0 = acc[ai][bj][m][0] * ri, v1 = acc[ai][bj][m][1] * ri;
                        const int g0 = u.pn * 256 + bj * 128 + wc * 32, off = g0 % 192;
                        if (off >= 128 && row >= 4096) {
                            const int p = (off == 128) ? (t >> 6) : (t & 63); const float* tb = rope + (p * 16 + (fq & 1) * 8) * 2;
                            const float sg = (fq & 2) ? 1.f : -1.f;
#pragma unroll
                            for (int j = 0; j < 4; ++j) { const float p0 = __shfl_xor(v0[j], 32), p1 = __shfl_xor(v1[j], 32);
                                const float c0 = tb[2 * j], s0 = tb[2 * j + 1], c1 = tb[2 * (4 + j)], s1 = tb[2 * (4 + j) + 1];
                                v0[j] = v0[j] * c0 + sg * p0 * s0; v1[j] = v1[j] * c1 + sg * p1 * s1; }
                        }
                        u32x4 w; w.x = cvt_pk(v0[0], v0[1]); w.y = cvt_pk(v0[2], v0[3]); w.z = cvt_pk(v1[0], v1[1]); w.w = cvt_pk(v1[2], v1[3]);
                        *(u32x4*)(q + (size_t)row * 1536 + col0 + bj * 128) = w; }
                }
        } else {
#pragma unroll
            for (int ai = 0; ai < 2; ++ai)
#pragma unroll
                for (int m = 0; m < 4; ++m) {
                    const int row = row0 + ai * 128 + m * 16; const float ri = rsqrtf(rss[T + row] * (1.f / 512.f) + EPSN);
#pragma unroll
                    for (int bj = 0; bj < 2; ++bj) { const f32x4 v0 = acc[ai][bj][m][0] * ri, v1 = acc[ai][bj][m][1] * ri;
                        u32x4 w; w.x = cvt_pk(v0[0], v0[1]); w.y = cvt_pk(v0[2], v0[3]); w.z = cvt_pk(v1[0], v1[1]); w.w = cvt_pk(v1[2], v1[3]);
                        *(u32x4*)(kn + (size_t)row * 1024 + col0 + bj * 128) = w; }
                }
        }
    }
};

struct SchedVT {
    const char* z; const char* wv; int G, c;
    __device__ __forceinline__ bool next(int i, Unit& u) const {
        const int Lx = i * G + c; if (Lx >= 128) return false;
        u.pm = Lx & 3; u.pn = Lx >> 2; u.kind = 0; u.aux = 0; u.a = wv + (size_t)u.pm * 256 * 512 * 2; u.b = z + (size_t)u.pn * 256 * ZW * 2 + Z_CKV * 2; return true;
    }
};
struct EpiVT {
    bf16_t* vt; const float* rss;
    __device__ __forceinline__ void operator()(AccRef acc, const Unit& u, int wr, int wc, int fr, int fq) const {
        const int f0 = u.pm * 256 + wr * 64 + fr, tok0 = u.pn * 256 + wc * 32 + 8 * fq;
        f32x4 ri[2][2];
#pragma unroll
        for (int bj = 0; bj < 2; ++bj)
#pragma unroll
            for (int n = 0; n < 2; ++n)
#pragma unroll
                for (int j = 0; j < 4; ++j) ri[bj][n][j] = rsqrtf(rss[T + tok0 + bj * 128 + n * 4 + j] * (1.f / 512.f) + EPSN);
#pragma unroll
        for (int ai = 0; ai < 2; ++ai)
#pragma unroll
            for (int m = 0; m < 4; ++m) { bf16_t* rowp = vt + (size_t)(f0 + ai * 128 + m * 16) * T + tok0;
#pragma unroll
                for (int bj = 0; bj < 2; ++bj) { const f32x4 v0 = acc[ai][bj][m][0] * ri[bj][0], v1 = acc[ai][bj][m][1] * ri[bj][1];
                    u32x4 w; w.x = cvt_pk(v0[0], v0[1]); w.y = cvt_pk(v0[2], v0[3]); w.z = cvt_pk(v1[0], v1[1]); w.w = cvt_pk(v1[2], v1[3]);
                    *(u32x4*)(rowp + bj * 128) = w; } }
    }
};

struct SchedC {
    const char* cc; const char* wk; const char* wv; int G, c;
    __device__ __forceinline__ bool next(int i, Unit& u) const {
        const int Lx = i * G + c; if (Lx >= 64) return false;
        const int l = Lx >> 4, r = Lx & 15; u.aux = l;
        if (r < 8) { u.kind = 0; u.pm = r >> 2; u.pn = r & 3; u.a = cc + ((size_t)l * 512 + u.pm * 256) * 512 * 2; u.b = wk + ((size_t)l * 1024 + u.pn * 256) * 512 * 2; }
        else { const int s = r - 8; u.kind = 1; u.pm = s >> 1; u.pn = s & 1; u.a = wv + ((size_t)l * 1024 + u.pm * 256) * 512 * 2; u.b = cc + ((size_t)l * 512 + u.pn * 256) * 512 * 2; }
        return true;
    }
};
struct EpiC {
    bf16_t* kc; bf16_t* vtc;
    __device__ __forceinline__ void operator()(AccRef acc, const Unit& u, int wr, int wc, int fr, int fq) const {
        const int r0 = u.pm * 256 + wr * 64 + fr, c0 = u.pn * 256 + wc * 32 + 8 * fq;
        bf16_t* base = u.kind == 0 ? kc + (size_t)u.aux * 512 * 1024 : vtc + (size_t)u.aux * 1024 * 512; const int ld = u.kind == 0 ? 1024 : 512;
#pragma unroll
        for (int ai = 0; ai < 2; ++ai)
#pragma unroll
            for (int m = 0; m < 4; ++m) { bf16_t* rowp = base + (size_t)(r0 + ai * 128 + m * 16) * ld + c0;
#pragma unroll
                for (int bj = 0; bj < 2; ++bj) { const f32x4 v0 = acc[ai][bj][m][0], v1 = acc[ai][bj][m][1];
                    u32x4 w; w.x = cvt_pk(v0[0], v0[1]); w.y = cvt_pk(v0[2], v0[3]); w.z = cvt_pk(v1[0], v1[1]); w.w = cvt_pk(v1[2], v1[3]);
                    *(u32x4*)(rowp + bj * 128) = w; } }
    }
};

struct SchedBr {
    const char* am; const char* as; const char* ar; const char* w; int G, c;
    __device__ __forceinline__ bool next(int i, Unit& u) const {
        const int tile = (i / 3) * G + c; if (tile >= 256) return false;
        const int br = i % 3; pg8::tile_order(tile, 32, 8, u.pm, u.pn); u.kind = br; u.aux = br < 2 ? 1 : 0;
        u.a = (br == 0 ? am : br == 1 ? as : ar) + (size_t)u.pm * 256 * 1024 * 2; u.b = w + ((size_t)br * 2048 + u.pn * 256) * 1024 * 2; return true;
    }
};
struct EpiBr {
    const bf16_t* z; bf16_t* ymb;
    __device__ __forceinline__ void operator()(AccRef acc, const Unit& u, int wr, int wc, int fr, int fq) const {
        const int row0 = u.pm * 256 + wr * 64 + fr, col0 = u.pn * 256 + wc * 32 + 8 * fq;
#pragma unroll
        for (int ai = 0; ai < 2; ++ai)
#pragma unroll
            for (int m = 0; m < 4; ++m) { const int row = row0 + ai * 128 + m * 16;
#pragma unroll
                for (int bj = 0; bj < 2; ++bj) { const int col = col0 + bj * 128;
                    const bf16_t* mp = z + (size_t)row * ZW + Z_MRG + u.kind * 2048 + col;
                    const u32x4 mg = *(const u32x4*)mp;
                    f32x4 s0, s1; s0[0] = bflo(mg.x); s0[1] = bfhi(mg.x); s0[2] = bflo(mg.y); s0[3] = bfhi(mg.y); s1[0] = bflo(mg.z); s1[1] = bfhi(mg.z); s1[2] = bflo(mg.w); s1[3] = bfhi(mg.w);
                    if (u.kind < 2) { const u32x4 mn = *(const u32x4*)(mp + 2048);
                        s0[0] *= __builtin_amdgcn_rcpf(bflo(mn.x)); s0[1] *= __builtin_amdgcn_rcpf(bfhi(mn.x)); s0[2] *= __builtin_amdgcn_rcpf(bflo(mn.y)); s0[3] *= __builtin_amdgcn_rcpf(bfhi(mn.y));
                        s1[0] *= __builtin_amdgcn_rcpf(bflo(mn.z)); s1[1] *= __builtin_amdgcn_rcpf(bfhi(mn.z)); s1[2] *= __builtin_amdgcn_rcpf(bflo(mn.w)); s1[3] *= __builtin_amdgcn_rcpf(bfhi(mn.w));
                        acc[ai][bj][m][0] *= s0; acc[ai][bj][m][1] *= s1; }
                    else { const f32x4 v0 = acc[ai][bj][m][0] * s0, v1 = acc[ai][bj][m][1] * s1;
                        u32x4 w; w.x = cvt_pk(v0[0], v0[1]); w.y = cvt_pk(v0[2], v0[3]); w.z = cvt_pk(v1[0], v1[1]); w.w = cvt_pk(v1[2], v1[3]);
                        *(u32x4*)(ymb + (size_t)row * DM + col) = w; }
                } }
    }
};

struct SchedOut {
    const char* a; const char* w; int G, c;
    __device__ __forceinline__ bool next(int i, Unit& u) const {
        const int tile = i * G + c; if (tile >= 256) return false;
        pg8::tile_order(tile, 32, 8, u.pm, u.pn); u.kind = 0; u.aux = 0; u.a = a + (size_t)u.pm * 256 * 2048 * 2; u.b = w + (size_t)u.pn * 256 * 2048 * 2; return true;
    }
};
struct EpiOut {
    float* y; float* rss; bool doss;
    __device__ __forceinline__ void operator()(AccRef acc, const Unit& u, int wr, int wc, int fr, int fq) const {
        const int row0 = u.pm * 256 + wr * 64 + fr, col0 = u.pn * 256 + wc * 32 + 8 * fq;
#pragma unroll
        for (int ai = 0; ai < 2; ++ai)
#pragma unroll
            for (int m = 0; m < 4; ++m) { const int row = row0 + ai * 128 + m * 16; float ss = 0.f;
#pragma unroll
                for (int bj = 0; bj < 2; ++bj) { const f32x4 v0 = acc[ai][bj][m][0], v1 = acc[ai][bj][m][1]; float* yp = y + (size_t)row * DM + col0 + bj * 128;
                    ss += v0[0] * v0[0] + v0[1] * v0[1] + v0[2] * v0[2] + v0[3] * v0[3] + v1[0] * v1[0] + v1[1] * v1[1] + v1[2] * v1[2] + v1[3] * v1[3];
                    *(f32x4*)yp = v0; *(f32x4*)(yp + 4) = v1; }
                ss += __shfl_xor(ss, 16); ss += __shfl_xor(ss, 32); if (fq == 0 && doss) atomicAdd(rss + 3 * T + row, ss); }
    }
};
__device__ __forceinline__ void transpose_item(const float* W, int K, int N, int k0, int n0, bf16_t* dst0, const float* gk, LAS float* scr, int lane) {
    const int kr = lane >> 3, c4 = (lane & 7) * 4;
    f32x4 v[8];
#pragma unroll
    for (int i = 0; i < 8; ++i) v[i] = __builtin_nontemporal_load((const f32x4*)(W + (size_t)(k0 + 8 * i + kr) * N + n0 + c4));
    if (gk) {
#pragma unroll
        for (int i = 0; i < 8; ++i) v[i] = v[i] * gk[k0 + 8 * i + kr]; }
#pragma unroll
    for (int i = 0; i < 8; ++i) { LAS float* sp = scr + (8 * i + kr) * 33 + c4; sp[0] = v[i][0]; sp[1] = v[i][1]; sp[2] = v[i][2]; sp[3] = v[i][3]; }
    asm volatile("s_waitcnt lgkmcnt(0)" ::: "memory");
    const int c = lane & 7;
#pragma unroll
    for (int j = 0; j < 4; ++j) { const int n = (lane >> 3) + 8 * j; const LAS float* s = scr + (8 * c) * 33 + n;
        u32x4 o; o.x = cvt_pk(s[0 * 33], s[1 * 33]); o.y = cvt_pk(s[2 * 33], s[3 * 33]); o.z = cvt_pk(s[4 * 33], s[5 * 33]); o.w = cvt_pk(s[6 * 33], s[7 * 33]);
        *(u32x4*)(dst0 + (size_t)n * K + k0 + 8 * c) = o; }
    asm volatile("s_waitcnt lgkmcnt(0)" ::: "memory");
}

__device__ __forceinline__ void phase_prologue(const Ctx& X, LAS unsigned char* lds) {
    const int tid = X.tid, lane = tid & 63, wave = tid >> 6;
    const int gw = X.c * 8 + wave, NGW = X.G * 8;
    LAS float* scr = (LAS float*)(lds + wave * 8704);
    constexpr int I_IN = 32 * 482, I_UQ = 8 * 48, I_UKV = 8 * 64, I_BR = 16 * 64, I_OUT = 32 * 64;
    constexpr int PER_L = I_IN + I_UQ + 2 * I_UKV + 3 * I_BR + I_OUT;
    for (int it = gw; it < NL * PER_L; it += NGW) {
        const int l = it / PER_L; int r = it % PER_L;
        if (r < I_IN) { const int kb = r / 482, nb = r % 482, n0 = nb * 32; const int d0 = n0 < 1024 ? n0 : (n0 < 1088 ? Z_KR + (n0 - 1024) : n0 - 64);
            transpose_item(X.in[11] + (size_t)l * 2048 * INC, 2048, INC, kb * 64, n0, WSP(bf16_t, O_WIN) + ((size_t)l * ZW + d0) * 2048, nullptr, scr, lane); continue; }
        r -= I_IN;
        if (r < I_UQ) { const int kb = r / 48, nb = r % 48;
            transpose_item(X.in[14] + (size_t)l * 512 * 1536, 512, 1536, kb * 64, nb * 32, WSP(bf16_t, O_WUQ) + ((size_t)l * 1536 + nb * 32) * 512, X.in[12] + l * 512, scr, lane); continue; }
        r -= I_UQ;
        if (r < 2 * I_UKV) { const int gfold = r >= I_UKV; if (gfold) r -= I_UKV; const int kb = r / 64, nb = r % 64, n0 = nb * 32, hd = n0 >> 8, d = n0 & 255;
            bf16_t* dst = (d < 128 ? WSP(bf16_t, gfold ? O_WKG : O_WKP) : WSP(bf16_t, gfold ? O_WVG : O_WVP)) + ((size_t)l * 1024 + hd * 128 + (d & 127)) * 512;
            transpose_item(X.in[15] + (size_t)l * 512 * 2048, 512, 2048, kb * 64, n0, dst, gfold ? X.in[13] + l * 512 : nullptr, scr, lane); continue; }
        r -= 2 * I_UKV;
        if (r < 3 * I_BR) { const int br = r / I_BR; r %= I_BR; const int kb = r / 64, nb = r % 64;
            transpose_item(X.in[21 + br] + (size_t)l * 1024 * 2048, 1024, 2048, kb * 64, nb * 32, WSP(bf16_t, O_WBR) + (((size_t)l * 3 + br) * 2048 + nb * 32) * 1024, nullptr, scr, lane); continue; }
        r -= 3 * I_BR;
        { const int kb = r / 64, nb = r % 64;
            transpose_item(X.in[24] + (size_t)l * 2048 * 2048, 2048, 2048, kb * 64, nb * 32, WSP(bf16_t, O_WOUT) + ((size_t)l * 2048 + nb * 32) * 2048, nullptr, scr, lane); }
    }
    const int gt = X.c * NTHREADS + tid, NGT = X.G * NTHREADS;
    for (int i = gt; i < NL * 512 * 512 / 4; i += NGT) { const int e = i * 4, l = e / (512 * 512), rr = (e / 512) % 512, cidx = e % 512, b = rr >> 8, t = rr & 255;
        const f32x4 v = *(const f32x4*)(X.in[2] + (((size_t)b * NL + l) * 256 + t) * 512 + cidx);
        u32x2 w; w.x = cvt_pk(v[0], v[1]); w.y = cvt_pk(v[2], v[3]); *(u32x2*)(WSP(bf16_t, O_CKVC) + e) = w; }
    for (int i = gt; i < NL * 512 * 64 / 4; i += NGT) { const int e = i * 4, l = e / (512 * 64), rr = (e / 64) % 512, cidx = e % 64, b = rr >> 8, t = rr & 255;
        const f32x4 v = *(const f32x4*)(X.in[3] + (((size_t)b * NL + l) * 256 + t) * 64 + cidx);
        u32x2 w; w.x = cvt_pk(v[0], v[1]); w.y = cvt_pk(v[2], v[3]); *(u32x2*)(WSP(bf16_t, O_KRC) + e) = w; }
    for (int i = gt; i < 64 * 16; i += NGT) { const int p = i >> 4, f = i & 15; const float inv = powf(10000.f, -(float)f / 16.f); const float ang = (float)p * inv;
        WSP(float, O_ROPE)[2 * i] = cosf(ang); WSP(float, O_ROPE)[2 * i + 1] = sinf(ang); }
    for (int i = gt; i < 4 * T; i += NGT) WSP(float, O_RSS)[i] = 0.f;
    LAS float* sl = (LAS float*)(lds + 69632);
    LAS float* red = (LAS float*)(lds + 69632 + 24576);
    __syncthreads();
    for (int i = tid; i < 3 * 2048; i += NTHREADS) { const int cidx = i >> 11, k = i & 2047; const float v = cidx == 0 ? X.in[6][k] : X.in[5][(cidx - 1) * 2048 + k]; sl[i] = silu_f(v); }
    __syncthreads();
    for (int un = X.c; un < NL * 192; un += X.G) {
        const int l = un / 192, col0 = (un % 192) * 32, kg = tid >> 3, c4 = tid & 7;
        const float* wp = X.in[7] + (size_t)l * 2048 * 6144 + col0 + 4 * c4;
        f32x4 a0 = {0.f, 0.f, 0.f, 0.f}, a1 = a0, a2 = a0;
#pragma unroll 8
        for (int k = kg; k < 2048; k += 64) { const f32x4 w = *(const f32x4*)(wp + (size_t)k * 6144); a0 += w * sl[k]; a1 += w * sl[2048 + k]; a2 += w * sl[4096 + k]; }
        LAS float* rp = red + (kg * 8 + c4) * 12;
#pragma unroll
        for (int j = 0; j < 4; ++j) { rp[j] = a0[j]; rp[4 + j] = a1[j]; rp[8 + j] = a2[j]; }
        __syncthreads();
        if (tid < 96) { const int cc = tid / 12, jj = tid % 12; float s = 0.f; for (int g = 0; g < 64; ++g) s += red[(g * 8 + cc) * 12 + jj];
            const int cidx = jj >> 2, col = col0 + 4 * cc + (jj & 3); WSP(float, O_MOD)[((size_t)l * 3 + cidx) * 6144 + col] = s + X.in[8][l * 6144 + col]; }
        __syncthreads();
    }
}

__device__ __forceinline__ void phase_rows(const Ctx& X, int l, bool upd, int ln) {
    const int tid = X.tid, lane = tid & 63, wave = tid >> 6;
    const float* mod = WSP(float, O_MOD);
    for (int row0 = (X.c * 8 + wave) * 2; row0 < T; row0 += X.G * 16) {
        f32x4 v[2][8];
#pragma unroll
        for (int rr = 0; rr < 2; ++rr) { const int row = row0 + rr;
            const float* xsrc = (upd && l > 0) || (!upd && ln > 0) ? WSP(float, O_X) + (size_t)row * DM : (row < 4096 ? X.in[0] + (size_t)row * DM : X.in[1] + (size_t)(row - 4096) * DM);
#pragma unroll
            for (int j = 0; j < 8; ++j) v[rr][j] = *(const f32x4*)(xsrc + j * 256 + lane * 4); }
        const int cidx = row0 < 4096 ? 0 : 1 + ((row0 - 4096) >> 11);
        if (upd) {
            const float* gate = mod + ((size_t)l * 3 + cidx) * 6144 + 4096; const float* gp = X.in[10] + l * 2048;
#pragma unroll
            for (int rr = 0; rr < 2; ++rr) { const int row = row0 + rr; const float* yp = WSP(float, O_Y) + (size_t)row * DM;
                f32x4 y[8];
#pragma unroll
                for (int j = 0; j < 8; ++j) y[j] = *(const f32x4*)(yp + j * 256 + lane * 4);
                const float ri = rsqrtf(WSP(float, O_RSS)[3 * T + row] * (1.f / 2048.f) + EPSN);
                float* xdst = (l == NL - 1) ? X.out + (row < 4096 ? OUT_YP + (size_t)row * DM : OUT_YS + (size_t)(row - 4096) * DM) : WSP(float, O_X) + (size_t)row * DM;
#pragma unroll
                for (int j = 0; j < 8; ++j) { const int c = j * 256 + lane * 4; const f32x4 gg = *(const f32x4*)(gate + c) * *(const f32x4*)(gp + c);
                    v[rr][j] += gg * (y[j] * ri); *(f32x4*)(xdst + c) = v[rr][j]; }
                __builtin_amdgcn_sched_barrier(0); }
        }
        __builtin_amdgcn_sched_barrier(0);
        if (ln < NL) {
            float ss0 = 0.f, ss1 = 0.f;
#pragma unroll
            for (int j = 0; j < 8; ++j) { ss0 += v[0][j][0] * v[0][j][0] + v[0][j][1] * v[0][j][1] + v[0][j][2] * v[0][j][2] + v[0][j][3] * v[0][j][3];
                ss1 += v[1][j][0] * v[1][j][0] + v[1][j][1] * v[1][j][1] + v[1][j][2] * v[1][j][2] + v[1][j][3] * v[1][j][3]; }
            ss0 = wave_sum(ss0); ss1 = wave_sum(ss1); __builtin_amdgcn_sched_barrier(0); const float ri0 = rsqrtf(ss0 * (1.f / 2048.f) + EPSN), ri1 = rsqrtf(ss1 * (1.f / 2048.f) + EPSN);
            const float* sh = mod + ((size_t)ln * 3 + cidx) * 6144; const float* sc = sh + 2048; const float* gp = X.in[9] + ln * 2048;
            bf16_t* hp = WSP(bf16_t, O_H) + (size_t)row0 * DM;
#pragma unroll
            for (int j = 0; j < 8; ++j) { const int c = j * 256 + lane * 4; const f32x4 s = *(const f32x4*)(sc + c), b = *(const f32x4*)(sh + c), g = *(const f32x4*)(gp + c);
                const f32x4 gs = g * (s + 1.f);
                const f32x4 h0 = v[0][j] * ri0 * gs + b, h1 = v[1][j] * ri1 * gs + b;
                u32x2 w; w.x = cvt_pk(h0[0], h0[1]); w.y = cvt_pk(h0[2], h0[3]); *(u32x2*)(hp + c) = w;
                w.x = cvt_pk(h1[0], h1[1]); w.y = cvt_pk(h1[2], h1[3]); *(u32x2*)(hp + DM + c) = w; }
        }
    }
}

__device__ __forceinline__ void phase_misc(const Ctx& X, int l) {
    const int tid = X.tid, lane = tid & 63, wave = tid >> 6;
    const bf16_t* z = WSP(bf16_t, O_Z); const float* rope = WSP(float, O_ROPE);
    for (int row = X.c * 8 + wave; row < T; row += X.G * 8) {
        const bf16_t* zr = z + (size_t)row * ZW;
        float kr = bf2f(zr[Z_KR + lane]);
        if (row < 4096) {
            const int b = row >> 8, t = row & 255;
            const float ri = rsqrtf(WSP(float, O_RSS)[T + row] * (1.f / 512.f) + EPSN);
            const u32x4 w = *(const u32x4*)(zr + Z_CKV + lane * 8); const float* g = X.in[13] + l * 512 + lane * 8;
            float* o = X.out + OUT_CKV + (((size_t)b * NL + l) * 256 + t) * 512 + lane * 8;
            f32x4 o0, o1; o0[0] = bflo(w.x) * ri * g[0]; o0[1] = bfhi(w.x) * ri * g[1]; o0[2] = bflo(w.y) * ri * g[2]; o0[3] = bfhi(w.y) * ri * g[3];
            o1[0] = bflo(w.z) * ri * g[4]; o1[1] = bfhi(w.z) * ri * g[5]; o1[2] = bflo(w.w) * ri * g[6]; o1[3] = bfhi(w.w) * ri * g[7];
            *(f32x4*)o = o0; *(f32x4*)(o + 4) = o1;
            X.out[OUT_KR + (((size_t)b * NL + l) * 256 + t) * 64 + lane] = kr;
        } else {
            const int t = (row - 4096) & 2047; const int p = lane < 32 ? (t >> 6) : (t & 63); const int f = lane & 15;
            const float cs = rope[(p * 16 + f) * 2], sn = rope[(p * 16 + f) * 2 + 1];
            const float pr = __shfl_xor(kr, 16);
            kr = (lane & 16) ? kr * cs + pr * sn : kr * cs - pr * sn;
        }
        const float nb = __shfl_down(kr, 1);
        if ((lane & 1) == 0) *(unsigned*)(WSP(bf16_t, O_KR) + (size_t)row * 64 + lane) = cvt_pk(kr, nb);
    }
}
constexpr int PB = 272;
constexpr int BUFB = 128 * PB;
constexpr int PO = 132;
__device__ __forceinline__ void mma128(const LAS unsigned char* As, const LAS unsigned char* Bs, f32x16 (&acc)[2], int wr, int wc, int lane) {
    const int r32 = lane & 31, hi = lane >> 5;
    const LAS unsigned char* ap = As + (32 * wr + r32) * PB + hi * 16;
    const LAS unsigned char* bp = Bs + (64 * wc + r32) * PB + hi * 16;
#pragma unroll 2
    for (int s = 0; s < 8; ++s) {
        const bf16x8 a = *(const LAS bf16x8*)(ap + s * 32);
        const bf16x8 b0 = *(const LAS bf16x8*)(bp + s * 32);
        const bf16x8 b1 = *(const LAS bf16x8*)(bp + 32 * PB + s * 32);
        acc[0] = __builtin_amdgcn_mfma_f32_32x32x16_bf16(a, b0, acc[0], 0, 0, 0);
        acc[1] = __builtin_amdgcn_mfma_f32_32x32x16_bf16(a, b1, acc[1], 0, 0, 0);
    }
}
__device__ __forceinline__ int crow(int r, int hi) { return (r & 3) + 8 * (r >> 2) + 4 * hi; }
__device__ __forceinline__ void stage_tile(LAS unsigned char* dst, const bf16_t* src, size_t ld, int tid) {
#pragma unroll
    for (int i = 0; i < 4; ++i) { const int c = tid + i * NTHREADS, r = c >> 4, ch = c & 15;
        *(LAS u32x4*)(dst + r * PB + ch * 16) = *(const u32x4*)(src + (size_t)r * ld + ch * 8); }
}
__device__ __forceinline__ float log_sigmoid_f(float x) { return -log1pf(expf(-x)); }

__device__ __forceinline__ void sgu_item(const Ctx& X, LAS unsigned char* lds, int l, int item) {
    int tid_ = X.tid; asm volatile("" : "+v"(tid_));
    const int tid = tid_, lane = tid & 63, wave = tid >> 6, wr = wave >> 1, wc = wave & 1;
    const int n = item >> 3, g = item & 7, tok0 = n * 128;
    LAS unsigned char* As = lds; LAS unsigned char* Bs = lds + BUFB; LAS float* Os = (LAS float*)(lds + 2 * BUFB);
    const float* ws = X.in[17] + ((size_t)l * 8 + g) * 16384; const float* rss = WSP(float, O_RSS) + 2 * T + tok0;
#pragma unroll
    for (int i = 0; i < 4; ++i) { const int c = tid + i * NTHREADS, r = c >> 4, ch = c & 15;
        const f32x4 w0 = *(const f32x4*)(ws + r * 128 + ch * 8), w1 = *(const f32x4*)(ws + r * 128 + ch * 8 + 4);
        const f32x4 s0 = *(const f32x4*)(rss + ch * 8), s1 = *(const f32x4*)(rss + ch * 8 + 4);
        u32x4 o; o.x = cvt_pk(w0[0] * rsqrtf(s0[0] * (1.f / 1024.f) + EPSN), w0[1] * rsqrtf(s0[1] * (1.f / 1024.f) + EPSN));
        o.y = cvt_pk(w0[2] * rsqrtf(s0[2] * (1.f / 1024.f) + EPSN), w0[3] * rsqrtf(s0[3] * (1.f / 1024.f) + EPSN));
        o.z = cvt_pk(w1[0] * rsqrtf(s1[0] * (1.f / 1024.f) + EPSN), w1[1] * rsqrtf(s1[1] * (1.f / 1024.f) + EPSN));
        o.w = cvt_pk(w1[2] * rsqrtf(s1[2] * (1.f / 1024.f) + EPSN), w1[3] * rsqrtf(s1[3] * (1.f / 1024.f) + EPSN));
        *(LAS u32x4*)(As + r * PB + ch * 16) = o; }
    stage_tile(Bs, WSP(bf16_t, O_VST) + (size_t)(g * 128) * T + tok0, T, tid);
    __syncthreads();
    f32x16 acc[2]; acc[0] = (f32x16)(0.f); acc[1] = (f32x16)(0.f);
    mma128(As, Bs, acc, wr, wc, lane);
    { const int hi = lane >> 5, cb = 64 * wc + (lane & 31);
#pragma unroll
      for (int t = 0; t < 2; ++t)
#pragma unroll
        for (int r = 0; r < 16; ++r) Os[(32 * wr + crow(r, hi)) * PO + cb + 32 * t] = acc[t][r]; }
    __syncthreads();
    { const int p = tid >> 2, cseg = (tid & 3) * 32; const bf16_t* zr = WSP(bf16_t, O_Z) + (size_t)(tok0 + p) * ZW;
      const float bs = X.in[18][((size_t)l * 128 + p) * 8 + g]; const float* gs = X.in[16] + l * 1024 + g * 128 + cseg;
      bf16_t* op = WSP(bf16_t, O_AS) + (size_t)(tok0 + p) * 1024 + g * 128 + cseg;
#pragma unroll
      for (int i = 0; i < 4; ++i) {
          const u32x4 uu = *(const u32x4*)(zr + Z_U + g * 128 + cseg + i * 8), gg = *(const u32x4*)(zr + Z_GPS + g * 128 + cseg + i * 8);
          const f32x4 s0 = *(const LAS f32x4*)(Os + p * PO + cseg + i * 8), s1 = *(const LAS f32x4*)(Os + p * PO + cseg + i * 8 + 4);
          const f32x4 g0 = *(const f32x4*)(gs + i * 8), g1 = *(const f32x4*)(gs + i * 8 + 4);
          u32x4 o; o.x = cvt_pk((s0[0] * g0[0] + bs) * bflo(uu.x) * bflo(gg.x), (s0[1] * g0[1] + bs) * bfhi(uu.x) * bfhi(gg.x));
          o.y = cvt_pk((s0[2] * g0[2] + bs) * bflo(uu.y) * bflo(gg.y), (s0[3] * g0[3] + bs) * bfhi(uu.y) * bfhi(gg.y));
          o.z = cvt_pk((s1[0] * g1[0] + bs) * bflo(uu.z) * bflo(gg.z), (s1[1] * g1[1] + bs) * bfhi(uu.z) * bfhi(gg.z));
          o.w = cvt_pk((s1[2] * g1[2] + bs) * bflo(uu.w) * bflo(gg.w), (s1[3] * g1[3] + bs) * bfhi(uu.w) * bfhi(gg.w));
          *(u32x4*)(op + i * 8) = o; } }
    __syncthreads();
}

__device__ __forceinline__ void retstate_item(const Ctx& X, LAS unsigned char* lds, int l, int item) {
    int tid_ = X.tid; asm volatile("" : "+v"(tid_));
    const int tid = tid_, lane = tid & 63, wave = tid >> 6, wr = wave >> 1, wc = wave & 1;
    const int n = item >> 3, hd = item & 7, tok0 = n * 128;
    LAS unsigned char* As = lds; LAS unsigned char* Bf = lds + BUFB; LAS unsigned char* Bb = lds + 2 * BUFB;
    const float lgf = log_sigmoid_f(X.in[19][(l * 2 + 0) * 8 + hd]) * 1.4426950408889634f, lgb = log_sigmoid_f(X.in[19][(l * 2 + 1) * 8 + hd]) * 1.4426950408889634f;
    stage_tile(As, WSP(bf16_t, O_RVT) + (size_t)(hd * 128) * T + tok0, T, tid);
    { const bf16_t* kz = WSP(bf16_t, O_Z) + (size_t)tok0 * ZW + Z_RK + hd * 128;
#pragma unroll
      for (int i = 0; i < 4; ++i) { const int combo = wave * 4 + i, j = (combo & 1) * 64 + lane, d0 = (combo >> 1) * 8;
          const u32x4 w = *(const u32x4*)(kz + (size_t)j * ZW + d0);
          const float wf = exp2f(lgf * (float)(127 - j)), wb = exp2f(lgb * (float)j);
          const float kv[8] = {bflo(w.x), bfhi(w.x), bflo(w.y), bfhi(w.y), bflo(w.z), bfhi(w.z), bflo(w.w), bfhi(w.w)};
#pragma unroll
          for (int e = 0; e < 8; ++e) { *(LAS bf16_t*)(Bf + (d0 + e) * PB + j * 2) = (bf16_t)(cvt_pk(kv[e] * wf, 0.f) & 0xffffu); *(LAS bf16_t*)(Bb + (d0 + e) * PB + j * 2) = (bf16_t)(cvt_pk(kv[e] * wb, 0.f) & 0xffffu); } } }
    __syncthreads();
    f32x16 af[2], ab[2]; af[0] = (f32x16)(0.f); af[1] = (f32x16)(0.f); ab[0] = (f32x16)(0.f); ab[1] = (f32x16)(0.f);
    mma128(As, Bf, af, wr, wc, lane); mma128(As, Bb, ab, wr, wc, lane);
    float* st = WSP(float, O_ST) + ((size_t)(n * 8 + hd) * 2) * 16384;
    { const int hi = lane >> 5, cb = 64 * wc + (lane & 31);
#pragma unroll
      for (int t = 0; t < 2; ++t)
#pragma unroll
        for (int r = 0; r < 16; ++r) { const int e = 32 * wr + crow(r, hi); st[e * 128 + cb + 32 * t] = af[t][r]; st[16384 + e * 128 + cb + 32 * t] = ab[t][r]; } }
    __syncthreads();
}

__device__ __forceinline__ void retout_item(const Ctx& X, LAS unsigned char* lds, int l, int item) {
    int tid_ = X.tid; asm volatile("" : "+v"(tid_));
    const int tid = tid_, lane = tid & 63, wave = tid >> 6, wr = wave >> 1, wc = wave & 1;
    const int n = item >> 3, hd = item & 7, tok0 = n * 128;
    const bool smp = n >= 32; const int nc = smp ? 16 : 2, jc = smp ? ((n - 32) & 15) : (n & 1), n0 = n - jc, bs = smp ? (n - 32) >> 4 : n >> 1;
    LAS unsigned char* B0 = lds; LAS unsigned char* B1 = lds + BUFB; LAS unsigned char* B2 = lds + 2 * BUFB; LAS unsigned char* B3 = lds + 3 * BUFB;
    const float lnf = log_sigmoid_f(X.in[19][(l * 2 + 0) * 8 + hd]), lnb = log_sigmoid_f(X.in[19][(l * 2 + 1) * 8 + hd]);
    const float lgf = lnf * 1.4426950408889634f, lgb = lnb * 1.4426950408889634f, gcf = exp2f(128.f * lgf), gcb = exp2f(128.f * lgb);
    const bf16_t* z = WSP(bf16_t, O_Z);
    stage_tile(B0, z + (size_t)tok0 * ZW + Z_RQ + hd * 128, ZW, tid);
    stage_tile(B1, z + (size_t)tok0 * ZW + Z_RK + hd * 128, ZW, tid);
    stage_tile(B3, WSP(bf16_t, O_RVT) + (size_t)(hd * 128) * T + tok0, T, tid);
    __syncthreads();
    const int hi = lane >> 5, cb = 64 * wc + (lane & 31);
    { f32x16 aw[2]; aw[0] = (f32x16)(0.f); aw[1] = (f32x16)(0.f);
      mma128(B0, B1, aw, wr, wc, lane);
#pragma unroll
      for (int t = 0; t < 2; ++t)
#pragma unroll
        for (int r = 0; r < 16; ++r) { const int i = 32 * wr + crow(r, hi), j = cb + 32 * t; const float dd = (float)(i - j);
            const float dec = (i >= j) ? exp2f(lgf * dd) : exp2f(-lgb * dd);
            *(LAS bf16_t*)(B2 + i * PB + j * 2) = (bf16_t)(cvt_pk(aw[t][r] * dec, 0.f) & 0xffffu); } }
    __syncthreads();
    const int e_ = tid >> 2, dseg = (tid & 3) * 32;
    const float* stb = WSP(float, O_ST);
    f32x4 R[8];
    if (smp) { const float* s0 = X.in[4] + ((((size_t)bs * NL + l) * 2 + 0) * 8 + hd) * 16384;
#pragma unroll
        for (int q = 0; q < 8; ++q)
#pragma unroll
            for (int k = 0; k < 4; ++k) R[q][k] = s0[(size_t)(dseg + q * 4 + k) * 128 + e_]; }
    else {
#pragma unroll
        for (int q = 0; q < 8; ++q) R[q] = (f32x4){0.f, 0.f, 0.f, 0.f}; }
#pragma unroll 1
    for (int jj = 0; jj < jc; ++jj) { const float* sp = stb + ((size_t)((n0 + jj) * 8 + hd) * 2 + 0) * 16384 + e_ * 128 + dseg;
#pragma unroll
        for (int q = 0; q < 8; ++q) R[q] = R[q] * gcf + *(const f32x4*)(sp + q * 4); }
#pragma unroll
    for (int q = 0; q < 4; ++q) { u32x4 o; o.x = cvt_pk(R[2 * q][0], R[2 * q][1]); o.y = cvt_pk(R[2 * q][2], R[2 * q][3]); o.z = cvt_pk(R[2 * q + 1][0], R[2 * q + 1][1]); o.w = cvt_pk(R[2 * q + 1][2], R[2 * q + 1][3]);
        *(LAS u32x4*)(B1 + e_ * PB + (dseg + q * 8) * 2) = o; }
    if (!smp && jc == 1) {
        const float* sp = stb + ((size_t)(n * 8 + hd) * 2 + 0) * 16384 + e_ * 128 + dseg; float* o = X.out + OUT_RET + ((((size_t)bs * NL + l) * 2 + 0) * 8 + hd) * 16384;
#pragma unroll
        for (int q = 0; q < 8; ++q) { const f32x4 f = R[q] * gcf + *(const f32x4*)(sp + q * 4);
#pragma unroll
            for (int k = 0; k < 4; ++k) o[(size_t)(dseg + q * 4 + k) * 128 + e_] = f[k]; } }
    f32x16 ao[2]; ao[0] = (f32x16)(0.f); ao[1] = (f32x16)(0.f);
    mma128(B2, B3, ao, wr, wc, lane);
    __syncthreads();
    f32x16 ac[2]; ac[0] = (f32x16)(0.f); ac[1] = (f32x16)(0.f);
    mma128(B0, B1, ac, wr, wc, lane);
#pragma unroll
    for (int t = 0; t < 2; ++t)
#pragma unroll
        for (int r = 0; r < 16; ++r) { const int i = 32 * wr + crow(r, hi); ao[t][r] += ac[t][r] * exp2f(lgf * (float)(i + 1)); }
    if (smp) { const float* s0 = X.in[4] + ((((size_t)bs * NL + l) * 2 + 1) * 8 + hd) * 16384;
#pragma unroll
        for (int q = 0; q < 8; ++q)
#pragma unroll
            for (int k = 0; k < 4; ++k) R[q][k] = s0[(size_t)(dseg + q * 4 + k) * 128 + e_]; }
    else {
#pragma unroll
        for (int q = 0; q < 8; ++q) R[q] = (f32x4){0.f, 0.f, 0.f, 0.f}; }
#pragma unroll 1
    for (int jj = nc - 1; jj > jc; --jj) { const float* sp = stb + ((size_t)((n0 + jj) * 8 + hd) * 2 + 1) * 16384 + e_ * 128 + dseg;
#pragma unroll
        for (int q = 0; q < 8; ++q) R[q] = R[q] * gcb + *(const f32x4*)(sp + q * 4); }
#pragma unroll
    for (int q = 0; q < 4; ++q) { u32x4 o; o.x = cvt_pk(R[2 * q][0], R[2 * q][1]); o.y = cvt_pk(R[2 * q][2], R[2 * q][3]); o.z = cvt_pk(R[2 * q + 1][0], R[2 * q + 1][1]); o.w = cvt_pk(R[2 * q + 1][2], R[2 * q + 1][3]);
        *(LAS u32x4*)(B3 + e_ * PB + (dseg + q * 8) * 2) = o; }
    if (!smp && jc == 0) {
        const float* sp = stb + ((size_t)(n * 8 + hd) * 2 + 1) * 16384 + e_ * 128 + dseg; float* o = X.out + OUT_RET + ((((size_t)bs * NL + l) * 2 + 1) * 8 + hd) * 16384;
#pragma unroll
        for (int q = 0; q < 8; ++q) { const f32x4 f = R[q] * gcb + *(const f32x4*)(sp + q * 4);
#pragma unroll
            for (int k = 0; k < 4; ++k) o[(size_t)(dseg + q * 4 + k) * 128 + e_] = f[k]; } }
    __syncthreads();
    ac[0] = (f32x16)(0.f); ac[1] = (f32x16)(0.f);
    mma128(B0, B3, ac, wr, wc, lane);
    LAS float* Os = (LAS float*)(lds + BUFB);
#pragma unroll
    for (int t = 0; t < 2; ++t)
#pragma unroll
        for (int r = 0; r < 16; ++r) { const int i = 32 * wr + crow(r, hi); Os[i * PO + cb + 32 * t] = ao[t][r] + ac[t][r] * exp2f(lgb * (float)(128 - i)); }
    __syncthreads();
    { const int p = tid >> 2, cseg = (tid & 3) * 32; f32x4 v[8]; float s = 0.f;
#pragma unroll
      for (int q = 0; q < 8; ++q) { v[q] = *(const LAS f32x4*)(Os + p * PO + cseg + q * 4); s += v[q][0] + v[q][1] + v[q][2] + v[q][3]; }
      s += __shfl_xor(s, 1); s += __shfl_xor(s, 2); const float mu = s * (1.f / 128.f); float s2 = 0.f;
#pragma unroll
      for (int q = 0; q < 8; ++q) { v[q] = v[q] - mu; s2 += v[q][0] * v[q][0] + v[q][1] * v[q][1] + v[q][2] * v[q][2] + v[q][3] * v[q][3]; }
      s2 += __shfl_xor(s2, 1); s2 += __shfl_xor(s2, 2); const float rs = rsqrtf(s2 * (1.f / 128.f) + EPSN);
      const bf16_t* gp = z + (size_t)(tok0 + p) * ZW + Z_GPR + hd * 128 + cseg; const float* gr = X.in[20] + l * 1024 + hd * 128 + cseg;
      bf16_t* op = WSP(bf16_t, O_AR) + (size_t)(tok0 + p) * 1024 + hd * 128 + cseg;
#pragma unroll
      for (int q = 0; q < 4; ++q) { const u32x4 gg = *(const u32x4*)(gp + q * 8); const f32x4 g0 = *(const f32x4*)(gr + q * 8), g1 = *(const f32x4*)(gr + q * 8 + 4); const f32x4 a = v[2 * q] * rs * g0, b = v[2 * q + 1] * rs * g1;
          u32x4 o; o.x = cvt_pk(a[0] * bflo(gg.x), a[1] * bfhi(gg.x)); o.y = cvt_pk(a[2] * bflo(gg.y), a[3] * bfhi(gg.y)); o.z = cvt_pk(b[0] * bflo(gg.z), b[1] * bfhi(gg.z)); o.w = cvt_pk(b[2] * bflo(gg.w), b[3] * bfhi(gg.w));
          *(u32x4*)(op + q * 8) = o; } }
    __syncthreads();
}
constexpr int KPB = 400;
constexpr int VPB = 272;
constexpr int ATT_KB = 128 * KPB;
__device__ __forceinline__ float xmax16(float x) { const unsigned u = __float_as_uint(x); auto r = __builtin_amdgcn_permlane16_swap(u, u, false, false); return fmaxf(__uint_as_float(r[0]), __uint_as_float(r[1])); }
__device__ __forceinline__ float xmax32(float x) { const unsigned u = __float_as_uint(x); auto r = __builtin_amdgcn_permlane32_swap(u, u, false, false); return fmaxf(__uint_as_float(r[0]), __uint_as_float(r[1])); }
__device__ __forceinline__ float xsum16(float x) { const unsigned u = __float_as_uint(x); auto r = __builtin_amdgcn_permlane16_swap(u, u, false, false); return __uint_as_float(r[0]) + __uint_as_float(r[1]); }
__device__ __forceinline__ float xsum32(float x) { const unsigned u = __float_as_uint(x); auto r = __builtin_amdgcn_permlane32_swap(u, u, false, false); return __uint_as_float(r[0]) + __uint_as_float(r[1]); }
__device__ __forceinline__ void attn_unit(const Ctx& X, LAS unsigned char* lds, int l, int unit) {
    int tid_ = X.tid; asm volatile("" : "+v"(tid_));
    const int tid = tid_, lane = tid & 63, wave = tid >> 6, qi = lane & 15, g = lane >> 4;
    int tokb, ncache, nnew, hd, qb, bc = 0;
    if (unit < 256) { bc = unit >> 7; hd = (unit >> 4) & 7; qb = unit & 15; tokb = 4096 + bc * 2048; ncache = 256; nnew = 2048; }
    else { const int r = unit - 256; const int s = r >> 4; hd = (r >> 1) & 7; qb = r & 1; tokb = s * 256; ncache = 0; nnew = 256; }
    const int nct = ncache >> 7, ntile = (ncache + nnew) >> 7;
    const bf16_t* KN = WSP(bf16_t, O_KN); const bf16_t* KR = WSP(bf16_t, O_KR); const bf16_t* VT = WSP(bf16_t, O_VT);
    const bf16_t* KC = WSP(bf16_t, O_KC) + (size_t)l * 512 * 1024; const bf16_t* KRC = WSP(bf16_t, O_KRC) + (size_t)l * 512 * 64; const bf16_t* VTC = WSP(bf16_t, O_VTC) + (size_t)l * 1024 * 512;
    const int tokq = tokb + qb * 128 + wave * 16 + qi;
    bf16x8 qf[6];
    { const bf16_t* qp = WSP(bf16_t, O_Q) + (size_t)tokq * 1536 + hd * 192 + g * 8;
#pragma unroll
      for (int s = 0; s < 6; ++s) qf[s] = *(const bf16x8*)(qp + s * 32); }
    LAS unsigned char* kb = lds; LAS unsigned char* vb = lds + ATT_KB;
    u32x4 sk[4], sr[2], sv[4];
#define ATT_LOAD(j) do { const int _j = (j); const bf16_t *kn_, *kr_, *vt_; size_t ldv_; \
        if (_j < nct) { const int r0 = bc * 256 + _j * 128; kn_ = KC + (size_t)r0 * 1024 + hd * 128; kr_ = KRC + (size_t)r0 * 64; vt_ = VTC + (size_t)(hd * 128) * 512 + r0; ldv_ = 512; } \
        else { const int r0 = tokb + (_j - nct) * 128; kn_ = KN + (size_t)r0 * 1024 + hd * 128; kr_ = KR + (size_t)r0 * 64; vt_ = VT + (size_t)(hd * 128) * T + r0; ldv_ = T; } \
        _Pragma("unroll") for (int i = 0; i < 4; ++i) { const int c = tid + i * NTHREADS; sk[i] = *(const u32x4*)(kn_ + (size_t)(c >> 4) * 1024 + (c & 15) * 8); sv[i] = *(const u32x4*)(vt_ + (size_t)(c >> 4) * ldv_ + (c & 15) * 8); } \
        _Pragma("unroll") for (int i = 0; i < 2; ++i) { const int c = tid + i * NTHREADS; sr[i] = *(const u32x4*)(kr_ + (size_t)(c >> 3) * 64 + (c & 7) * 8); } } while (0)
#define ATT_STORE() do { \
        _Pragma("unroll") for (int i = 0; i < 4; ++i) { const int c = tid + i * NTHREADS; *(LAS u32x4*)(kb + (c >> 4) * KPB + (c & 15) * 16) = sk[i]; *(LAS u32x4*)(vb + (c >> 4) * VPB + (c & 15) * 16) = sv[i]; } \
        _Pragma("unroll") for (int i = 0; i < 2; ++i) { const int c = tid + i * NTHREADS; *(LAS u32x4*)(kb + (c >> 3) * KPB + 256 + (c & 7) * 16) = sr[i]; } } while (0)
    f32x4 O[8];
#pragma unroll
    for (int u = 0; u < 8; ++u) O[u] = (f32x4){0.f, 0.f, 0.f, 0.f};
    float mrun = -INFINITY, lrun = 0.f;
    ATT_LOAD(0); ATT_STORE();
    __syncthreads();
    for (int j = 0; j < ntile; ++j) {
        if (j + 1 < ntile) ATT_LOAD(j + 1);
        f32x4 S[8];
#pragma unroll
        for (int t = 0; t < 8; ++t) { S[t] = (f32x4){0.f, 0.f, 0.f, 0.f};
#pragma unroll
            for (int s = 0; s < 6; ++s) { const bf16x8 a = *(const LAS bf16x8*)(kb + (16 * t + qi) * KPB + (32 * s + 8 * g) * 2);
                S[t] = __builtin_amdgcn_mfma_f32_16x16x32_bf16(a, qf[s], S[t], 0, 0, 0); } }
        float mx = S[0][0];
#pragma unroll
        for (int t = 0; t < 8; ++t)
#pragma unroll
            for (int i = 0; i < 4; ++i) mx = fmaxf(mx, S[t][i]);
        mx = xmax32(xmax16(mx));
        const float mnew = fmaxf(mrun, mx), alpha = __builtin_amdgcn_exp2f(mrun - mnew); mrun = mnew;
        float ps = 0.f;
#pragma unroll
        for (int t = 0; t < 8; ++t)
#pragma unroll
            for (int i = 0; i < 4; ++i) { S[t][i] = __builtin_amdgcn_exp2f(S[t][i] - mnew); ps += S[t][i]; }
        ps = xsum32(xsum16(ps));
        lrun = lrun * alpha + ps;
#pragma unroll
        for (int u = 0; u < 8; ++u) O[u] = O[u] * alpha;
#pragma unroll
        for (int c = 0; c < 4; ++c) {
            u32x4 pw; pw.x = cvt_pk(S[2 * c][0], S[2 * c][1]); pw.y = cvt_pk(S[2 * c][2], S[2 * c][3]); pw.z = cvt_pk(S[2 * c + 1][0], S[2 * c + 1][1]); pw.w = cvt_pk(S[2 * c + 1][2], S[2 * c + 1][3]);
            const bf16x8 pb = __builtin_bit_cast(bf16x8, pw);
#pragma unroll
            for (int u = 0; u < 8; ++u) { const LAS unsigned char* vp = vb + (16 * u + qi) * VPB + (32 * c + 4 * g) * 2;
                const u32x2 lo = *(const LAS u32x2*)vp, hi2 = *(const LAS u32x2*)(vp + 32);
                u32x4 aw; aw.x = lo.x; aw.y = lo.y; aw.z = hi2.x; aw.w = hi2.y;
                O[u] = __builtin_amdgcn_mfma_f32_16x16x32_bf16(__builtin_bit_cast(bf16x8, aw), pb, O[u], 0, 0, 0); } }
        __syncthreads();
        if (j + 1 < ntile) { ATT_STORE(); __syncthreads(); }
    }
    { const float il = 1.f / lrun; const bf16_t* gp = WSP(bf16_t, O_Z) + (size_t)tokq * ZW + Z_GPM + hd * 128 + 4 * g; bf16_t* op = WSP(bf16_t, O_AM) + (size_t)tokq * 1024 + hd * 128 + 4 * g;
#pragma unroll
      for (int u = 0; u < 8; ++u) { const u32x2 gg = *(const u32x2*)(gp + 16 * u); u32x2 o;
          o.x = cvt_pk(O[u][0] * il * bflo(gg.x), O[u][1] * il * bfhi(gg.x)); o.y = cvt_pk(O[u][2] * il * bflo(gg.y), O[u][3] * il * bfhi(gg.y));
          *(u32x2*)(op + 16 * u) = o; } }
#undef ATT_LOAD
#undef ATT_STORE
}
constexpr int NPHASE = 2 + 6 * NL;
#define REOPAQUE(X) do { unsigned long long w_ = (unsigned long long)args.ws, o_ = (unsigned long long)args.out, i_ = (unsigned long long)__builtin_amdgcn_kernarg_segment_ptr(); int t_ = threadIdx.x, c_ = blockIdx.x, g_ = gridDim.x; \
    asm volatile("" : "+s"(w_), "+s"(o_), "+s"(i_), "+v"(t_), "+s"(c_), "+s"(g_)); X.ws = (unsigned char*)(GAS unsigned char*)w_; X.out = (float*)(GAS float*)o_; X.in.p = (CPtr64)i_; X.tid = t_; X.c = c_; X.G = g_; } while (0)
#ifndef RPTM
#define RPTM 0
#endif
#define NREP(k) ((((RPTM) >> (k)) & 1) + 1)
#ifndef PHM
#define PHM 0xffff
#endif
__global__ void __launch_bounds__(NTHREADS, 2) mk_fwd(Args args) {
    extern __shared__ __attribute__((aligned(16))) unsigned char lds_raw[];
    LAS unsigned char* lds = (LAS unsigned char*)lds_raw;
    cg::grid_group grid = cg::this_grid();
    volatile LAS unsigned* bst = (volatile LAS unsigned*)(lds + LDS_BYTES - 64);
    if (threadIdx.x < 16) bst[threadIdx.x] = 0u;
    __syncthreads();
    XcdBarrier xbar = xcd_barrier_post((unsigned*)(args.ws + O_BAR), bst);
    for (int ph = args.ph_lo; ph < args.ph_hi; ++ph) {
        Ctx X; REOPAQUE(X);
        const int tid = X.tid;
        const char* ws = (const char*)X.ws;
        if (ph == 0) { for (int rep = 0; rep < NREP(0); ++rep) if (PHM & 1) phase_prologue(X, lds); }
        else if (ph == 1) { for (int rep = 0; rep < NREP(1); ++rep) {
            SchedC S{ws + O_CKVC, ws + O_WKP, ws + O_WVP, X.G, X.c}; EpiC E{WSP(bf16_t, O_KC), WSP(bf16_t, O_VTC)};
            if (PHM & 2) pg8::gemm_phase(lds, tid, 512, 512, 512, S, E);
            REOPAQUE(X); if (PHM & 4) phase_rows(X, 0, false, 0); }
        } else {
            const int l = (ph - 2) / 6, sp = (ph - 2) % 6;
            if (sp == 0) { for (int rep = 0; rep < NREP(2); ++rep) {
                SchedZ S{ws + O_H, ws + O_WIN + (size_t)l * ZW * 2048 * 2, X.G, X.c}; EpiZ E{WSP(bf16_t, O_Z), WSP(bf16_t, O_VST), WSP(bf16_t, O_RVT), WSP(float, O_RSS), rep == 0};
                if (PHM & 8) pg8::gemm_phase(lds, tid, 2048, 2048, 2048, S, E); }
            } else if (sp == 1) { for (int rep = 0; rep < NREP(3); ++rep) {
                { SchedQK S{ws + O_Z, ws + O_WUQ + (size_t)l * 1536 * 512 * 2, ws + O_WKG + (size_t)l * 1024 * 512 * 2, X.G, X.c}; EpiQK E{WSP(bf16_t, O_Q), WSP(bf16_t, O_KN), WSP(float, O_RSS), WSP(float, O_ROPE)};
                  if (PHM & 16) pg8::gemm_phase(lds, tid, 512, ZW, 512, S, E); }
                { SchedVT S{ws + O_Z, ws + O_WVG + (size_t)l * 1024 * 512 * 2, X.G, X.G - 1 - X.c};     EpiVT E{WSP(bf16_t, O_VT), WSP(float, O_RSS)};
                  if (PHM & 32) pg8::gemm_phase(lds, tid, 512, 512, ZW, S, E); }
                REOPAQUE(X); if (PHM & 64) phase_misc(X, l);
                REOPAQUE(X);
                for (int it = X.G - 1 - X.c; it < 512; it += X.G) if (PHM & 128) sgu_item(X, lds, l, it);
                REOPAQUE(X);
                for (int it = X.G - 1 - X.c; it < 512; it += X.G) if (PHM & 256) retstate_item(X, lds, l, it); }
            } else if (sp == 2) { for (int rep = 0; rep < NREP(4); ++rep) {
                for (int i = X.c * NTHREADS + tid; i < T; i += X.G * NTHREADS) WSP(float, O_RSS)[3 * T + i] = 0.f;
                for (int r2 = 0; r2 < NREP(7); ++r2)
                for (int it = X.c; it < 512; it += X.G) if (PHM & 512) {
                    const int x = it & 7, slot = (it & 255) >> 3;
                    const int un = it < 256 ? (((x * 2 + (slot >> 4)) << 4) | (slot & 15)) : 256 + (((x * 16 + (slot >> 1)) << 1) | (slot & 1));
                    attn_unit(X, lds, l, un); }
                REOPAQUE(X);
                for (int r2 = 0; r2 < NREP(8); ++r2)
                for (int it = X.c; it < 512; it += X.G) if (PHM & 1024) retout_item(X, lds, l, (it < 256) ? 256 + it : it - 256); }
            } else if (sp == 3) { for (int rep = 0; rep < NREP(5); ++rep) {
                SchedBr S{ws + O_AM, ws + O_AS, ws + O_AR, ws + O_WBR + (size_t)l * 3 * 2048 * 1024 * 2, X.G, X.c}; EpiBr E{WSP(bf16_t, O_Z), WSP(bf16_t, O_YMB)};
                if (PHM & 2048) pg8::gemm_phase(lds, tid, 1024, 1024, 1024, S, E); }
            } else if (sp == 4) { for (int rep = 0; rep < NREP(6); ++rep) {
                for (int i = X.c * NTHREADS + tid; i < 3 * T; i += X.G * NTHREADS) WSP(float, O_RSS)[i] = 0.f;
                SchedOut S{ws + O_YMB, ws + O_WOUT + (size_t)l * 2048 * 2048 * 2, X.G, X.c}; EpiOut E{WSP(float, O_Y), WSP(float, O_RSS), rep == 0};
                if (PHM & 4096) pg8::gemm_phase(lds, tid, 2048, 2048, 2048, S, E); }
            } else {
                if (PHM & 8192) phase_rows(X, l, true, l + 1);
            }
        }
        if (ph + 1 < args.ph_hi) { if (ph == 0) { __syncthreads(); grid.sync(); } else { REOPAQUE(X); xbar.bar = (unsigned*)(X.ws + O_BAR); xcd_barrier(xbar); } }
    }
}

extern "C" void kernel_launch(void* const* d_in, const int* in_sizes, int n_in, void* d_out, int out_size, void* d_ws, size_t ws_size, hipStream_t stream) {
    static int grid = 0;
    if (grid == 0) {
        if (n_in != 25 || ws_size < WS_END) { fprintf(stderr, "kernel_launch: unexpected n_in %d / ws %zu (need %zu)\n", n_in, ws_size, (size_t)WS_END); grid = -1; return; }
        int dev = 0, cus = 0, per_cu = 0;
        (void)hipGetDevice(&dev); (void)hipDeviceGetAttribute(&cus, hipDeviceAttributeMultiprocessorCount, dev);
        (void)hipFuncSetAttribute((const void*)mk_fwd, hipFuncAttributeMaxDynamicSharedMemorySize, LDS_BYTES);
        (void)hipOccupancyMaxActiveBlocksPerMultiprocessor(&per_cu, (const void*)mk_fwd, NTHREADS, LDS_BYTES);
        if (per_cu < 1) { fprintf(stderr, "kernel_launch: occupancy query says %d blocks per CU\n", per_cu); per_cu = 1; }
        grid = cus * per_cu;
    }
    if (grid < 0) return;
    Args a{};
    for (int i = 0; i < 25; ++i) a.in[i] = (const float*)d_in[i];
    a.out = (float*)d_out; a.ws = (unsigned char*)d_ws;
#if MK_MULTI
    for (int ph = 0; ph < NPHASE; ++ph) { a.ph_lo = ph; a.ph_hi = ph + 1; hipLaunchKernelGGL(mk_fwd, dim3(grid), dim3(NTHREADS), LDS_BYTES, stream, a); }
#else
    a.ph_lo = 0; a.ph_hi = NPHASE;
    (void)hipMemsetAsync((unsigned char*)d_ws + O_BAR, 0, 16384, stream);
    void* kargs[] = {&a};
    hipError_t e = hipLaunchCooperativeKernel((const void*)mk_fwd, dim3(grid), dim3(NTHREADS), kargs, LDS_BYTES, stream);
    if (e != hipSuccess) fprintf(stderr, "cooperative launch failed: %s (grid %d)\n", hipGetErrorString(e), grid);
#endif
}
```

```cpp
#define MK_MULTI 0
#define RPTM 0
#define PROBE_SP -1
#include <hip/hip_runtime.h>
#include <hip/hip_cooperative_groups.h>
#include <cstdio>
namespace cg = cooperative_groups;

#define LAS __attribute__((address_space(3)))
#define GAS __attribute__((address_space(1)))
typedef unsigned short bf16_t;
typedef short bf16x8 __attribute__((ext_vector_type(8)));
typedef float f32x4 __attribute__((ext_vector_type(4)));
typedef float f32x16 __attribute__((ext_vector_type(16)));
typedef unsigned u32x4 __attribute__((ext_vector_type(4)));
typedef unsigned u32x2 __attribute__((ext_vector_type(2)));

constexpr int NTHREADS = 512;
constexpr int LDS_BYTES = 147456;
constexpr int T = 8192, DM = 2048, ZW = 15616, NL = 4, INC = 15424;
constexpr float EPSN = 1e-6f;
constexpr int Z_CQ = 0, Z_CKV = 512, Z_GPM = 1024, Z_U = 2048, Z_VS = 3072, Z_GPS = 4096, Z_RQ = 5120, Z_RK = 6144, Z_RV = 7168, Z_GPR = 8192, Z_MRG = 9216, Z_KR = 15360;
constexpr size_t OUT_YP = 0, OUT_YS = 8388608, OUT_CKV = 16777216, OUT_KR = 25165824, OUT_RET = 26214400;

constexpr size_t O_WIN = 0,                         S_WIN = (size_t)NL * ZW * 2048 * 2;
constexpr size_t O_WUQ = O_WIN + S_WIN,             S_WUQ = (size_t)NL * 1536 * 512 * 2;
constexpr size_t O_WKG = O_WUQ + S_WUQ,             S_WK = (size_t)NL * 1024 * 512 * 2;
constexpr size_t O_WVG = O_WKG + S_WK;
constexpr size_t O_WKP = O_WVG + S_WK;
constexpr size_t O_WVP = O_WKP + S_WK;
constexpr size_t O_WBR = O_WVP + S_WK,              S_WBR = (size_t)NL * 3 * 2048 * 1024 * 2;
constexpr size_t O_WOUT = O_WBR + S_WBR,            S_WOUT = (size_t)NL * 2048 * 2048 * 2;
constexpr size_t O_CKVC = O_WOUT + S_WOUT,          S_CKVC = (size_t)NL * 512 * 512 * 2;
constexpr size_t O_KRC = O_CKVC + S_CKVC,           S_KRC = (size_t)NL * 512 * 64 * 2;
constexpr size_t O_KC = O_KRC + S_KRC,              S_KC = (size_t)NL * 512 * 1024 * 2;
constexpr size_t O_VTC = O_KC + S_KC;
constexpr size_t O_MOD = O_VTC + S_KC,              S_MOD = (size_t)NL * 3 * 6144 * 4;
constexpr size_t O_ROPE = O_MOD + S_MOD,            S_ROPE = 64 * 16 * 8;
constexpr size_t O_RSS = O_ROPE + S_ROPE,           S_RSS = (size_t)4 * T * 4;
constexpr size_t O_H = O_RSS + S_RSS,               S_H = (size_t)T * DM * 2;
constexpr size_t O_X = O_H + S_H,                   S_X = (size_t)T * DM * 4;
constexpr size_t O_Z = O_X + S_X,                   S_Z = (size_t)T * ZW * 2;
constexpr size_t O_VST = O_Z + S_Z,                 S_T16 = (size_t)1024 * T * 2;
constexpr size_t O_RVT = O_VST + S_T16;
constexpr size_t O_VT = O_RVT + S_T16;
constexpr size_t O_KN = O_VT + S_T16;
constexpr size_t O_AM = O_KN + S_T16;
constexpr size_t O_AS = O_AM + S_T16;
constexpr size_t O_AR = O_AS + S_T16;
constexpr size_t O_Q = O_AR + S_T16,                S_Q = (size_t)T * 1536 * 2;
constexpr size_t O_KR = O_Q + S_Q,                  S_KR = (size_t)T * 64 * 2;
constexpr size_t O_ST = O_KR + S_KR,                S_ST = (size_t)64 * 8 * 2 * 16384 * 4;
constexpr size_t O_YMF = O_ST + S_ST;
constexpr size_t O_YMB = O_YMF + S_X;
constexpr size_t O_Y = O_YMB + S_H;
constexpr size_t O_PF = O_Y + S_X,                  S_PF = (size_t)64 * 8 * 2 * 16384 * 2;
constexpr size_t O_BAR = O_PF + S_PF;
constexpr size_t WS_END = O_BAR + 16384;

struct Args { const float* in[25]; float* out; unsigned char* ws; int ph_lo, ph_hi; };

__device__ __forceinline__ unsigned cvt_pk(float lo, float hi) { unsigned r; asm volatile("v_cvt_pk_bf16_f32 %0, %1, %2" : "=v"(r) : "v"(lo), "v"(hi)); return r; }
__device__ __forceinline__ float bf2f(unsigned short b) { return __uint_as_float(((unsigned)b) << 16); }
__device__ __forceinline__ float bflo(unsigned w) { return __uint_as_float(w << 16); }
__device__ __forceinline__ float bfhi(unsigned w) { return __uint_as_float(w & 0xffff0000u); }
__device__ __forceinline__ float sigm_f(float x) { return __builtin_amdgcn_rcpf(1.f + __builtin_amdgcn_exp2f(x * -1.4426950408889634f)); }
__device__ __forceinline__ float silu_f(float x) { return x * sigm_f(x); }
__device__ __forceinline__ float wave_sum(float v) {
#pragma unroll
    for (int o = 1; o < 64; o <<= 1) v += __shfl_xor(v, o);
    return v;
}

namespace pg8 {
constexpr int BM = 256, BK = 64, HALF = 128, HTB = HALF * BK * 2, STAGE_BYTES = 8 * HTB, NXCD = 8, WGM = 8;
__host__ __device__ __forceinline__ int lds_byte(int r, int c) { const int st = (r >> 4) * 2 + (c >> 5), rr = r & 15, cc = c & 31, ob = rr * 64 + cc * 2; return st * 1024 + (ob ^ (((ob >> 9) & 1) << 5)); }
__host__ __device__ __forceinline__ void stage_rc(int b, int& R, int& C) { const int st = b / 1024, sb = b % 1024, swz = sb ^ (((sb >> 9) & 1) << 5); R = (st >> 1) * 16 + swz / 64; C = (st & 1) * 32 + (swz % 64) / 2; }
__host__ __device__ __forceinline__ int perm32(int rho) { const int n = rho >> 4, i = rho & 15; return 8 * (i >> 2) + 4 * n + (i & 3); }

struct Unit { const char* a; const char* b; int pm, pn, kind, aux; };

__device__ __forceinline__ void tile_order(int L, int nM, int nN, int& pm, int& pn) {
    const int nwg = nM * nN; int wgid = L; { const int q = nwg / NXCD, r = nwg % NXCD, xcd = wgid % NXCD, off = wgid / NXCD; wgid = (xcd < r ? xcd * (q + 1) : r * (q + 1) + (xcd - r) * q) + off; }
    const int nig = WGM * nN, gid = wgid / nig, fm = gid * WGM, gsz = (nM - fm) < WGM ? (nM - fm) : WGM;
    pm = fm + ((wgid % nig) % gsz); pn = (wgid % nig) / gsz;
}

template <class Epi, class Sched>
__device__ __forceinline__ void gemm_phase(LAS unsigned char* lds, const int tid, const int K, const int lda, const int ldb, const Sched& S, const Epi& E) {
    const int  wid = __builtin_amdgcn_readfirstlane(tid >> 6), lane = tid & 63, wr = wid >> 2, wc = wid & 3, fr = lane & 15, fq = lane >> 4;
    const int nt = K / BK;
    unsigned voffA[2], voffB[2];
#pragma unroll
    for (int i = 0; i < 2; ++i) { int R, C; stage_rc(tid * 16 + i * 8192, R, C); const int Rb = (R & ~31) + perm32(R & 31);
        voffA[i] = (unsigned)(R * lda + C) * 2u; voffB[i] = (unsigned)(Rb * ldb + C) * 2u; }
    const size_t kstep = (size_t)(BK * 2);
    const size_t hstepA = (size_t)HALF * lda * 2, hstepB = (size_t)HALF * ldb * 2;
    const unsigned ldsw = (unsigned)wid * 1024u;
    const int aoff = lds_byte(wr * 64 + fr, fq * 8), boff = lds_byte(wc * 32 + fr, fq * 8);
#define PG8_SA(b, h) (((b) * 2 + (h)) * HTB)
#define PG8_SB(b, h) ((4 + (b) * 2 + (h)) * HTB)
#define PG8_STAGE(bufoff, gbase, voff) do { _Pragma("unroll") for (int _i = 0; _i < 2; ++_i) \
        __builtin_amdgcn_global_load_lds((const unsigned*)((const char*)(gbase) + (voff)[_i]), (LAS unsigned*)(lds + (bufoff) + ldsw + _i * 8192), 16, 0, 0); } while (0)
#define PG8_LDA(dst, b, h) do { _Pragma("unroll") for (int m = 0; m < 4; ++m) _Pragma("unroll") for (int k = 0; k < 2; ++k) dst[m][k] = *(const LAS bf16x8*)(lds + PG8_SA(b, h) + aoff + m * 2048 + k * 1024); } while (0)
#define PG8_LDB(dst, b, h) do { _Pragma("unroll") for (int n = 0; n < 2; ++n) _Pragma("unroll") for (int k = 0; k < 2; ++k) dst[n][k] = *(const LAS bf16x8*)(lds + PG8_SB(b, h) + boff + n * 2048 + k * 1024); } while (0)
#define PG8_MMA(ai, bj, At, Bt) do { __builtin_amdgcn_s_setprio(1); _Pragma("unroll") for (int m = 0; m < 4; ++m) _Pragma("unroll") for (int n = 0; n < 2; ++n) _Pragma("unroll") for (int k = 0; k < 2; ++k) \
        acc[ai][bj][m][n] = __builtin_amdgcn_mfma_f32_16x16x32_bf16(Bt[n][k], At[m][k], acc[ai][bj][m][n], 0, 0, 0); __builtin_amdgcn_s_setprio(0); } while (0)
#define PG8_WAIT_V(n) asm volatile("s_waitcnt vmcnt(" #n ")" ::: "memory")
#define PG8_WAIT_L(n) asm volatile("s_waitcnt lgkmcnt(" #n ")" ::: "memory")
#define PG8_BAR __builtin_amdgcn_s_barrier()
#define PG8_SCHED __builtin_amdgcn_sched_barrier(0)
    Unit cur, nxt; int ui = 0;
    if (!S.next(0, cur)) return;
    f32x4 acc[2][2][4][2];
#pragma unroll
    for (int a = 0; a < 2; ++a)
#pragma unroll
        for (int b = 0; b < 2; ++b)
#pragma unroll
            for (int m = 0; m < 4; ++m)
#pragma unroll
                for (int n = 0; n < 2; ++n) acc[a][b][m][n] = (f32x4){0.f, 0.f, 0.f, 0.f};
    bf16x8 At[4][2], B0[2][2], B1[2][2];
    const char* cA = cur.a; const char* cB = cur.b;
    PG8_STAGE(PG8_SB(0, 0), cB, voffB); PG8_STAGE(PG8_SA(0, 0), cA, voffA); PG8_STAGE(PG8_SB(0, 1), cB + hstepB, voffB); PG8_STAGE(PG8_SA(0, 1), cA + hstepA, voffA);
    if (wr == 1) PG8_BAR;
    PG8_WAIT_V(4); PG8_BAR;
    PG8_STAGE(PG8_SB(1, 0), cB + kstep, voffB); PG8_STAGE(PG8_SA(1, 0), cA + kstep, voffA); PG8_STAGE(PG8_SB(1, 1), cB + hstepB + kstep, voffB);
    PG8_WAIT_V(6); PG8_BAR;
    for (;;) {
        const bool has_next = S.next(ui + 1, nxt);
        const char* nA = has_next ? nxt.a : cA; const char* nB = has_next ? nxt.b : cB;
        for (int t = 0; t < nt; t += 2) {
            const bool last = (t == nt - 2);
            const char* a1 = cA + (size_t)(t + 1) * kstep;
            const char* a2 = last ? nA : cA + (size_t)(t + 2) * kstep; const char* b2 = last ? nB : cB + (size_t)(t + 2) * kstep;
            const char* a3 = a2 + kstep; const char* b3 = b2 + kstep;
            PG8_LDB(B0, 0, 0); PG8_SCHED; PG8_LDA(At, 0, 0); PG8_STAGE(PG8_SA(1, 1), a1 + hstepA, voffA);
            PG8_WAIT_L(8); PG8_BAR; PG8_WAIT_L(0); PG8_MMA(0, 0, At, B0); PG8_BAR; PG8_SCHED;
            PG8_LDB(B1, 0, 1); PG8_STAGE(PG8_SB(0, 0), b2, voffB);
            PG8_BAR; PG8_WAIT_L(0); PG8_MMA(0, 1, At, B1); PG8_BAR;
            PG8_LDA(At, 0, 1); PG8_STAGE(PG8_SA(0, 0), a2, voffA);
            PG8_BAR; PG8_WAIT_L(0); PG8_MMA(1, 0, At, B0); PG8_BAR; PG8_SCHED;
            PG8_STAGE(PG8_SB(0, 1), b2 + hstepB, voffB);
            PG8_WAIT_V(6); PG8_BAR; PG8_MMA(1, 1, At, B1); PG8_BAR;
            PG8_LDB(B0, 1, 0); PG8_SCHED; PG8_LDA(At, 1, 0); PG8_STAGE(PG8_SA(0, 1), a2 + hstepA, voffA);
            PG8_WAIT_L(8); PG8_BAR; PG8_WAIT_L(0); PG8_MMA(0, 0, At, B0); PG8_BAR; PG8_SCHED;
            PG8_LDB(B1, 1, 1); PG8_STAGE(PG8_SB(1, 0), b3, voffB);
            PG8_BAR; PG8_WAIT_L(0); PG8_MMA(0, 1, At, B1); PG8_BAR;
            PG8_LDA(At, 1, 1); PG8_STAGE(PG8_SA(1, 0), a3, voffA);
            PG8_BAR; PG8_WAIT_L(0); PG8_MMA(1, 0, At, B0); PG8_BAR; PG8_SCHED;
            PG8_STAGE(PG8_SB(1, 1), b3 + hstepB, voffB);
            PG8_WAIT_V(6); PG8_BAR; PG8_MMA(1, 1, At, B1); PG8_BAR;
        }
        E(acc, cur, wr, wc, fr, fq);
        if (!has_next) break;
        if (cur.aux != 1)
#pragma unroll
        for (int a = 0; a < 2; ++a)
#pragma unroll
            for (int b = 0; b < 2; ++b)
#pragma unroll
                for (int m = 0; m < 4; ++m)
#pragma unroll
                    for (int n = 0; n < 2; ++n) acc[a][b][m][n] = (f32x4){0.f, 0.f, 0.f, 0.f};
        cur = nxt; cA = nA; cB = nB; ++ui;
    }
    PG8_WAIT_V(0);
    if (wr == 0) PG8_BAR;
    PG8_BAR;
#undef PG8_SA
#undef PG8_SB
#undef PG8_STAGE
#undef PG8_LDA
#undef PG8_LDB
#undef PG8_MMA
#undef PG8_WAIT_V
#undef PG8_WAIT_L
#undef PG8_BAR
#undef PG8_SCHED
}
}
typedef f32x4 (&AccRef)[2][2][4][2];

#define XB_TMO      128
#define XB_XCNT(j)  (256  + 64 * (j))
#define XB_XSUB(j)  (1280 + 64 * (j))
#define XB_XGEN(j)  (2304 + 64 * (j))
#define XB_TOP      3328
#define XB_TOPGEN   3392
#define XCD_BAR_WORDS 3456
#define XB_SPIN_CAP (1u << 22)
__device__ __forceinline__ unsigned xb_ld(unsigned* p)              { return __hip_atomic_load(p, __ATOMIC_RELAXED, __HIP_MEMORY_SCOPE_AGENT); }
__device__ __forceinline__ unsigned xb_add(unsigned* p, unsigned v) { return __hip_atomic_fetch_add(p, v, __ATOMIC_RELAXED, __HIP_MEMORY_SCOPE_AGENT); }
__device__ __forceinline__ unsigned xb_xcc_id() { return (unsigned)__builtin_amdgcn_s_getreg((3 << 11) | 20) & 0xFu; }
#define XB_SPIN(cond, bar) do { unsigned _sp = 0; while (cond) { __builtin_amdgcn_s_sleep(1); \
    if ((++_sp & 255u) == 0u) { if (xb_ld(&(bar)[XB_TMO])) break; if (_sp > XB_SPIN_CAP) { atomicAdd(&(bar)[XB_TMO], 1u); break; } } } } while (0)
struct XcdBarrier { unsigned* bar; unsigned x; volatile LAS unsigned* st; };
__device__ __forceinline__ XcdBarrier xcd_barrier_post(unsigned* bar, volatile LAS unsigned* st) {
    XcdBarrier b; b.bar = bar; b.x = xb_xcc_id(); b.st = st;
    if (threadIdx.x == 0) (void)xb_add(&bar[XB_XCNT(b.x)], 1u);
    return b;
}
__device__ __forceinline__ void xcd_barrier_complete(unsigned* bar, unsigned x, unsigned& nloc, unsigned& nx) {
    const unsigned G = gridDim.x * gridDim.y * gridDim.z;
    unsigned sum, cnt, mine, sp = 0u;
    for (;;) {
        sum = 0u; cnt = 0u; mine = 0u;
#pragma unroll
        for (unsigned j = 0; j < 16; ++j) { const unsigned c = xb_ld(&bar[XB_XCNT(j)]); sum += c; cnt += (c > 0u) ? 1u : 0u; }
        mine = xb_ld(&bar[XB_XCNT(x)]);
        if (sum == G) break;
        __builtin_amdgcn_s_sleep(1);
        if ((++sp & 255u) == 0u) { if (xb_ld(&bar[XB_TMO])) break; if (sp > XB_SPIN_CAP) { atomicAdd(&bar[XB_TMO], 1u); break; } }
    }
    nloc = mine > 0u ? mine : 1u; nx = cnt > 0u ? cnt : 1u;
}
__device__ __forceinline__ void xcd_barrier(const XcdBarrier& b) {
    asm volatile("s_waitcnt vmcnt(0)" ::: "memory");
    __syncthreads();
    if (threadIdx.x == 0) {
        unsigned* bar = b.bar;
        __builtin_amdgcn_s_waitcnt(0);
        unsigned nloc = b.st[0], nx = b.st[1];
        if (nloc == 0u) { xcd_barrier_complete(bar, b.x, nloc, nx); b.st[0] = nloc; b.st[1] = nx; }
        const unsigned old = xb_add(&bar[XB_XSUB(b.x)], 1u);
        const unsigned gen = old / nloc;
        if (old + 1u == (gen + 1u) * nloc) {
            __builtin_amdgcn_fence(__ATOMIC_RELEASE, "agent");
            asm volatile("s_waitcnt vmcnt(0)" ::: "memory");
            const unsigned og = xb_add(&bar[XB_TOP], 1u);
            const unsigned tg = og / nx;
            if (og + 1u == (tg + 1u) * nx) xb_add(&bar[XB_TOPGEN], 1u);
            else XB_SPIN(xb_ld(&bar[XB_TOPGEN]) == tg, bar);
            __builtin_amdgcn_fence(__ATOMIC_ACQUIRE, "agent");
            xb_add(&bar[XB_XGEN(b.x)], 1u);
            asm volatile("s_waitcnt vmcnt(0)" ::: "memory");
        } else {
            XB_SPIN(xb_ld(&bar[XB_XGEN(b.x)]) == gen, bar);
            __builtin_amdgcn_fence(__ATOMIC_ACQUIRE, "agent");
            asm volatile("s_waitcnt vmcnt(0)" ::: "memory");
        }
    }
    __syncthreads();
}
using pg8::Unit;
typedef const unsigned long long __attribute__((address_space(4)))* CPtr64;
struct InTab { CPtr64 p; __device__ __forceinline__ const float* operator[](int i) const { return (const float*)(GAS const float*)p[i]; } };
struct Ctx {
    unsigned char* ws; float* out; InTab in;
    int G, c, tid;
};
#define WSP(T_, off) ((T_*)(X.ws + (off)))

struct SchedZ {
    const char* h; const char* w; int G, c, mode;
    __device__ __forceinline__ bool next(int i, Unit& u) const {
        const int ntn = mode ? 37 : 24; const long Lx = (long)i * G + c; if (Lx >= 32 * ntn) return false;
        int pm, pj; pg8::tile_order((int)Lx, 32, ntn, pm, pj);
        const int pn = mode ? (pj < 4 ? 4 + pj : pj < 8 ? 16 + pj : 24 + pj) : (pj < 4 ? pj : pj < 16 ? pj + 4 : pj + 8);
        const char* hp = h + (size_t)pm * 256 * 2048 * 2; const char* wp = w + (size_t)pn * 256 * 2048 * 2;
        const bool sw = (pn >= 12 && pn < 16) || (pn >= 28 && pn < 32);
        u.pm = pm; u.pn = pn; u.kind = sw ? 1 : 0; u.aux = 0; u.a = sw ? wp : hp; u.b = sw ? hp : wp; return true;
    }
};
struct EpiZ {
    bf16_t* z; bf16_t* vsT; bf16_t* rvT; float* rss; bool doss;
    __device__ __forceinline__ void operator()(AccRef acc, const Unit& u, int wr, int wc, int fr, int fq) const {
        if (u.kind == 0) {
            const int pn = u.pn;
            const int act = (pn >= 36 && pn < 60) ? 2 : ((pn >= 4 && pn < 8) || (pn >= 16 && pn < 20) || (pn >= 32 && pn < 36)) ? 1 : (pn >= 24 && pn < 28) ? 3 : 0;
            const int row0 = u.pm * 256 + wr * 64 + fr, col0 = pn * 256 + wc * 32 + 8 * fq;
#pragma unroll
            for (int ai = 0; ai < 2; ++ai)
#pragma unroll
                for (int m = 0; m < 4; ++m) {
                    const int row = row0 + ai * 128 + m * 16; bf16_t* rowp = z + (size_t)row * ZW + col0; float ss = 0.f;
#pragma unroll
                    for (int bj = 0; bj < 2; ++bj) { f32x4 v0 = acc[ai][bj][m][0], v1 = acc[ai][bj][m][1];
                        if (act == 0) { ss += v0[0] * v0[0] + v0[1] * v0[1] + v0[2] * v0[2] + v0[3] * v0[3] + v1[0] * v1[0] + v1[1] * v1[1] + v1[2] * v1[2] + v1[3] * v1[3]; }
                        else if (act == 1) {
#pragma unroll
                            for (int j = 0; j < 4; ++j) { v0[j] = silu_f(v0[j]); v1[j] = silu_f(v1[j]); } }
                        else if (act == 2) {
#pragma unroll
                            for (int j = 0; j < 4; ++j) { v0[j] = fmaxf(sigm_f(v0[j]), 1e-20f); v1[j] = fmaxf(sigm_f(v1[j]), 1e-20f); } }
                        else { v0 = v0 * 0.08838834764831845f; v1 = v1 * 0.08838834764831845f; }
                        u32x4 w; w.x = cvt_pk(v0[0], v0[1]); w.y = cvt_pk(v0[2], v0[3]); w.z = cvt_pk(v1[0], v1[1]); w.w = cvt_pk(v1[2], v1[3]);
                        *(u32x4*)(rowp + bj * 128) = w; }
                    if (pn < 4 && doss) { ss += __shfl_xor(ss, 16); ss += __shfl_xor(ss, 32); if (fq == 0) atomicAdd(rss + (pn >> 1) * T + row, ss); }
                }
        } else {
            const bool isv = u.pn < 16; bf16_t* dst = isv ? vsT : rvT; const int f0 = (u.pn - (isv ? 12 : 28)) * 256 + wr * 64 + fr, tok0 = u.pm * 256 + wc * 32 + 8 * fq;
            float cs[2][2][4];
#pragma unroll
            for (int bj = 0; bj < 2; ++bj)
#pragma unroll
                for (int n = 0; n < 2; ++n)
#pragma unroll
                    for (int j = 0; j < 4; ++j) cs[bj][n][j] = 0.f;
#pragma unroll
            for (int ai = 0; ai < 2; ++ai)
#pragma unroll
                for (int m = 0; m < 4; ++m) { bf16_t* rowp = dst + (size_t)(f0 + ai * 128 + m * 16) * T + tok0;
#pragma unroll
                    for (int bj = 0; bj < 2; ++bj) { const f32x4 v0 = acc[ai][bj][m][0], v1 = acc[ai][bj][m][1];
#pragma unroll
                        for (int j = 0; j < 4; ++j) { cs[bj][0][j] += v0[j] * v0[j]; cs[bj][1][j] += v1[j] * v1[j]; }
                        u32x4 w; w.x = cvt_pk(v0[0], v0[1]); w.y = cvt_pk(v0[2], v0[3]); w.z = cvt_pk(v1[0], v1[1]); w.w = cvt_pk(v1[2], v1[3]);
                        *(u32x4*)(rowp + bj * 128) = w; } }
            if (isv && doss) {
#pragma unroll
                for (int bj = 0; bj < 2; ++bj)
#pragma unroll
                    for (int n = 0; n < 2; ++n)
#pragma unroll
                        for (int j = 0; j < 4; ++j) { float s = cs[bj][n][j]; s += __shfl_xor(s, 1); s += __shfl_xor(s, 2); s += __shfl_xor(s, 4); s += __shfl_xor(s, 8);
                            if (fr == 0) atomicAdd(rss + 2 * T + tok0 + bj * 128 + n * 4 + j, s); }
            }
        }
    }
};

__device__ __forceinline__ int deal_qk(int i, int G, int c) {
    if (G != 256) { const int L = i * G + c; return L < 320 ? L : -1; }
    if (c < 160) return i == 0 ? c : -1;
    const int r = c - 160; if (r < 64) return i < 2 ? 160 + 2 * r + i : -1;
    return i == 0 ? 288 + (r - 64) : -1;
}
__device__ __forceinline__ int deal_vt(int i, int G, int c) {
    if (G != 256) { const int L = i * G + c; return L < 128 ? L : -1; }
    if (c < 160) return -1;
    const int r = c - 160; if (r < 64) return i == 0 ? r : -1;
    return i < 2 ? 64 + 2 * (r - 64) + i : -1;
}
struct SchedQK {
    const char* z; const char* wq; const char* wk; int G, c;
    __device__ __forceinline__ bool next(int i, Unit& u) const {
        const int Lx = deal_qk(i, G, c); if (Lx < 0) return false;
        if (Lx < 192) { u.pm = Lx / 6; u.pn = Lx % 6; u.kind = 0; u.a = z + (size_t)u.pm * 256 * ZW * 2 + Z_CQ * 2; u.b = wq + (size_t)u.pn * 256 * 512 * 2; }
        else { const int r = Lx - 192; u.pm = r / 4; u.pn = r % 4; u.kind = 1; u.a = z + (size_t)u.pm * 256 * ZW * 2 + Z_CKV * 2; u.b = wk + (size_t)u.pn * 256 * 512 * 2; }
        u.aux = 0; return true;
    }
};
constexpr float QSCALE = 0.07216878364870322f * 1.4426950408889634f;
struct EpiQK {
    bf16_t* q; bf16_t* kn; const float* rss; const LAS float* rope;
    __device__ __forceinline__ void operator()(AccRef acc, const Unit& u, int wr, int wc, int fr, int fq) const {
        const int row0 = u.pm * 256 + wr * 64 + fr, col0 = u.pn * 256 + wc * 32 + 8 * fq;
        float rr[2][4];
#pragma unroll
        for (int ai = 0; ai < 2; ++ai)
#pragma unroll
            for (int m = 0; m < 4; ++m) rr[ai][m] = rss[(u.kind == 0 ? 0 : T) + row0 + ai * 128 + m * 16];
        __builtin_amdgcn_sched_barrier(0);
        if (u.kind == 0) {
#pragma unroll
            for (int ai = 0; ai < 2; ++ai)
#pragma unroll
                for (int m = 0; m < 4; ++m) {
                    const int row = row0 + ai * 128 + m * 16; const float ri = rsqrtf(rr[ai][m] * (1.f / 512.f) + EPSN) * QSCALE;
                    const int t = (row - 4096) & 2047;
#pragma unroll
                    for (int bj = 0; bj < 2; ++bj) { f32x4 v0 = acc[ai][bj][m][0] * ri, v1 = acc[ai][bj][m][1] * ri;
                        const int g0 = u.pn * 256 + bj * 128 + wc * 32, off = g0 % 192;
                        if (off >= 128 && row >= 4096) {
                            const int p = (off == 128) ? (t >> 6) : (t & 63); const LAS float* tb = rope + (p * 16 + (fq & 1) * 8) * 2;
                            const float sg = (fq & 2) ? 1.f : -1.f;
#pragma unroll
                            for (int j = 0; j < 4; ++j) { const float p0 = __shfl_xor(v0[j], 32), p1 = __shfl_xor(v1[j], 32);
                                const float c0 = tb[2 * j], s0 = tb[2 * j + 1], c1 = tb[2 * (4 + j)], s1 = tb[2 * (4 + j) + 1];
                                v0[j] = v0[j] * c0 + sg * p0 * s0; v1[j] = v1[j] * c1 + sg * p1 * s1; }
                        }
                        u32x4 w; w.x = cvt_pk(v0[0], v0[1]); w.y = cvt_pk(v0[2], v0[3]); w.z = cvt_pk(v1[0], v1[1]); w.w = cvt_pk(v1[2], v1[3]);
                        *(u32x4*)(q + (size_t)row * 1536 + col0 + bj * 128) = w; }
                }
        } else {
#pragma unroll
            for (int ai = 0; ai < 2; ++ai)
#pragma unroll
                for (int m = 0; m < 4; ++m) {
                    const int row = row0 + ai * 128 + m * 16; const float ri = rsqrtf(rr[ai][m] * (1.f / 512.f) + EPSN);
#pragma unroll
                    for (int bj = 0; bj < 2; ++bj) { const f32x4 v0 = acc[ai][bj][m][0] * ri, v1 = acc[ai][bj][m][1] * ri;
                        u32x4 w; w.x = cvt_pk(v0[0], v0[1]); w.y = cvt_pk(v0[2], v0[3]); w.z = cvt_pk(v1[0], v1[1]); w.w = cvt_pk(v1[2], v1[3]);
                        *(u32x4*)(kn + (size_t)row * 1024 + col0 + bj * 128) = w; }
                }
        }
    }
};

struct SchedVT {
    const char* z; const char* wv; int G, c;
    __device__ __forceinline__ bool next(int i, Unit& u) const {
        const int Lx = deal_vt(i, G, c); if (Lx < 0) return false;
        u.pm = Lx & 3; u.pn = Lx >> 2; u.kind = 0; u.aux = 0; u.a = wv + (size_t)u.pm * 256 * 512 * 2; u.b = z + (size_t)u.pn * 256 * ZW * 2 + Z_CKV * 2; return true;
    }
};
struct EpiVT {
    bf16_t* vt; const float* rss;
    __device__ __forceinline__ void operator()(AccRef acc, const Unit& u, int wr, int wc, int fr, int fq) const {
        const int f0 = u.pm * 256 + wr * 64 + fr, tok0 = u.pn * 256 + wc * 32 + 8 * fq;
        f32x4 ri[2][2];
#pragma unroll
        for (int bj = 0; bj < 2; ++bj)
#pragma unroll
            for (int n = 0; n < 2; ++n)
#pragma unroll
                for (int j = 0; j < 4; ++j) ri[bj][n][j] = rsqrtf(rss[T + tok0 + bj * 128 + n * 4 + j] * (1.f / 512.f) + EPSN);
#pragma unroll
        for (int ai = 0; ai < 2; ++ai)
#pragma unroll
            for (int m = 0; m < 4; ++m) { bf16_t* rowp = vt + (size_t)(f0 + ai * 128 + m * 16) * T + tok0;
#pragma unroll
                for (int bj = 0; bj < 2; ++bj) { const f32x4 v0 = acc[ai][bj][m][0] * ri[bj][0], v1 = acc[ai][bj][m][1] * ri[bj][1];
                    u32x4 w; w.x = cvt_pk(v0[0], v0[1]); w.y = cvt_pk(v0[2], v0[3]); w.z = cvt_pk(v1[0], v1[1]); w.w = cvt_pk(v1[2], v1[3]);
                    *(u32x4*)(rowp + bj * 128) = w; } }
    }
};

struct SchedC {
    const char* cc; const char* wk; const char* wv; int G, c, l;
    __device__ __forceinline__ bool next(int i, Unit& u) const {
        const int r = i * G + c; if (r >= 16) return false;
        u.aux = l;
        if (r < 8) { u.kind = 0; u.pm = r >> 2; u.pn = r & 3; u.a = cc + ((size_t)l * 512 + u.pm * 256) * 512 * 2; u.b = wk + ((size_t)l * 1024 + u.pn * 256) * 512 * 2; }
        else { const int s = r - 8; u.kind = 1; u.pm = s >> 1; u.pn = s & 1; u.a = wv + ((size_t)l * 1024 + u.pm * 256) * 512 * 2; u.b = cc + ((size_t)l * 512 + u.pn * 256) * 512 * 2; }
        return true;
    }
};
struct EpiC {
    bf16_t* kc; bf16_t* vtc;
    __device__ __forceinline__ void operator()(AccRef acc, const Unit& u, int wr, int wc, int fr, int fq) const {
        const int r0 = u.pm * 256 + wr * 64 + fr, c0 = u.pn * 256 + wc * 32 + 8 * fq;
        bf16_t* base = u.kind == 0 ? kc + (size_t)u.aux * 512 * 1024 : vtc + (size_t)u.aux * 1024 * 512; const int ld = u.kind == 0 ? 1024 : 512;
#pragma unroll
        for (int ai = 0; ai < 2; ++ai)
#pragma unroll
            for (int m = 0; m < 4; ++m) { bf16_t* rowp = base + (size_t)(r0 + ai * 128 + m * 16) * ld + c0;
#pragma unroll
                for (int bj = 0; bj < 2; ++bj) { const f32x4 v0 = acc[ai][bj][m][0], v1 = acc[ai][bj][m][1];
                    u32x4 w; w.x = cvt_pk(v0[0], v0[1]); w.y = cvt_pk(v0[2], v0[3]); w.z = cvt_pk(v1[0], v1[1]); w.w = cvt_pk(v1[2], v1[3]);
                    *(u32x4*)(rowp + bj * 128) = w; } }
    }
};

struct SchedBr {
    const char* am; const char* as; const char* ar; const char* w; int G, c;
    __device__ __forceinline__ bool next(int i, Unit& u) const {
        const int tile = (i / 3) * G + c; if (tile >= 256) return false;
        const int br = i % 3; pg8::tile_order(tile, 32, 8, u.pm, u.pn); u.kind = br; u.aux = br < 2 ? 1 : 0;
        u.a = (br == 0 ? am : br == 1 ? as : ar) + (size_t)u.pm * 256 * 1024 * 2; u.b = w + ((size_t)br * 2048 + u.pn * 256) * 1024 * 2; return true;
    }
};
struct EpiBr {
    const bf16_t* z; bf16_t* ymb;
    __device__ __forceinline__ void operator()(AccRef acc, const Unit& u, int wr, int wc, int fr, int fq) const {
        const int row0 = u.pm * 256 + wr * 64 + fr, col0 = u.pn * 256 + wc * 32 + 8 * fq;
#pragma unroll
        for (int ai = 0; ai < 2; ++ai) {
            u32x4 g0[4][2], g1[4][2];
#pragma unroll
            for (int m = 0; m < 4; ++m)
#pragma unroll
                for (int bj = 0; bj < 2; ++bj) { const bf16_t* mp = z + (size_t)(row0 + ai * 128 + m * 16) * ZW + Z_MRG + u.kind * 2048 + col0 + bj * 128;
                    g0[m][bj] = *(const u32x4*)mp; if (u.kind < 2) g1[m][bj] = *(const u32x4*)(mp + 2048); }
            __builtin_amdgcn_sched_barrier(0);
#pragma unroll
            for (int m = 0; m < 4; ++m) { const int row = row0 + ai * 128 + m * 16;
#pragma unroll
                for (int bj = 0; bj < 2; ++bj) { const int col = col0 + bj * 128;
                    const u32x4 mg = g0[m][bj];
                    f32x4 s0, s1; s0[0] = bflo(mg.x); s0[1] = bfhi(mg.x); s0[2] = bflo(mg.y); s0[3] = bfhi(mg.y); s1[0] = bflo(mg.z); s1[1] = bfhi(mg.z); s1[2] = bflo(mg.w); s1[3] = bfhi(mg.w);
                    if (u.kind < 2) { const u32x4 mn = g1[m][bj];
                        s0[0] *= __builtin_amdgcn_rcpf(bflo(mn.x)); s0[1] *= __builtin_amdgcn_rcpf(bfhi(mn.x)); s0[2] *= __builtin_amdgcn_rcpf(bflo(mn.y)); s0[3] *= __builtin_amdgcn_rcpf(bfhi(mn.y));
                        s1[0] *= __builtin_amdgcn_rcpf(bflo(mn.z)); s1[1] *= __builtin_amdgcn_rcpf(bfhi(mn.z)); s1[2] *= __builtin_amdgcn_rcpf(bflo(mn.w)); s1[3] *= __builtin_amdgcn_rcpf(bfhi(mn.w));
                        acc[ai][bj][m][0] *= s0; acc[ai][bj][m][1] *= s1; }
                    else { const f32x4 v0 = acc[ai][bj][m][0] * s0, v1 = acc[ai][bj][m][1] * s1;
                        u32x4 w; w.x = cvt_pk(v0[0], v0[1]); w.y = cvt_pk(v0[2], v0[3]); w.z = cvt_pk(v1[0], v1[1]); w.w = cvt_pk(v1[2], v1[3]);
                        *(u32x4*)(ymb + (size_t)row * DM + col) = w; }
                } }
            __builtin_amdgcn_sched_barrier(0);
        }
    }
};

struct SchedOut {
    const char* a; const char* w; int G, c;
    __device__ __forceinline__ bool next(int i, Unit& u) const {
        const int tile = i * G + c; if (tile >= 256) return false;
        pg8::tile_order(tile, 32, 8, u.pm, u.pn); u.kind = 0; u.aux = 0; u.a = a + (size_t)u.pm * 256 * 2048 * 2; u.b = w + (size_t)u.pn * 256 * 2048 * 2; return true;
    }
};
struct EpiOut {
    float* y; float* rss; bool doss;
    __device__ __forceinline__ void operator()(AccRef acc, const Unit& u, int wr, int wc, int fr, int fq) const {
        const int row0 = u.pm * 256 + wr * 64 + fr, col0 = u.pn * 256 + wc * 32 + 8 * fq;
#pragma unroll
        for (int ai = 0; ai < 2; ++ai)
#pragma unroll
            for (int m = 0; m < 4; ++m) { const int row = row0 + ai * 128 + m * 16; float ss = 0.f;
#pragma unroll
                for (int bj = 0; bj < 2; ++bj) { const f32x4 v0 = acc[ai][bj][m][0], v1 = acc[ai][bj][m][1]; float* yp = y + (size_t)row * DM + col0 + bj * 128;
                    ss += v0[0] * v0[0] + v0[1] * v0[1] + v0[2] * v0[2] + v0[3] * v0[3] + v1[0] * v1[0] + v1[1] * v1[1] + v1[2] * v1[2] + v1[3] * v1[3];
                    *(f32x4*)yp = v0; *(f32x4*)(yp + 4) = v1; }
                ss += __shfl_xor(ss, 16); ss += __shfl_xor(ss, 32); if (fq == 0 && doss) atomicAdd(rss + 3 * T + row, ss); }
    }
};
__device__ __forceinline__ void transpose_item(const float* W, int K, int N, int k0, int n0, bf16_t* dst0, const float* gk, LAS float* scr, int lane) {
    const int kr = lane >> 3, c4 = (lane & 7) * 4;
    f32x4 v[8];
#pragma unroll
    for (int i = 0; i < 8; ++i) v[i] = __builtin_nontemporal_load((const f32x4*)(W + (size_t)(k0 + 8 * i + kr) * N + n0 + c4));
    if (gk) {
#pragma unroll
        for (int i = 0; i < 8; ++i) v[i] = v[i] * gk[k0 + 8 * i + kr]; }
#pragma unroll
    for (int i = 0; i < 8; ++i) { LAS float* sp = scr + (8 * i + kr) * 33 + c4; sp[0] = v[i][0]; sp[1] = v[i][1]; sp[2] = v[i][2]; sp[3] = v[i][3]; }
    asm volatile("s_waitcnt lgkmcnt(0)" ::: "memory");
    const int c = lane & 7;
#pragma unroll
    for (int j = 0; j < 4; ++j) { const int n = (lane >> 3) + 8 * j; const LAS float* s = scr + (8 * c) * 33 + n;
        u32x4 o; o.x = cvt_pk(s[0 * 33], s[1 * 33]); o.y = cvt_pk(s[2 * 33], s[3 * 33]); o.z = cvt_pk(s[4 * 33], s[5 * 33]); o.w = cvt_pk(s[6 * 33], s[7 * 33]);
        *(u32x4*)(dst0 + (size_t)n * K + k0 + 8 * c) = o; }
    asm volatile("s_waitcnt lgkmcnt(0)" ::: "memory");
}

__device__ __forceinline__ void phase_prologue(const Ctx& X, LAS unsigned char* lds) {
    const int tid = X.tid, lane = tid & 63, wave = tid >> 6;
    const int gw = X.c * 8 + wave, NGW = X.G * 8;
    LAS float* scr = (LAS float*)(lds + wave * 8704);
    constexpr int I_IN = 32 * 482, I_UQ = 8 * 48, I_UKV = 8 * 64, I_BR = 16 * 64, I_OUT = 32 * 64;
    constexpr int PER_L = I_IN + I_UQ + 2 * I_UKV + 3 * I_BR + I_OUT;
    for (int it = gw; it < NL * PER_L; it += NGW) {
        const int l = it / PER_L; int r = it % PER_L;
        if (r < I_IN) { const int kb = r / 482, nb = r % 482, n0 = nb * 32; const int d0 = n0 < 1024 ? n0 : (n0 < 1088 ? Z_KR + (n0 - 1024) : n0 - 64);
            transpose_item(X.in[11] + (size_t)l * 2048 * INC, 2048, INC, kb * 64, n0, WSP(bf16_t, O_WIN) + ((size_t)l * ZW + d0) * 2048, nullptr, scr, lane); continue; }
        r -= I_IN;
        if (r < I_UQ) { const int kb = r / 48, nb = r % 48;
            transpose_item(X.in[14] + (size_t)l * 512 * 1536, 512, 1536, kb * 64, nb * 32, WSP(bf16_t, O_WUQ) + ((size_t)l * 1536 + nb * 32) * 512, X.in[12] + l * 512, scr, lane); continue; }
        r -= I_UQ;
        if (r < 2 * I_UKV) { const int gfold = r >= I_UKV; if (gfold) r -= I_UKV; const int kb = r / 64, nb = r % 64, n0 = nb * 32, hd = n0 >> 8, d = n0 & 255;
            bf16_t* dst = (d < 128 ? WSP(bf16_t, gfold ? O_WKG : O_WKP) : WSP(bf16_t, gfold ? O_WVG : O_WVP)) + ((size_t)l * 1024 + hd * 128 + (d & 127)) * 512;
            transpose_item(X.in[15] + (size_t)l * 512 * 2048, 512, 2048, kb * 64, n0, dst, gfold ? X.in[13] + l * 512 : nullptr, scr, lane); continue; }
        r -= 2 * I_UKV;
        if (r < 3 * I_BR) { const int br = r / I_BR; r %= I_BR; const int kb = r / 64, nb = r % 64;
            transpose_item(X.in[21 + br] + (size_t)l * 1024 * 2048, 1024, 2048, kb * 64, nb * 32, WSP(bf16_t, O_WBR) + (((size_t)l * 3 + br) * 2048 + nb * 32) * 1024, nullptr, scr, lane); continue; }
        r -= 3 * I_BR;
        { const int kb = r / 64, nb = r % 64;
            transpose_item(X.in[24] + (size_t)l * 2048 * 2048, 2048, 2048, kb * 64, nb * 32, WSP(bf16_t, O_WOUT) + ((size_t)l * 2048 + nb * 32) * 2048, nullptr, scr, lane); }
    }
    const int gt = X.c * NTHREADS + tid, NGT = X.G * NTHREADS;
    for (int i = gt; i < NL * 512 * 512 / 4; i += NGT) { const int e = i * 4, l = e / (512 * 512), rr = (e / 512) % 512, cidx = e % 512, b = rr >> 8, t = rr & 255;
        const f32x4 v = *(const f32x4*)(X.in[2] + (((size_t)b * NL + l) * 256 + t) * 512 + cidx);
        u32x2 w; w.x = cvt_pk(v[0], v[1]); w.y = cvt_pk(v[2], v[3]); *(u32x2*)(WSP(bf16_t, O_CKVC) + e) = w; }
    for (int i = gt; i < NL * 512 * 64 / 4; i += NGT) { const int e = i * 4, l = e / (512 * 64), rr = (e / 64) % 512, cidx = e % 64, b = rr >> 8, t = rr & 255;
        const f32x4 v = *(const f32x4*)(X.in[3] + (((size_t)b * NL + l) * 256 + t) * 64 + cidx);
        u32x2 w; w.x = cvt_pk(v[0], v[1]); w.y = cvt_pk(v[2], v[3]); *(u32x2*)(WSP(bf16_t, O_KRC) + e) = w; }
    for (int i = gt; i < 64 * 16; i += NGT) { const int p = i >> 4, f = i & 15; const float inv = powf(10000.f, -(float)f / 16.f); const float ang = (float)p * inv;
        WSP(float, O_ROPE)[2 * i] = cosf(ang); WSP(float, O_ROPE)[2 * i + 1] = sinf(ang); }
    for (int i = gt; i < 4 * T; i += NGT) WSP(float, O_RSS)[i] = 0.f;
    LAS float* sl = (LAS float*)(lds + 69632);
    LAS float* red = (LAS float*)(lds + 69632 + 24576);
    __syncthreads();
    for (int i = tid; i < 3 * 2048; i += NTHREADS) { const int cidx = i >> 11, k = i & 2047; const float v = cidx == 0 ? X.in[6][k] : X.in[5][(cidx - 1) * 2048 + k]; sl[i] = silu_f(v); }
    __syncthreads();
    for (int un = X.c; un < NL * 192; un += X.G) {
        const int l = un / 192, col0 = (un % 192) * 32, kg = tid >> 3, c4 = tid & 7;
        const float* wp = X.in[7] + (size_t)l * 2048 * 6144 + col0 + 4 * c4;
        f32x4 a0 = {0.f, 0.f, 0.f, 0.f}, a1 = a0, a2 = a0;
#pragma unroll 1
        for (int kb = 0; kb < 32; kb += 8) {
            f32x4 w[8];
#pragma unroll
            for (int q = 0; q < 8; ++q) w[q] = __builtin_nontemporal_load((const f32x4*)(wp + (size_t)(kg + 64 * (kb + q)) * 6144));
            __builtin_amdgcn_sched_barrier(0);
#pragma unroll
            for (int q = 0; q < 8; ++q) { const int k = kg + 64 * (kb + q); a0 += w[q] * sl[k]; a1 += w[q] * sl[2048 + k]; a2 += w[q] * sl[4096 + k]; }
        }
        LAS float* rp = red + (kg * 8 + c4) * 12;
#pragma unroll
        for (int j = 0; j < 4; ++j) { rp[j] = a0[j]; rp[4 + j] = a1[j]; rp[8 + j] = a2[j]; }
        __syncthreads();
        if (tid < 96) { const int cc = tid / 12, jj = tid % 12; float s = 0.f; for (int g = 0; g < 64; ++g) s += red[(g * 8 + cc) * 12 + jj];
            const int cidx = jj >> 2, col = col0 + 4 * cc + (jj & 3); WSP(float, O_MOD)[((size_t)l * 3 + cidx) * 6144 + col] = s + X.in[8][l * 6144 + col]; }
        __syncthreads();
    }
}

__device__ __forceinline__ void phase_rows(const Ctx& X, int l, bool upd, int ln) {
    const int tid = X.tid, lane = tid & 63, wave = tid >> 6;
    const float* mod = WSP(float, O_MOD);
    for (int row0 = (X.c * 8 + wave) * 2; row0 < T; row0 += X.G * 16) {
        f32x4 v[2][8];
#pragma unroll
        for (int rr = 0; rr < 2; ++rr) { const int row = row0 + rr;
            const float* xsrc = (upd && l > 0) || (!upd && ln > 0) ? WSP(float, O_X) + (size_t)row * DM : (row < 4096 ? X.in[0] + (size_t)row * DM : X.in[1] + (size_t)(row - 4096) * DM);
#pragma unroll
            for (int j = 0; j < 8; ++j) v[rr][j] = *(const f32x4*)(xsrc + j * 256 + lane * 4); }
        const int cidx = row0 < 4096 ? 0 : 1 + ((row0 - 4096) >> 11);
        if (upd) {
            const float* gate = mod + ((size_t)l * 3 + cidx) * 6144 + 4096; const float* gp = X.in[10] + l * 2048;
            f32x4 gg[8], y[8];
#pragma unroll
            for (int j = 0; j < 8; ++j) { const int c = j * 256 + lane * 4; gg[j] = *(const f32x4*)(gate + c); y[j] = *(const f32x4*)(gp + c); }
            const float ri0 = rsqrtf(WSP(float, O_RSS)[3 * T + row0] * (1.f / 2048.f) + EPSN), ri1 = rsqrtf(WSP(float, O_RSS)[3 * T + row0 + 1] * (1.f / 2048.f) + EPSN);
            __builtin_amdgcn_sched_barrier(0);
#pragma unroll
            for (int j = 0; j < 8; ++j) gg[j] = gg[j] * y[j];
#pragma unroll
            for (int rr = 0; rr < 2; ++rr) { const int row = row0 + rr; const float ri = rr ? ri1 : ri0; const float* yp = WSP(float, O_Y) + (size_t)row * DM;
#pragma unroll
                for (int j = 0; j < 8; ++j) y[j] = *(const f32x4*)(yp + j * 256 + lane * 4);
                __builtin_amdgcn_sched_barrier(0);
                float* xdst = (l == NL - 1) ? X.out + (row < 4096 ? OUT_YP + (size_t)row * DM : OUT_YS + (size_t)(row - 4096) * DM) : WSP(float, O_X) + (size_t)row * DM;
#pragma unroll
                for (int j = 0; j < 8; ++j) { v[rr][j] += gg[j] * (y[j] * ri); *(f32x4*)(xdst + j * 256 + lane * 4) = v[rr][j]; }
                __builtin_amdgcn_sched_barrier(0); }
        }
        __builtin_amdgcn_sched_barrier(0);
        if (ln < NL) {
            const float* sh = mod + ((size_t)ln * 3 + cidx) * 6144; const float* sc = sh + 2048; const float* gp = X.in[9] + ln * 2048;
            f32x4 s[8], b[8], g[8];
#pragma unroll
            for (int j = 0; j < 8; ++j) { const int c = j * 256 + lane * 4; s[j] = *(const f32x4*)(sc + c); b[j] = *(const f32x4*)(sh + c); g[j] = *(const f32x4*)(gp + c); }
            float ss0 = 0.f, ss1 = 0.f;
#pragma unroll
            for (int j = 0; j < 8; ++j) { ss0 += v[0][j][0] * v[0][j][0] + v[0][j][1] * v[0][j][1] + v[0][j][2] * v[0][j][2] + v[0][j][3] * v[0][j][3];
                ss1 += v[1][j][0] * v[1][j][0] + v[1][j][1] * v[1][j][1] + v[1][j][2] * v[1][j][2] + v[1][j][3] * v[1][j][3]; }
            ss0 = wave_sum(ss0); ss1 = wave_sum(ss1); const float ri0 = rsqrtf(ss0 * (1.f / 2048.f) + EPSN), ri1 = rsqrtf(ss1 * (1.f / 2048.f) + EPSN);
            __builtin_amdgcn_sched_barrier(0);
            bf16_t* hp = WSP(bf16_t, O_H) + (size_t)row0 * DM;
#pragma unroll
            for (int j = 0; j < 8; ++j) { const int c = j * 256 + lane * 4;
                const f32x4 gs = g[j] * (s[j] + 1.f);
                const f32x4 h0 = v[0][j] * ri0 * gs + b[j], h1 = v[1][j] * ri1 * gs + b[j];
                u32x2 w; w.x = cvt_pk(h0[0], h0[1]); w.y = cvt_pk(h0[2], h0[3]); *(u32x2*)(hp + c) = w;
                w.x = cvt_pk(h1[0], h1[1]); w.y = cvt_pk(h1[2], h1[3]); *(u32x2*)(hp + DM + c) = w; }
        }
    }
}

__device__ __forceinline__ void phase_misc(const Ctx& X, int l) {
    const int tid = X.tid, lane = tid & 63, wave = tid >> 6;
    const bf16_t* z = WSP(bf16_t, O_Z);
    for (int row = X.c * 8 + wave; row < 4096; row += X.G * 8) {
        const bf16_t* zr = z + (size_t)row * ZW;
        const int b = row >> 8, t = row & 255;
        const float ri = rsqrtf(WSP(float, O_RSS)[T + row] * (1.f / 512.f) + EPSN);
        const u32x4 w = *(const u32x4*)(zr + Z_CKV + lane * 8); const float* g = X.in[13] + l * 512 + lane * 8;
        const f32x4 g0 = *(const f32x4*)g, g1 = *(const f32x4*)(g + 4);
        float* o = X.out + OUT_CKV + (((size_t)b * NL + l) * 256 + t) * 512 + lane * 8;
        f32x4 o0, o1; o0[0] = bflo(w.x) * ri * g0[0]; o0[1] = bfhi(w.x) * ri * g0[1]; o0[2] = bflo(w.y) * ri * g0[2]; o0[3] = bfhi(w.y) * ri * g0[3];
        o1[0] = bflo(w.z) * ri * g1[0]; o1[1] = bfhi(w.z) * ri * g1[1]; o1[2] = bflo(w.w) * ri * g1[2]; o1[3] = bfhi(w.w) * ri * g1[3];
        *(f32x4*)o = o0; *(f32x4*)(o + 4) = o1;
    }
}
__device__ __forceinline__ void phase_krope(const Ctx& X, int l) {
    const int tid = X.tid, lane = tid & 63, wave = tid >> 6;
    const bf16_t* z = WSP(bf16_t, O_Z); const float* rope = WSP(float, O_ROPE);
    for (int row = X.c * 8 + wave; row < T; row += X.G * 8) {
        float kr = bf2f(z[(size_t)row * ZW + Z_KR + lane]);
        if (row < 4096) { const int b = row >> 8, t = row & 255; X.out[OUT_KR + (((size_t)b * NL + l) * 256 + t) * 64 + lane] = kr; }
        else {
            const int t = (row - 4096) & 2047; const int p = lane < 32 ? (t >> 6) : (t & 63); const int f = lane & 15;
            const float cs = rope[(p * 16 + f) * 2], sn = rope[(p * 16 + f) * 2 + 1];
            const float pr = __shfl_xor(kr, 16);
            kr = (lane & 16) ? kr * cs + pr * sn : kr * cs - pr * sn;
        }
        const float nb = __shfl_down(kr, 1);
        if ((lane & 1) == 0) *(unsigned*)(WSP(bf16_t, O_KR) + (size_t)row * 64 + lane) = cvt_pk(kr, nb);
    }
}
constexpr int PB = 272;
constexpr int BUFB = 128 * PB;
constexpr int PO = 132;
__device__ __forceinline__ void mma128(const LAS unsigned char* As, const LAS unsigned char* Bs, f32x16 (&acc)[2], int wr, int wc, int lane) {
    const int r32 = lane & 31, hi = lane >> 5;
    const LAS unsigned char* ap = As + (32 * wr + r32) * PB + hi * 16;
    const LAS unsigned char* bp = Bs + (64 * wc + r32) * PB + hi * 16;
#pragma unroll 2
    for (int s = 0; s < 8; ++s) {
        const bf16x8 a = *(const LAS bf16x8*)(ap + s * 32);
        const bf16x8 b0 = *(const LAS bf16x8*)(bp + s * 32);
        const bf16x8 b1 = *(const LAS bf16x8*)(bp + 32 * PB + s * 32);
        acc[0] = __builtin_amdgcn_mfma_f32_32x32x16_bf16(a, b0, acc[0], 0, 0, 0);
        acc[1] = __builtin_amdgcn_mfma_f32_32x32x16_bf16(a, b1, acc[1], 0, 0, 0);
    }
}
__device__ __forceinline__ int crow(int r, int hi) { return (r & 3) + 8 * (r >> 2) + 4 * hi; }
__device__ __forceinline__ void stage_tile(LAS unsigned char* dst, const bf16_t* src, size_t ld, int tid) {
#pragma unroll
    for (int i = 0; i < 4; ++i) { const int c = tid + i * NTHREADS, r = c >> 4, ch = c & 15;
        *(LAS u32x4*)(dst + r * PB + ch * 16) = *(const u32x4*)(src + (size_t)r * ld + ch * 8); }
}
__device__ __forceinline__ float log_sigmoid_f(float x) { return -log1pf(expf(-x)); }

__device__ __forceinline__ void sgu_item(const Ctx& X, LAS unsigned char* lds, int l, int item) {
    int tid_ = X.tid; asm volatile("" : "+v"(tid_));
    const int tid = tid_, lane = tid & 63, wave = tid >> 6, wr = wave >> 1, wc = wave & 1;
    const int n = item >> 3, g = item & 7, tok0 = n * 128;
    LAS unsigned char* As = lds; LAS unsigned char* Bs = lds + BUFB; LAS float* Os = (LAS float*)(lds + 2 * BUFB);
    const float* ws = X.in[17] + ((size_t)l * 8 + g) * 16384; const float* rss = WSP(float, O_RSS) + 2 * T + tok0;
    { f32x4 w0[4], w1[4], s0[4], s1[4];
#pragma unroll
      for (int i = 0; i < 4; ++i) { const int c = tid + i * NTHREADS, r = c >> 4, ch = c & 15;
          w0[i] = *(const f32x4*)(ws + r * 128 + ch * 8); w1[i] = *(const f32x4*)(ws + r * 128 + ch * 8 + 4); s0[i] = *(const f32x4*)(rss + ch * 8); s1[i] = *(const f32x4*)(rss + ch * 8 + 4); }
      __builtin_amdgcn_sched_barrier(0);
#pragma unroll
      for (int i = 0; i < 4; ++i) { const int c = tid + i * NTHREADS, r = c >> 4, ch = c & 15;
          u32x4 o; o.x = cvt_pk(w0[i][0] * rsqrtf(s0[i][0] * (1.f / 1024.f) + EPSN), w0[i][1] * rsqrtf(s0[i][1] * (1.f / 1024.f) + EPSN));
          o.y = cvt_pk(w0[i][2] * rsqrtf(s0[i][2] * (1.f / 1024.f) + EPSN), w0[i][3] * rsqrtf(s0[i][3] * (1.f / 1024.f) + EPSN));
          o.z = cvt_pk(w1[i][0] * rsqrtf(s1[i][0] * (1.f / 1024.f) + EPSN), w1[i][1] * rsqrtf(s1[i][1] * (1.f / 1024.f) + EPSN));
          o.w = cvt_pk(w1[i][2] * rsqrtf(s1[i][2] * (1.f / 1024.f) + EPSN), w1[i][3] * rsqrtf(s1[i][3] * (1.f / 1024.f) + EPSN));
          *(LAS u32x4*)(As + r * PB + ch * 16) = o; } }
    stage_tile(Bs, WSP(bf16_t, O_VST) + (size_t)(g * 128) * T + tok0, T, tid);
    const int p = tid >> 2, cseg = (tid & 3) * 32; const bf16_t* zr = WSP(bf16_t, O_Z) + (size_t)(tok0 + p) * ZW;
    u32x4 uu4[4], gg4[4]; f32x4 gs4[8];
#pragma unroll
    for (int i = 0; i < 4; ++i) { uu4[i] = *(const u32x4*)(zr + Z_U + g * 128 + cseg + i * 8); gg4[i] = *(const u32x4*)(zr + Z_GPS + g * 128 + cseg + i * 8); }
#pragma unroll
    for (int i = 0; i < 8; ++i) gs4[i] = *(const f32x4*)(X.in[16] + l * 1024 + g * 128 + cseg + i * 4);
    const float bs = X.in[18][((size_t)l * 128 + p) * 8 + g];
    __syncthreads();
    f32x16 acc[2]; acc[0] = (f32x16)(0.f); acc[1] = (f32x16)(0.f);
    mma128(As, Bs, acc, wr, wc, lane);
    { const int hi = lane >> 5, cb = 64 * wc + (lane & 31);
#pragma unroll
      for (int t = 0; t < 2; ++t)
#pragma unroll
        for (int r = 0; r < 16; ++r) Os[(32 * wr + crow(r, hi)) * PO + cb + 32 * t] = acc[t][r]; }
    __syncthreads();
    {
      bf16_t* op = WSP(bf16_t, O_AS) + (size_t)(tok0 + p) * 1024 + g * 128 + cseg;
#pragma unroll
      for (int i = 0; i < 4; ++i) {
          const u32x4 uu = uu4[i], gg = gg4[i];
          const f32x4 s0 = *(const LAS f32x4*)(Os + p * PO + cseg + i * 8), s1 = *(const LAS f32x4*)(Os + p * PO + cseg + i * 8 + 4);
          const f32x4 g0 = gs4[2 * i], g1 = gs4[2 * i + 1];
          u32x4 o; o.x = cvt_pk((s0[0] * g0[0] + bs) * bflo(uu.x) * bflo(gg.x), (s0[1] * g0[1] + bs) * bfhi(uu.x) * bfhi(gg.x));
          o.y = cvt_pk((s0[2] * g0[2] + bs) * bflo(uu.y) * bflo(gg.y), (s0[3] * g0[3] + bs) * bfhi(uu.y) * bfhi(gg.y));
          o.z = cvt_pk((s1[0] * g1[0] + bs) * bflo(uu.z) * bflo(gg.z), (s1[1] * g1[1] + bs) * bfhi(uu.z) * bfhi(gg.z));
          o.w = cvt_pk((s1[2] * g1[2] + bs) * bflo(uu.w) * bflo(gg.w), (s1[3] * g1[3] + bs) * bfhi(uu.w) * bfhi(gg.w));
          *(u32x4*)(op + i * 8) = o; } }
    __syncthreads();
}

__device__ __forceinline__ void retstate_item(const Ctx& X, LAS unsigned char* lds, int l, int item) {
    int tid_ = X.tid; asm volatile("" : "+v"(tid_));
    const int tid = tid_, lane = tid & 63, wave = tid >> 6, wr = wave >> 1, wc = wave & 1;
    const int n = item >> 3, hd = item & 7, tok0 = n * 128;
    LAS unsigned char* As = lds; LAS unsigned char* Bf = lds + BUFB; LAS unsigned char* Bb = lds + 2 * BUFB;
    const float lgf = log_sigmoid_f(X.in[19][(l * 2 + 0) * 8 + hd]) * 1.4426950408889634f, lgb = log_sigmoid_f(X.in[19][(l * 2 + 1) * 8 + hd]) * 1.4426950408889634f;
    stage_tile(As, WSP(bf16_t, O_RVT) + (size_t)(hd * 128) * T + tok0, T, tid);
    { const bf16_t* kz = WSP(bf16_t, O_Z) + (size_t)tok0 * ZW + Z_RK + hd * 128;
      const int j0 = 2 * lane;
      const float wf0 = exp2f(lgf * (float)(127 - j0)), wf1 = exp2f(lgf * (float)(126 - j0)), wb0 = exp2f(lgb * (float)j0), wb1 = exp2f(lgb * (float)(j0 + 1));
      u32x4 wa[2], wb[2];
#pragma unroll
      for (int i = 0; i < 2; ++i) { const int d0 = (wave * 2 + i) * 8; wa[i] = *(const u32x4*)(kz + (size_t)j0 * ZW + d0); wb[i] = *(const u32x4*)(kz + (size_t)(j0 + 1) * ZW + d0); }
#pragma unroll
      for (int i = 0; i < 2; ++i) { const int d0 = (wave * 2 + i) * 8;
          const float ka[8] = {bflo(wa[i].x), bfhi(wa[i].x), bflo(wa[i].y), bfhi(wa[i].y), bflo(wa[i].z), bfhi(wa[i].z), bflo(wa[i].w), bfhi(wa[i].w)};
          const float kb[8] = {bflo(wb[i].x), bfhi(wb[i].x), bflo(wb[i].y), bfhi(wb[i].y), bflo(wb[i].z), bfhi(wb[i].z), bflo(wb[i].w), bfhi(wb[i].w)};
#pragma unroll
          for (int e = 0; e < 8; ++e) { *(LAS unsigned*)(Bf + (d0 + e) * PB + j0 * 2) = cvt_pk(ka[e] * wf0, kb[e] * wf1); *(LAS unsigned*)(Bb + (d0 + e) * PB + j0 * 2) = cvt_pk(ka[e] * wb0, kb[e] * wb1); } } }
    __syncthreads();
    f32x16 af[2], ab[2]; af[0] = (f32x16)(0.f); af[1] = (f32x16)(0.f); ab[0] = (f32x16)(0.f); ab[1] = (f32x16)(0.f);
    mma128(As, Bf, af, wr, wc, lane); mma128(As, Bb, ab, wr, wc, lane);
    float* st = WSP(float, O_ST) + ((size_t)(n * 8 + hd) * 2) * 16384;
    { const int hi = lane >> 5, cb = 64 * wc + (lane & 31);
#pragma unroll
      for (int t = 0; t < 2; ++t)
#pragma unroll
        for (int r = 0; r < 16; ++r) { const int e = 32 * wr + crow(r, hi); st[e * 128 + cb + 32 * t] = af[t][r]; st[16384 + e * 128 + cb + 32 * t] = ab[t][r]; } }
    __syncthreads();
}

__device__ __forceinline__ void retout_item(const Ctx& X, LAS unsigned char* lds, int l, int item) {
    int tid_ = X.tid; asm volatile("" : "+v"(tid_));
    const int tid = tid_, lane = tid & 63, wave = tid >> 6, wr = wave >> 1, wc = wave & 1;
    const int n = item >> 3, hd = item & 7, tok0 = n * 128;
    LAS unsigned char* B0 = lds; LAS unsigned char* B1 = lds + BUFB; LAS unsigned char* B2 = lds + 2 * BUFB; LAS unsigned char* B3 = lds + 3 * BUFB;
    LAS unsigned char* B4 = lds + 4 * BUFB;
    const float lgf = log_sigmoid_f(X.in[19][(l * 2 + 0) * 8 + hd]) * 1.4426950408889634f, lgb = log_sigmoid_f(X.in[19][(l * 2 + 1) * 8 + hd]) * 1.4426950408889634f;
    const bf16_t* z = WSP(bf16_t, O_Z); const bf16_t* pf = WSP(bf16_t, O_PF) + (size_t)(n * 8 + hd) * 2 * 16384;
    (void)B4;
    stage_tile(B0, z + (size_t)tok0 * ZW + Z_RQ + hd * 128, ZW, tid);
    stage_tile(B1, z + (size_t)tok0 * ZW + Z_RK + hd * 128, ZW, tid);
    stage_tile(B3, WSP(bf16_t, O_RVT) + (size_t)(hd * 128) * T + tok0, T, tid);
    u32x4 pfr[2][4];
#pragma unroll
    for (int d = 0; d < 2; ++d)
#pragma unroll
        for (int i = 0; i < 4; ++i) { const int c = tid + i * NTHREADS; pfr[d][i] = *(const u32x4*)(pf + d * 16384 + (size_t)(c >> 4) * 128 + (c & 15) * 8); }
    const int p_ = tid >> 2, cseg_ = (tid & 3) * 32;
    u32x4 gpr[4]; f32x4 grr[8];
#pragma unroll
    for (int q = 0; q < 4; ++q) gpr[q] = *(const u32x4*)(z + (size_t)(tok0 + p_) * ZW + Z_GPR + hd * 128 + cseg_ + q * 8);
#pragma unroll
    for (int q = 0; q < 8; ++q) grr[q] = *(const f32x4*)(X.in[20] + l * 1024 + hd * 128 + cseg_ + q * 4);
    __syncthreads();
    const int hi = lane >> 5, cb = 64 * wc + (lane & 31);
    { f32x16 aw[2]; aw[0] = (f32x16)(0.f); aw[1] = (f32x16)(0.f);
      mma128(B0, B1, aw, wr, wc, lane);
#pragma unroll
      for (int t = 0; t < 2; ++t)
#pragma unroll
        for (int r = 0; r < 16; ++r) { const int i = 32 * wr + crow(r, hi), j = cb + 32 * t; const float dd = (float)(i - j);
            const float dec = (i >= j) ? __builtin_amdgcn_exp2f(lgf * dd) : __builtin_amdgcn_exp2f(-lgb * dd);
            *(LAS bf16_t*)(B2 + i * PB + j * 2) = (bf16_t)(cvt_pk(aw[t][r] * dec, 0.f) & 0xffffu); } }
    __syncthreads();
#pragma unroll
    for (int i = 0; i < 4; ++i) { const int c = tid + i * NTHREADS; *(LAS u32x4*)(B1 + (c >> 4) * PB + (c & 15) * 16) = pfr[0][i]; }
    f32x16 ao[2]; ao[0] = (f32x16)(0.f); ao[1] = (f32x16)(0.f);
    mma128(B2, B3, ao, wr, wc, lane);
    __syncthreads();
#pragma unroll
    for (int i = 0; i < 4; ++i) { const int c = tid + i * NTHREADS; *(LAS u32x4*)(B3 + (c >> 4) * PB + (c & 15) * 16) = pfr[1][i]; }
    f32x16 ac[2]; ac[0] = (f32x16)(0.f); ac[1] = (f32x16)(0.f);
    mma128(B0, B1, ac, wr, wc, lane);
#pragma unroll
    for (int t = 0; t < 2; ++t)
#pragma unroll
        for (int r = 0; r < 16; ++r) { const int i = 32 * wr + crow(r, hi); ao[t][r] += ac[t][r] * __builtin_amdgcn_exp2f(lgf * (float)(i + 1)); }
    __syncthreads();
    ac[0] = (f32x16)(0.f); ac[1] = (f32x16)(0.f);
    mma128(B0, B3, ac, wr, wc, lane);
    LAS float* Os = (LAS float*)(lds + BUFB);
#pragma unroll
    for (int t = 0; t < 2; ++t)
#pragma unroll
        for (int r = 0; r < 16; ++r) { const int i = 32 * wr + crow(r, hi); Os[i * PO + cb + 32 * t] = ao[t][r] + ac[t][r] * __builtin_amdgcn_exp2f(lgb * (float)(128 - i)); }
    __syncthreads();
    { const int p = tid >> 2, cseg = (tid & 3) * 32; f32x4 v[8]; float s = 0.f;
#pragma unroll
      for (int q = 0; q < 8; ++q) { v[q] = *(const LAS f32x4*)(Os + p * PO + cseg + q * 4); s += v[q][0] + v[q][1] + v[q][2] + v[q][3]; }
      s += __shfl_xor(s, 1); s += __shfl_xor(s, 2); const float mu = s * (1.f / 128.f); float s2 = 0.f;
#pragma unroll
      for (int q = 0; q < 8; ++q) { v[q] = v[q] - mu; s2 += v[q][0] * v[q][0] + v[q][1] * v[q][1] + v[q][2] * v[q][2] + v[q][3] * v[q][3]; }
      s2 += __shfl_xor(s2, 1); s2 += __shfl_xor(s2, 2); const float rs = rsqrtf(s2 * (1.f / 128.f) + EPSN);

      bf16_t* op = WSP(bf16_t, O_AR) + (size_t)(tok0 + p) * 1024 + hd * 128 + cseg;
#pragma unroll
      for (int q = 0; q < 4; ++q) { const u32x4 gg = gpr[q]; const f32x4 g0 = grr[2 * q], g1 = grr[2 * q + 1]; const f32x4 a = v[2 * q] * rs * g0, b = v[2 * q + 1] * rs * g1;
          u32x4 o; o.x = cvt_pk(a[0] * bflo(gg.x), a[1] * bfhi(gg.x)); o.y = cvt_pk(a[2] * bflo(gg.y), a[3] * bfhi(gg.y)); o.z = cvt_pk(b[0] * bflo(gg.z), b[1] * bfhi(gg.z)); o.w = cvt_pk(b[2] * bflo(gg.w), b[3] * bfhi(gg.w));
          *(u32x4*)(op + q * 8) = o; } }
    __syncthreads();
}

__device__ __forceinline__ void phase_prefix(const Ctx& X, int l) {
    const int tid = X.tid;
    const float* stb = WSP(float, O_ST); bf16_t* pf = WSP(bf16_t, O_PF);
    for (int it = X.c; it < 256; it += X.G) {
        const int chain = it >> 3, sl = it & 7, b = chain >> 4, hd = (chain >> 1) & 7, dir = chain & 1;
        const int e = sl * 16 + (tid >> 5), d4 = (tid & 31) * 4, n0 = 32 + b * 16;
        const float gc = exp2f(128.f * 1.4426950408889634f * log_sigmoid_f(X.in[19][(l * 2 + dir) * 8 + hd]));
        f32x4 S[16];
#pragma unroll
        for (int j = 0; j < 16; ++j) S[j] = *(const f32x4*)(stb + ((size_t)((n0 + j) * 8 + hd) * 2 + dir) * 16384 + e * 128 + d4);
        const float* s0 = X.in[4] + ((((size_t)b * NL + l) * 2 + dir) * 8 + hd) * 16384;
        f32x4 R; R[0] = s0[(size_t)(d4 + 0) * 128 + e]; R[1] = s0[(size_t)(d4 + 1) * 128 + e]; R[2] = s0[(size_t)(d4 + 2) * 128 + e]; R[3] = s0[(size_t)(d4 + 3) * 128 + e];
#pragma unroll
        for (int jj = 0; jj < 16; ++jj) { const int j = dir ? 15 - jj : jj;
            u32x2 o; o.x = cvt_pk(R[0], R[1]); o.y = cvt_pk(R[2], R[3]);
            *(u32x2*)(pf + ((size_t)((n0 + j) * 8 + hd) * 2 + dir) * 16384 + e * 128 + d4) = o;
            R = R * gc + S[j]; }
    }
    for (int it = X.c; it < 256; it += X.G) {
        const int s = it >> 4, hd = (it >> 1) & 7, dir = it & 1, n0 = s * 2;
        const float gc = exp2f(128.f * 1.4426950408889634f * log_sigmoid_f(X.in[19][(l * 2 + dir) * 8 + hd]));
        float* o = X.out + OUT_RET + ((((size_t)s * NL + l) * 2 + dir) * 8 + hd) * 16384;
        const int nfirst = dir ? n0 + 1 : n0, nsecond = dir ? n0 : n0 + 1;
#pragma unroll
        for (int k = 0; k < 8; ++k) { const int idx = (k * NTHREADS + tid) * 4, e = idx >> 7, d4 = idx & 127;
            const f32x4 Sa = *(const f32x4*)(stb + ((size_t)(nfirst * 8 + hd) * 2 + dir) * 16384 + idx), Sb = *(const f32x4*)(stb + ((size_t)(nsecond * 8 + hd) * 2 + dir) * 16384 + idx);
            u32x2 z0; z0.x = 0u; z0.y = 0u; u32x2 w; w.x = cvt_pk(Sa[0], Sa[1]); w.y = cvt_pk(Sa[2], Sa[3]);
            *(u32x2*)(pf + ((size_t)(nfirst * 8 + hd) * 2 + dir) * 16384 + idx) = z0;
            *(u32x2*)(pf + ((size_t)(nsecond * 8 + hd) * 2 + dir) * 16384 + idx) = w;
            const f32x4 f = Sa * gc + Sb;
            o[(size_t)(d4 + 0) * 128 + e] = f[0]; o[(size_t)(d4 + 1) * 128 + e] = f[1]; o[(size_t)(d4 + 2) * 128 + e] = f[2]; o[(size_t)(d4 + 3) * 128 + e] = f[3]; }
    }
}
constexpr int KPB = 400;
constexpr int VPB = 272;
constexpr int ATT_KB = 128 * KPB;
__device__ __forceinline__ float xmax16(float x) { const unsigned u = __float_as_uint(x); auto r = __builtin_amdgcn_permlane16_swap(u, u, false, false); return fmaxf(__uint_as_float(r[0]), __uint_as_float(r[1])); }
__device__ __forceinline__ float xmax32(float x) { const unsigned u = __float_as_uint(x); auto r = __builtin_amdgcn_permlane32_swap(u, u, false, false); return fmaxf(__uint_as_float(r[0]), __uint_as_float(r[1])); }
__device__ __forceinline__ float xsum16(float x) { const unsigned u = __float_as_uint(x); auto r = __builtin_amdgcn_permlane16_swap(u, u, false, false); return __uint_as_float(r[0]) + __uint_as_float(r[1]); }
__device__ __forceinline__ float xsum32(float x) { const unsigned u = __float_as_uint(x); auto r = __builtin_amdgcn_permlane32_swap(u, u, false, false); return __uint_as_float(r[0]) + __uint_as_float(r[1]); }
__device__ __forceinline__ void attn_unit(const Ctx& X, LAS unsigned char* lds, int l, int unit) {
    int tid_ = X.tid; asm volatile("" : "+v"(tid_));
    const int tid = tid_, lane = tid & 63, wave = tid >> 6, qi = lane & 15, g = lane >> 4;
    const int rbw = wave & 3, kh = wave >> 2;
    int tokb, ncache, nnew, hd, qb, bc = 0;
    if (unit < 256) { bc = unit >> 7; hd = (unit >> 4) & 7; qb = unit & 15; tokb = 4096 + bc * 2048; ncache = 256; nnew = 2048; }
    else { const int r = unit - 256; const int s = r >> 4; hd = (r >> 1) & 7; qb = r & 1; tokb = s * 256; ncache = 0; nnew = 256; }
    const int nct = ncache >> 7, ntile = (ncache + nnew) >> 7;
    const bf16_t* KN = WSP(bf16_t, O_KN); const bf16_t* KR = WSP(bf16_t, O_KR); const bf16_t* VT = WSP(bf16_t, O_VT);
    const bf16_t* KC = WSP(bf16_t, O_KC) + (size_t)l * 512 * 1024; const bf16_t* KRC = WSP(bf16_t, O_KRC) + (size_t)l * 512 * 64; const bf16_t* VTC = WSP(bf16_t, O_VTC) + (size_t)l * 1024 * 512;
    const int tokq = tokb + qb * 128 + rbw * 32 + qi;
    LAS unsigned char* qb_l = lds + ATT_KB + 128 * VPB;
    const LAS unsigned char* qbase = qb_l + (32 * rbw + qi) * KPB + 16 * g;
    LAS unsigned char* kb = lds; LAS unsigned char* vb = lds + ATT_KB;
    u32x4 sk[4], sr[2], sv[4];
#define ATT_LOAD(j) do { const int _j = (j); const bf16_t *kn_, *kr_, *vt_; size_t ldv_; \
        if (_j < nct) { const int r0 = bc * 256 + _j * 128; kn_ = KC + (size_t)r0 * 1024 + hd * 128; kr_ = KRC + (size_t)r0 * 64; vt_ = VTC + (size_t)(hd * 128) * 512 + r0; ldv_ = 512; } \
        else { const int r0 = tokb + (_j - nct) * 128; kn_ = KN + (size_t)r0 * 1024 + hd * 128; kr_ = KR + (size_t)r0 * 64; vt_ = VT + (size_t)(hd * 128) * T + r0; ldv_ = T; } \
        _Pragma("unroll") for (int i = 0; i < 4; ++i) { const int c = tid + i * NTHREADS; sk[i] = *(const u32x4*)(kn_ + (size_t)(c >> 4) * 1024 + (c & 15) * 8); sv[i] = *(const u32x4*)(vt_ + (size_t)(c >> 4) * ldv_ + (c & 15) * 8); } \
        _Pragma("unroll") for (int i = 0; i < 2; ++i) { const int c = tid + i * NTHREADS; sr[i] = *(const u32x4*)(kr_ + (size_t)(c >> 3) * 64 + (c & 7) * 8); } } while (0)
#define ATT_STORE() do { \
        _Pragma("unroll") for (int i = 0; i < 4; ++i) { const int c = tid + i * NTHREADS; *(LAS u32x4*)(kb + (c >> 4) * KPB + (c & 15) * 16) = sk[i]; *(LAS u32x4*)(vb + (c >> 4) * VPB + (c & 15) * 16) = sv[i]; } \
        _Pragma("unroll") for (int i = 0; i < 2; ++i) { const int c = tid + i * NTHREADS; *(LAS u32x4*)(kb + (c >> 3) * KPB + 256 + (c & 7) * 16) = sr[i]; } } while (0)
    f32x4 O[2][8];
#pragma unroll
    for (int rb = 0; rb < 2; ++rb)
#pragma unroll
        for (int u = 0; u < 8; ++u) O[rb][u] = (f32x4){0.f, 0.f, 0.f, 0.f};
    float mrun[2] = {-INFINITY, -INFINITY}, lrun[2] = {0.f, 0.f};
    const LAS unsigned char* kbase = kb + (64 * kh + qi) * KPB + 16 * g;
    const LAS unsigned char* vbase = vb + qi * VPB + (64 * kh + 4 * g) * 2;
    ATT_LOAD(0);
    u32x4 qst[6];
    { const bf16_t* qp = WSP(bf16_t, O_Q) + (size_t)(tokb + qb * 128) * 1536 + hd * 192;
#pragma unroll
      for (int i = 0; i < 6; ++i) { const int c = tid + i * NTHREADS, r = c / 24, ch = c % 24; qst[i] = *(const u32x4*)(qp + (size_t)r * 1536 + ch * 8); } }
#pragma unroll
    for (int i = 0; i < 6; ++i) { const int c = tid + i * NTHREADS, r = c / 24, ch = c % 24; *(LAS u32x4*)(qb_l + r * KPB + ch * 16) = qst[i]; }
    ATT_STORE();
    __syncthreads();
    for (int j = 0; j < ntile; ++j) {
        if (j + 1 < ntile) ATT_LOAD(j + 1);
        f32x4 S[2][4];
#pragma unroll
        for (int t = 0; t < 4; ++t) { S[0][t] = (f32x4){0.f, 0.f, 0.f, 0.f}; S[1][t] = (f32x4){0.f, 0.f, 0.f, 0.f}; }
        __builtin_amdgcn_s_setprio(1);
#pragma unroll
        for (int s = 0; s < 6; ++s) { const bf16x8 q0 = *(const LAS bf16x8*)(qbase + 64 * s), q1 = *(const LAS bf16x8*)(qbase + 16 * KPB + 64 * s);
#pragma unroll
            for (int t = 0; t < 4; ++t) { const bf16x8 a = *(const LAS bf16x8*)(kbase + 16 * t * KPB + 64 * s);
                S[0][t] = __builtin_amdgcn_mfma_f32_16x16x32_bf16(a, q0, S[0][t], 0, 0, 0);
                S[1][t] = __builtin_amdgcn_mfma_f32_16x16x32_bf16(a, q1, S[1][t], 0, 0, 0); } }
        __builtin_amdgcn_s_setprio(0);
        bf16x8 pb[2][2];
#pragma unroll
        for (int rb = 0; rb < 2; ++rb) {
            float mx = S[rb][0][0];
#pragma unroll
            for (int t = 0; t < 4; ++t)
#pragma unroll
                for (int i = 0; i < 4; ++i) mx = fmaxf(mx, S[rb][t][i]);
            if (!__all(mx - mrun[rb] <= 11.f)) { mx = xmax32(xmax16(mx)); const float mnew_ = fmaxf(mrun[rb], mx), alpha = __builtin_amdgcn_exp2f(mrun[rb] - mnew_); mrun[rb] = mnew_; lrun[rb] *= alpha;
#pragma unroll
                for (int u = 0; u < 8; ++u) O[rb][u] = O[rb][u] * alpha; }
            const float mnew = mrun[rb];
            float ps = 0.f;
#pragma unroll
            for (int t = 0; t < 4; ++t)
#pragma unroll
                for (int i = 0; i < 4; ++i) { S[rb][t][i] = __builtin_amdgcn_exp2f(S[rb][t][i] - mnew); ps += S[rb][t][i]; }
            lrun[rb] += ps;
#pragma unroll
            for (int c = 0; c < 2; ++c) { u32x4 pw; pw.x = cvt_pk(S[rb][2 * c][0], S[rb][2 * c][1]); pw.y = cvt_pk(S[rb][2 * c][2], S[rb][2 * c][3]); pw.z = cvt_pk(S[rb][2 * c + 1][0], S[rb][2 * c + 1][1]); pw.w = cvt_pk(S[rb][2 * c + 1][2], S[rb][2 * c + 1][3]);
                pb[rb][c] = __builtin_bit_cast(bf16x8, pw); }
        }
        __builtin_amdgcn_s_setprio(1);
#pragma unroll
        for (int c = 0; c < 2; ++c)
#pragma unroll
            for (int u = 0; u < 8; ++u) { const LAS unsigned char* vp = vbase + 16 * u * VPB + 64 * c;
                const u32x2 lo = *(const LAS u32x2*)vp, hi2 = *(const LAS u32x2*)(vp + 32);
                u32x4 aw; aw.x = lo.x; aw.y = lo.y; aw.z = hi2.x; aw.w = hi2.y; const bf16x8 av = __builtin_bit_cast(bf16x8, aw);
                O[0][u] = __builtin_amdgcn_mfma_f32_16x16x32_bf16(av, pb[0][c], O[0][u], 0, 0, 0);
                O[1][u] = __builtin_amdgcn_mfma_f32_16x16x32_bf16(av, pb[1][c], O[1][u], 0, 0, 0); }
        __builtin_amdgcn_s_setprio(0);
        __syncthreads();
        if (j + 1 < ntile) { ATT_STORE(); __syncthreads(); }
    }
    lrun[0] = xsum32(xsum16(lrun[0])); lrun[1] = xsum32(xsum16(lrun[1]));
    LAS float* xch = (LAS float*)lds + (size_t)rbw * 68 * 64 + lane;
    if (kh == 1) {
#pragma unroll
        for (int rb = 0; rb < 2; ++rb) {
#pragma unroll
            for (int u = 0; u < 8; ++u)
#pragma unroll
                for (int i = 0; i < 4; ++i) xch[(rb * 34 + u * 4 + i) * 64] = O[rb][u][i];
            xch[(rb * 34 + 32) * 64] = mrun[rb]; xch[(rb * 34 + 33) * 64] = lrun[rb]; }
    }
    __syncthreads();
    if (kh == 0) {
#pragma unroll
        for (int rb = 0; rb < 2; ++rb) {
            const float m1 = xch[(rb * 34 + 32) * 64], l1 = xch[(rb * 34 + 33) * 64];
            const float m = fmaxf(mrun[rb], m1), a0 = __builtin_amdgcn_exp2f(mrun[rb] - m), a1 = __builtin_amdgcn_exp2f(m1 - m);
            const float il = 1.f / (lrun[rb] * a0 + l1 * a1);
            const int tq = tokq + 16 * rb;
            const bf16_t* gp = WSP(bf16_t, O_Z) + (size_t)tq * ZW + Z_GPM + hd * 128 + 4 * g; bf16_t* op = WSP(bf16_t, O_AM) + (size_t)tq * 1024 + hd * 128 + 4 * g;
#pragma unroll
            for (int u = 0; u < 8; ++u) { const u32x2 gg = *(const u32x2*)(gp + 16 * u); f32x4 o;
#pragma unroll
                for (int i = 0; i < 4; ++i) o[i] = (O[rb][u][i] * a0 + xch[(rb * 34 + u * 4 + i) * 64] * a1) * il;
                u32x2 w; w.x = cvt_pk(o[0] * bflo(gg.x), o[1] * bfhi(gg.x)); w.y = cvt_pk(o[2] * bflo(gg.y), o[3] * bfhi(gg.y));
                *(u32x2*)(op + 16 * u) = w; } }
    }
    __syncthreads();
#undef ATT_LOAD
#undef ATT_STORE
}
constexpr int NPHASE = 2 + 7 * NL;
#define REOPAQUE(X) do { unsigned long long w_ = (unsigned long long)args.ws, o_ = (unsigned long long)args.out, i_ = (unsigned long long)__builtin_amdgcn_kernarg_segment_ptr(); int t_ = threadIdx.x, c_ = blockIdx.x, g_ = gridDim.x; \
    asm volatile("" : "+s"(w_), "+s"(o_), "+s"(i_), "+v"(t_), "+s"(c_), "+s"(g_)); X.ws = (unsigned char*)(GAS unsigned char*)w_; X.out = (float*)(GAS float*)o_; X.in.p = (CPtr64)i_; X.tid = t_; X.c = c_; X.G = g_; } while (0)
#ifndef PROBE_SP
#define PROBE_SP -1
#endif
#ifndef RPTM
#define RPTM 0
#endif
#define NREP(k) ((((RPTM) >> (k)) & 1) + 1)
#ifndef PHM
#define PHM 0xffff
#endif
__global__ void __launch_bounds__(NTHREADS, 2) mk_fwd(Args args) {
    extern __shared__ __attribute__((aligned(16))) unsigned char lds_raw[];
    LAS unsigned char* lds = (LAS unsigned char*)lds_raw;
    cg::grid_group grid = cg::this_grid();
    volatile LAS unsigned* bst = (volatile LAS unsigned*)(lds + LDS_BYTES - 64);
    if (threadIdx.x < 16) bst[threadIdx.x] = 0u;
    __syncthreads();
    XcdBarrier xbar = xcd_barrier_post((unsigned*)(args.ws + O_BAR), bst);
#if PROBE_SP >= 0
    unsigned long long pacc = 0ull;
#endif
    for (int ph = args.ph_lo; ph < args.ph_hi; ++ph) {
#if PROBE_SP >= 0
        const unsigned long long pt0 = __builtin_amdgcn_s_memrealtime();
#endif
        Ctx X; REOPAQUE(X);
        const int tid = X.tid;
        const char* ws = (const char*)X.ws;
        if (ph == 0) { for (int rep = 0; rep < NREP(0); ++rep) if (PHM & 1) phase_prologue(X, lds); }
        else if (ph == 1) { for (int rep = 0; rep < NREP(1); ++rep) {
            if (PHM & 4) phase_rows(X, 0, false, 0); }
        } else {
            const int l = (ph - 2) / 7, sp7 = (ph - 2) % 7, sp = sp7 < 2 ? sp7 : sp7 - 1;
            if (sp7 == 2) { phase_prefix(X, l); REOPAQUE(X); phase_krope(X, l); }
            else if (sp == 0) {
                SchedZ S{ws + O_H, ws + O_WIN + (size_t)l * ZW * 2048 * 2, X.G, X.c, 0}; EpiZ E{WSP(bf16_t, O_Z), WSP(bf16_t, O_VST), WSP(bf16_t, O_RVT), WSP(float, O_RSS), true};
                if (PHM & 8) pg8::gemm_phase(lds, tid, 2048, 2048, 2048, S, E);
            } else if (sp == 1) {
                for (int i = tid; i < 2048; i += NTHREADS) ((LAS float*)(lds + 131072))[i] = WSP(float, O_ROPE)[i];
                __syncthreads();
                { SchedZ S{ws + O_H, ws + O_WIN + (size_t)l * ZW * 2048 * 2, X.G, X.c, 1}; EpiZ E{WSP(bf16_t, O_Z), WSP(bf16_t, O_VST), WSP(bf16_t, O_RVT), WSP(float, O_RSS), true};
                  if (PHM & 8) pg8::gemm_phase(lds, tid, 2048, 2048, 2048, S, E); }
                REOPAQUE(X);
                { const char* ws2 = (const char*)X.ws;
                  SchedQK S{ws2 + O_Z, ws2 + O_WUQ + (size_t)l * 1536 * 512 * 2, ws2 + O_WKG + (size_t)l * 1024 * 512 * 2, X.G, X.c}; EpiQK E{WSP(bf16_t, O_Q), WSP(bf16_t, O_KN), WSP(float, O_RSS), (const LAS float*)(lds + 131072)};
                  if (PHM & 16) pg8::gemm_phase(lds, X.tid, 512, ZW, 512, S, E); }
                { const char* ws2 = (const char*)X.ws;
                  SchedVT S{ws2 + O_Z, ws2 + O_WVG + (size_t)l * 1024 * 512 * 2, X.G, X.c}; EpiVT E{WSP(bf16_t, O_VT), WSP(float, O_RSS)};
                  if (PHM & 32) pg8::gemm_phase(lds, X.tid, 512, 512, ZW, S, E); }
                REOPAQUE(X);
                { const char* ws2 = (const char*)X.ws;
                  SchedC S2{ws2 + O_CKVC, ws2 + O_WKP, ws2 + O_WVP, X.G, X.c, l}; EpiC E2{WSP(bf16_t, O_KC), WSP(bf16_t, O_VTC)};
                  if (PHM & 2) pg8::gemm_phase(lds, X.tid, 512, 512, 512, S2, E2); }
                REOPAQUE(X); if (PHM & 64) phase_misc(X, l);
                REOPAQUE(X);
                { int i0, i1;
                  if (X.G == 256) { const int c = X.c; if (c < 16) { i0 = 2 * c; i1 = i0 + 2; } else if (c < 96) { i0 = 32 + 4 * (c - 16); i1 = i0 + 4; } else if (c < 160) { i0 = 352 + 3 * (c - 96); i1 = i0 + 3; } else { i0 = 544 + 5 * (c - 160); i1 = i0 + 5; } }
                  else { const int per = (1024 + X.G - 1) / X.G; i0 = X.c * per; i1 = i0 + per < 1024 ? i0 + per : 1024; }
                  for (int it = i0; it < i1; ++it) { if (it < 512) { if (PHM & 128) sgu_item(X, lds, l, it); } else { if (PHM & 256) retstate_item(X, lds, l, it - 512); } } }
            } else if (sp == 2) { for (int rep = 0; rep < NREP(4); ++rep) {
                for (int i = X.c * NTHREADS + tid; i < T; i += X.G * NTHREADS) WSP(float, O_RSS)[3 * T + i] = 0.f;
#if PROBE_SP == 200 || PROBE_SP == 201
                const unsigned long long pa0 = __builtin_amdgcn_s_memrealtime();
#endif
                for (int r2 = 0; r2 < NREP(7); ++r2)
                for (int it = X.c; it < 512; it += X.G) if (PHM & 512) {
                    const int x = it & 7, slot = (it & 255) >> 3;
                    const int un = it < 256 ? (((x * 2 + (slot >> 4)) << 4) | (slot & 15)) : 256 + (((x * 16 + (slot >> 1)) << 1) | (slot & 1));
                    attn_unit(X, lds, l, un); }
#if PROBE_SP == 200
                pacc += __builtin_amdgcn_s_memrealtime() - pa0;
#endif
                REOPAQUE(X);
#if PROBE_SP == 201
                const unsigned long long pa1 = __builtin_amdgcn_s_memrealtime();
#endif
                for (int r2 = 0; r2 < NREP(8); ++r2)
                for (int it = X.c; it < 512; it += X.G) if (PHM & 1024) retout_item(X, lds, l, (it < 256) ? 256 + it : it - 256); }
#if PROBE_SP == 201
                pacc += __builtin_amdgcn_s_memrealtime() - pa1;
#endif
            } else if (sp == 3) { for (int rep = 0; rep < NREP(5); ++rep) {
                SchedBr S{ws + O_AM, ws + O_AS, ws + O_AR, ws + O_WBR + (size_t)l * 3 * 2048 * 1024 * 2, X.G, X.c}; EpiBr E{WSP(bf16_t, O_Z), WSP(bf16_t, O_YMB)};
                if (PHM & 2048) pg8::gemm_phase(lds, tid, 1024, 1024, 1024, S, E); }
            } else if (sp == 4) { for (int rep = 0; rep < NREP(6); ++rep) {
                for (int i = X.c * NTHREADS + tid; i < 3 * T; i += X.G * NTHREADS) WSP(float, O_RSS)[i] = 0.f;
                SchedOut S{ws + O_YMB, ws + O_WOUT + (size_t)l * 2048 * 2048 * 2, X.G, X.c}; EpiOut E{WSP(float, O_Y), WSP(float, O_RSS), rep == 0};
                if (PHM & 4096) pg8::gemm_phase(lds, tid, 2048, 2048, 2048, S, E); }
            } else {
                if (PHM & 8192) phase_rows(X, l, true, l + 1);
            }
        }
        if (ph + 1 < args.ph_hi) { if (ph == 0) { __syncthreads(); grid.sync(); } else { REOPAQUE(X); xbar.bar = (unsigned*)(X.ws + O_BAR); xcd_barrier(xbar); } }
#if PROBE_SP >= 0
        if (PROBE_SP < 200) { const bool hit = (PROBE_SP >= 100) ? (ph == PROBE_SP - 100) : (ph >= 2 && (ph - 2) % 7 == PROBE_SP); if (hit) pacc += __builtin_amdgcn_s_memrealtime() - pt0; }
#endif
    }
#if PROBE_SP == 300
    for (int k = 0; k < 20; ++k) xcd_barrier(xbar);
#endif
#if PROBE_SP >= 0
    if (blockIdx.x == 0 && threadIdx.x == 0) { const unsigned long long t1 = __builtin_amdgcn_s_memrealtime(); while (__builtin_amdgcn_s_memrealtime() - t1 < pacc) __builtin_amdgcn_s_sleep(8); }
#endif
}

extern "C" void kernel_launch(void* const* d_in, const int* in_sizes, int n_in, void* d_out, int out_size, void* d_ws, size_t ws_size, hipStream_t stream) {
    static int grid = 0;
    if (grid == 0) {
        if (n_in != 25 || ws_size < WS_END) { fprintf(stderr, "kernel_launch: unexpected n_in %d / ws %zu (need %zu)\n", n_in, ws_size, (size_t)WS_END); grid = -1; return; }
        int dev = 0, cus = 0, per_cu = 0;
        (void)hipGetDevice(&dev); (void)hipDeviceGetAttribute(&cus, hipDeviceAttributeMultiprocessorCount, dev);
        (void)hipFuncSetAttribute((const void*)mk_fwd, hipFuncAttributeMaxDynamicSharedMemorySize, LDS_BYTES);
        (void)hipOccupancyMaxActiveBlocksPerMultiprocessor(&per_cu, (const void*)mk_fwd, NTHREADS, LDS_BYTES);
        if (per_cu < 1) { fprintf(stderr, "kernel_launch: occupancy query says %d blocks per CU\n", per_cu); per_cu = 1; }
        grid = cus * per_cu;
    }
    if (grid < 0) return;
    Args a{};
    for (int i = 0; i < 25; ++i) a.in[i] = (const float*)d_in[i];
    a.out = (float*)d_out; a.ws = (unsigned char*)d_ws;
#if MK_MULTI
    for (int ph = 0; ph < NPHASE; ++ph) { a.ph_lo = ph; a.ph_hi = ph + 1; hipLaunchKernelGGL(mk_fwd, dim3(grid), dim3(NTHREADS), LDS_BYTES, stream, a); }
#else
    a.ph_lo = 0; a.ph_hi = NPHASE;
    (void)hipMemsetAsync((unsigned char*)d_ws + O_BAR, 0, 16384, stream);
    void* kargs[] = {&a};
    hipError_t e = hipLaunchCooperativeKernel((const void*)mk_fwd, dim3(grid), dim3(NTHREADS), kargs, LDS_BYTES, stream);
    if (e != hipSuccess) fprintf(stderr, "cooperative launch failed: %s (grid %d)\n", hipGetErrorString(e), grid);
#endif
}
```

```cpp
#define MK_MULTI 0
#define RPTM 0
#define PROBE_SP -1
#include <hip/hip_runtime.h>
#include <hip/hip_cooperative_groups.h>
#include <cstdio>
namespace cg = cooperative_groups;

#define LAS __attribute__((address_space(3)))
#define GAS __attribute__((address_space(1)))
typedef unsigned short bf16_t;
typedef short bf16x8 __attribute__((ext_vector_type(8)));
typedef float f32x4 __attribute__((ext_vector_type(4)));
typedef float f32x16 __attribute__((ext_vector_type(16)));
typedef unsigned u32x4 __attribute__((ext_vector_type(4)));
typedef unsigned u32x2 __attribute__((ext_vector_type(2)));

constexpr int NTHREADS = 512;
constexpr int LDS_BYTES = 147456;
constexpr int T = 8192, DM = 2048, ZW = 15616, NL = 4, INC = 15424;
constexpr float EPSN = 1e-6f;
constexpr int Z_CQ = 0, Z_CKV = 512, Z_GPM = 1024, Z_U = 2048, Z_VS = 3072, Z_GPS = 4096, Z_RQ = 5120, Z_RK = 6144, Z_RV = 7168, Z_GPR = 8192, Z_MRG = 9216, Z_KR = 15360;
constexpr size_t OUT_YP = 0, OUT_YS = 8388608, OUT_CKV = 16777216, OUT_KR = 25165824, OUT_RET = 26214400;

constexpr size_t O_WIN = 0,                         S_WIN = (size_t)NL * ZW * 2048 * 2;
constexpr size_t O_WUQ = O_WIN + S_WIN,             S_WUQ = (size_t)NL * 1536 * 512 * 2;
constexpr size_t O_WKG = O_WUQ + S_WUQ,             S_WK = (size_t)NL * 1024 * 512 * 2;
constexpr size_t O_WVG = O_WKG + S_WK;
constexpr size_t O_WKP = O_WVG + S_WK;
constexpr size_t O_WVP = O_WKP + S_WK;
constexpr size_t O_WBR = O_WVP + S_WK,              S_WBR = (size_t)NL * 3 * 2048 * 1024 * 2;
constexpr size_t O_WOUT = O_WBR + S_WBR,            S_WOUT = (size_t)NL * 2048 * 2048 * 2;
constexpr size_t O_CKVC = O_WOUT + S_WOUT,          S_CKVC = (size_t)NL * 512 * 512 * 2;
constexpr size_t O_KRC = O_CKVC + S_CKVC,           S_KRC = (size_t)NL * 512 * 64 * 2;
constexpr size_t O_KC = O_KRC + S_KRC,              S_KC = (size_t)NL * 512 * 1024 * 2;
constexpr size_t O_VTC = O_KC + S_KC;
constexpr size_t O_MOD = O_VTC + S_KC,              S_MOD = (size_t)NL * 3 * 6144 * 4;
constexpr size_t O_ROPE = O_MOD + S_MOD,            S_ROPE = 64 * 16 * 8;
constexpr size_t O_RSS = O_ROPE + S_ROPE,           S_RSS = (size_t)4 * T * 4;
constexpr size_t O_H = O_RSS + S_RSS,               S_H = (size_t)T * DM * 2;
constexpr size_t O_X = O_H + S_H,                   S_X = (size_t)T * DM * 4;
constexpr size_t O_Z = O_X + S_X,                   S_Z = (size_t)T * ZW * 2;
constexpr size_t O_VST = O_Z + S_Z,                 S_T16 = (size_t)1024 * T * 2;
constexpr size_t O_RVT = O_VST + S_T16;
constexpr size_t O_VT = O_RVT + S_T16;
constexpr size_t O_KN = O_VT + S_T16;
constexpr size_t O_AM = O_KN + S_T16;
constexpr size_t O_AS = O_AM + S_T16;
constexpr size_t O_AR = O_AS + S_T16;
constexpr size_t O_Q = O_AR + S_T16,                S_Q = (size_t)T * 1536 * 2;
constexpr size_t O_KR = O_Q + S_Q,                  S_KR = (size_t)T * 64 * 2;
constexpr size_t O_ST = O_KR + S_KR,                S_ST = (size_t)64 * 8 * 2 * 16384 * 4;
constexpr size_t O_YMF = O_ST + S_ST;
constexpr size_t O_YMB = O_YMF + S_X;
constexpr size_t O_Y = O_YMB + S_H;
constexpr size_t O_PF = O_Y + S_X,                  S_PF = (size_t)64 * 8 * 2 * 16384 * 2;
constexpr size_t O_BAR = O_PF + S_PF;
constexpr size_t WS_END = O_BAR + 16384;

struct Args { const float* in[25]; float* out; unsigned char* ws; int ph_lo, ph_hi; };

__device__ __forceinline__ unsigned cvt_pk(float lo, float hi) { unsigned r; asm volatile("v_cvt_pk_bf16_f32 %0, %1, %2" : "=v"(r) : "v"(lo), "v"(hi)); return r; }
__device__ __forceinline__ float bf2f(unsigned short b) { return __uint_as_float(((unsigned)b) << 16); }
__device__ __forceinline__ float bflo(unsigned w) { return __uint_as_float(w << 16); }
__device__ __forceinline__ float bfhi(unsigned w) { return __uint_as_float(w & 0xffff0000u); }
__device__ __forceinline__ float sigm_f(float x) { return __builtin_amdgcn_rcpf(1.f + __builtin_amdgcn_exp2f(x * -1.4426950408889634f)); }
__device__ __forceinline__ float silu_f(float x) { return x * sigm_f(x); }
__device__ __forceinline__ float wave_sum(float v) {
#pragma unroll
    for (int o = 1; o < 64; o <<= 1) v += __shfl_xor(v, o);
    return v;
}

namespace pg8 {
constexpr int BM = 256, BK = 64, HALF = 128, HTB = HALF * BK * 2, STAGE_BYTES = 8 * HTB, NXCD = 8, WGM = 8;
__host__ __device__ __forceinline__ int lds_byte(int r, int c) { const int st = (r >> 4) * 2 + (c >> 5), rr = r & 15, cc = c & 31, ob = rr * 64 + cc * 2; return st * 1024 + (ob ^ (((ob >> 9) & 1) << 5)); }
__host__ __device__ __forceinline__ void stage_rc(int b, int& R, int& C) { const int st = b / 1024, sb = b % 1024, swz = sb ^ (((sb >> 9) & 1) << 5); R = (st >> 1) * 16 + swz / 64; C = (st & 1) * 32 + (swz % 64) / 2; }
__host__ __device__ __forceinline__ int perm32(int rho) { const int n = rho >> 4, i = rho & 15; return 8 * (i >> 2) + 4 * n + (i & 3); }

struct Unit { const char* a; const char* b; int pm, pn, kind, aux; };

__device__ __forceinline__ void tile_order(int L, int nM, int nN, int& pm, int& pn) {
    const int nwg = nM * nN; int wgid = L; { const int q = nwg / NXCD, r = nwg % NXCD, xcd = wgid % NXCD, off = wgid / NXCD; wgid = (xcd < r ? xcd * (q + 1) : r * (q + 1) + (xcd - r) * q) + off; }
    const int nig = WGM * nN, gid = wgid / nig, fm = gid * WGM, gsz = (nM - fm) < WGM ? (nM - fm) : WGM;
    pm = fm + ((wgid % nig) % gsz); pn = (wgid % nig) / gsz;
}

template <class Epi, class Sched>
__device__ __forceinline__ void gemm_phase(LAS unsigned char* lds, const int tid, const int K, const int lda, const int ldb, const Sched& S, const Epi& E) {
    const int  wid = __builtin_amdgcn_readfirstlane(tid >> 6), lane = tid & 63, wr = wid >> 2, wc = wid & 3, fr = lane & 15, fq = lane >> 4;
    const int nt = K / BK;
    unsigned voffA[2], voffB[2];
#pragma unroll
    for (int i = 0; i < 2; ++i) { int R, C; stage_rc(tid * 16 + i * 8192, R, C); const int Rb = (R & ~31) + perm32(R & 31);
        voffA[i] = (unsigned)(R * lda + C) * 2u; voffB[i] = (unsigned)(Rb * ldb + C) * 2u; }
    const size_t kstep = (size_t)(BK * 2);
    const size_t hstepA = (size_t)HALF * lda * 2, hstepB = (size_t)HALF * ldb * 2;
    const unsigned ldsw = (unsigned)wid * 1024u;
    const int aoff = lds_byte(wr * 64 + fr, fq * 8), boff = lds_byte(wc * 32 + fr, fq * 8);
#define PG8_SA(b, h) (((b) * 2 + (h)) * HTB)
#define PG8_SB(b, h) ((4 + (b) * 2 + (h)) * HTB)
#define PG8_STAGE(bufoff, gbase, voff) do { _Pragma("unroll") for (int _i = 0; _i < 2; ++_i) \
        __builtin_amdgcn_global_load_lds((const unsigned*)((const char*)(gbase) + (voff)[_i]), (LAS unsigned*)(lds + (bufoff) + ldsw + _i * 8192), 16, 0, 0); } while (0)
#define PG8_LDA(dst, b, h) do { _Pragma("unroll") for (int m = 0; m < 4; ++m) _Pragma("unroll") for (int k = 0; k < 2; ++k) dst[m][k] = *(const LAS bf16x8*)(lds + PG8_SA(b, h) + aoff + m * 2048 + k * 1024); } while (0)
#define PG8_LDB(dst, b, h) do { _Pragma("unroll") for (int n = 0; n < 2; ++n) _Pragma("unroll") for (int k = 0; k < 2; ++k) dst[n][k] = *(const LAS bf16x8*)(lds + PG8_SB(b, h) + boff + n * 2048 + k * 1024); } while (0)
#define PG8_MMA(ai, bj, At, Bt) do { __builtin_amdgcn_s_setprio(1); _Pragma("unroll") for (int m = 0; m < 4; ++m) _Pragma("unroll") for (int n = 0; n < 2; ++n) _Pragma("unroll") for (int k = 0; k < 2; ++k) \
        acc[ai][bj][m][n] = __builtin_amdgcn_mfma_f32_16x16x32_bf16(Bt[n][k], At[m][k], acc[ai][bj][m][n], 0, 0, 0); __builtin_amdgcn_s_setprio(0); } while (0)
#define PG8_WAIT_V(n) asm volatile("s_waitcnt vmcnt(" #n ")" ::: "memory")
#define PG8_WAIT_L(n) asm volatile("s_waitcnt lgkmcnt(" #n ")" ::: "memory")
#define PG8_BAR __builtin_amdgcn_s_barrier()
#define PG8_SCHED __builtin_amdgcn_sched_barrier(0)
    Unit cur, nxt; int ui = 0;
    if (!S.next(0, cur)) return;
    f32x4 acc[2][2][4][2];
#pragma unroll
    for (int a = 0; a < 2; ++a)
#pragma unroll
        for (int b = 0; b < 2; ++b)
#pragma unroll
            for (int m = 0; m < 4; ++m)
#pragma unroll
                for (int n = 0; n < 2; ++n) acc[a][b][m][n] = (f32x4){0.f, 0.f, 0.f, 0.f};
    bf16x8 At[4][2], B0[2][2], B1[2][2];
    const char* cA = cur.a; const char* cB = cur.b;
    PG8_STAGE(PG8_SB(0, 0), cB, voffB); PG8_STAGE(PG8_SA(0, 0), cA, voffA); PG8_STAGE(PG8_SB(0, 1), cB + hstepB, voffB); PG8_STAGE(PG8_SA(0, 1), cA + hstepA, voffA);
    if (wr == 1) PG8_BAR;
    PG8_WAIT_V(4); PG8_BAR;
    PG8_STAGE(PG8_SB(1, 0), cB + kstep, voffB); PG8_STAGE(PG8_SA(1, 0), cA + kstep, voffA); PG8_STAGE(PG8_SB(1, 1), cB + hstepB + kstep, voffB);
    PG8_WAIT_V(6); PG8_BAR;
    for (;;) {
        const bool has_next = S.next(ui + 1, nxt);
        const char* nA = has_next ? nxt.a : cA; const char* nB = has_next ? nxt.b : cB;
        for (int t = 0; t < nt; t += 2) {
            const bool last = (t == nt - 2);
            const char* a1 = cA + (size_t)(t + 1) * kstep;
            const char* a2 = last ? nA : cA + (size_t)(t + 2) * kstep; const char* b2 = last ? nB : cB + (size_t)(t + 2) * kstep;
            const char* a3 = a2 + kstep; const char* b3 = b2 + kstep;
            PG8_LDB(B0, 0, 0); PG8_SCHED; PG8_LDA(At, 0, 0); PG8_STAGE(PG8_SA(1, 1), a1 + hstepA, voffA);
            PG8_WAIT_L(8); PG8_BAR; PG8_WAIT_L(0); PG8_MMA(0, 0, At, B0); PG8_BAR; PG8_SCHED;
            PG8_LDB(B1, 0, 1); PG8_STAGE(PG8_SB(0, 0), b2, voffB);
            PG8_BAR; PG8_WAIT_L(0); PG8_MMA(0, 1, At, B1); PG8_BAR;
            PG8_LDA(At, 0, 1); PG8_STAGE(PG8_SA(0, 0), a2, voffA);
            PG8_BAR; PG8_WAIT_L(0); PG8_MMA(1, 0, At, B0); PG8_BAR; PG8_SCHED;
            PG8_STAGE(PG8_SB(0, 1), b2 + hstepB, voffB);
            PG8_WAIT_V(6); PG8_BAR; PG8_MMA(1, 1, At, B1); PG8_BAR;
            PG8_LDB(B0, 1, 0); PG8_SCHED; PG8_LDA(At, 1, 0); PG8_STAGE(PG8_SA(0, 1), a2 + hstepA, voffA);
            PG8_WAIT_L(8); PG8_BAR; PG8_WAIT_L(0); PG8_MMA(0, 0, At, B0); PG8_BAR; PG8_SCHED;
            PG8_LDB(B1, 1, 1); PG8_STAGE(PG8_SB(1, 0), b3, voffB);
            PG8_BAR; PG8_WAIT_L(0); PG8_MMA(0, 1, At, B1); PG8_BAR;
            PG8_LDA(At, 1, 1); PG8_STAGE(PG8_SA(1, 0), a3, voffA);
            PG8_BAR; PG8_WAIT_L(0); PG8_MMA(1, 0, At, B0); PG8_BAR; PG8_SCHED;
            PG8_STAGE(PG8_SB(1, 1), b3 + hstepB, voffB);
            PG8_WAIT_V(6); PG8_BAR; PG8_MMA(1, 1, At, B1); PG8_BAR;
        }
        E(acc, cur, wr, wc, fr, fq);
        if (!has_next) break;
        if (cur.aux != 1)
#pragma unroll
        for (int a = 0; a < 2; ++a)
#pragma unroll
            for (int b = 0; b < 2; ++b)
#pragma unroll
                for (int m = 0; m < 4; ++m)
#pragma unroll
                    for (int n = 0; n < 2; ++n) acc[a][b][m][n] = (f32x4){0.f, 0.f, 0.f, 0.f};
        cur = nxt; cA = nA; cB = nB; ++ui;
    }
    PG8_WAIT_V(0);
    if (wr == 0) PG8_BAR;
    PG8_BAR;
#undef PG8_SA
#undef PG8_SB
#undef PG8_STAGE
#undef PG8_LDA
#undef PG8_LDB
#undef PG8_MMA
#undef PG8_WAIT_V
#undef PG8_WAIT_L
#undef PG8_BAR
#undef PG8_SCHED
}
}
typedef f32x4 (&AccRef)[2][2][4][2];

#define XB_TMO      128
#define XB_XCNT(j)  (256  + 64 * (j))
#define XB_XSUB(j)  (1280 + 64 * (j))
#define XB_XGEN(j)  (2304 + 64 * (j))
#define XB_TOP      3328
#define XB_TOPGEN   3392
#define XCD_BAR_WORDS 3456
#define XB_SPIN_CAP (1u << 22)
__device__ __forceinline__ unsigned xb_ld(unsigned* p)              { return __hip_atomic_load(p, __ATOMIC_RELAXED, __HIP_MEMORY_SCOPE_AGENT); }
__device__ __forceinline__ unsigned xb_add(unsigned* p, unsigned v) { return __hip_atomic_fetch_add(p, v, __ATOMIC_RELAXED, __HIP_MEMORY_SCOPE_AGENT); }
__device__ __forceinline__ unsigned xb_xcc_id() { return (unsigned)__builtin_amdgcn_s_getreg((3 << 11) | 20) & 0xFu; }
#define XB_SPIN(cond, bar) do { unsigned _sp = 0; while (cond) { __builtin_amdgcn_s_sleep(1); \
    if ((++_sp & 255u) == 0u) { if (xb_ld(&(bar)[XB_TMO])) break; if (_sp > XB_SPIN_CAP) { atomicAdd(&(bar)[XB_TMO], 1u); break; } } } } while (0)
struct XcdBarrier { unsigned* bar; unsigned x; volatile LAS unsigned* st; };
__device__ __forceinline__ XcdBarrier xcd_barrier_post(unsigned* bar, volatile LAS unsigned* st) {
    XcdBarrier b; b.bar = bar; b.x = xb_xcc_id(); b.st = st;
    if (threadIdx.x == 0) (void)xb_add(&bar[XB_XCNT(b.x)], 1u);
    return b;
}
__device__ __forceinline__ void xcd_barrier_complete(unsigned* bar, unsigned x, unsigned& nloc, unsigned& nx) {
    const unsigned G = gridDim.x * gridDim.y * gridDim.z;
    unsigned sum, cnt, mine, sp = 0u;
    for (;;) {
        sum = 0u; cnt = 0u; mine = 0u;
#pragma unroll
        for (unsigned j = 0; j < 16; ++j) { const unsigned c = xb_ld(&bar[XB_XCNT(j)]); sum += c; cnt += (c > 0u) ? 1u : 0u; }
        mine = xb_ld(&bar[XB_XCNT(x)]);
        if (sum == G) break;
        __builtin_amdgcn_s_sleep(1);
        if ((++sp & 255u) == 0u) { if (xb_ld(&bar[XB_TMO])) break; if (sp > XB_SPIN_CAP) { atomicAdd(&bar[XB_TMO], 1u); break; } }
    }
    nloc = mine > 0u ? mine : 1u; nx = cnt > 0u ? cnt : 1u;
}
__device__ __forceinline__ void xcd_barrier(const XcdBarrier& b) {
    asm volatile("s_waitcnt vmcnt(0)" ::: "memory");
    __syncthreads();
    if (threadIdx.x == 0) {
        unsigned* bar = b.bar;
        __builtin_amdgcn_s_waitcnt(0);
        unsigned nloc = b.st[0], nx = b.st[1];
        if (nloc == 0u) { xcd_barrier_complete(bar, b.x, nloc, nx); b.st[0] = nloc; b.st[1] = nx; }
        const unsigned old = xb_add(&bar[XB_XSUB(b.x)], 1u);
        const unsigned gen = old / nloc;
        if (old + 1u == (gen + 1u) * nloc) {
            __builtin_amdgcn_fence(__ATOMIC_RELEASE, "agent");
            asm volatile("s_waitcnt vmcnt(0)" ::: "memory");
            const unsigned og = xb_add(&bar[XB_TOP], 1u);
            const unsigned tg = og / nx;
            if (og + 1u == (tg + 1u) * nx) xb_add(&bar[XB_TOPGEN], 1u);
            else XB_SPIN(xb_ld(&bar[XB_TOPGEN]) == tg, bar);
            __builtin_amdgcn_fence(__ATOMIC_ACQUIRE, "agent");
            xb_add(&bar[XB_XGEN(b.x)], 1u);
            asm volatile("s_waitcnt vmcnt(0)" ::: "memory");
        } else {
            XB_SPIN(xb_ld(&bar[XB_XGEN(b.x)]) == gen, bar);
            __builtin_amdgcn_fence(__ATOMIC_ACQUIRE, "agent");
            asm volatile("s_waitcnt vmcnt(0)" ::: "memory");
        }
    }
    __syncthreads();
}
using pg8::Unit;
typedef const unsigned long long __attribute__((address_space(4)))* CPtr64;
struct InTab { CPtr64 p; __device__ __forceinline__ const float* operator[](int i) const { return (const float*)(GAS const float*)p[i]; } };
struct Ctx {
    unsigned char* ws; float* out; InTab in;
    int G, c, tid;
};
#define WSP(T_, off) ((T_*)(X.ws + (off)))

struct SchedZ {
    const char* h; const char* w; int G, c, mode;
    __device__ __forceinline__ bool next(int i, Unit& u) const {
        const int ntn = mode ? 37 : 24; const long Lx = (long)i * G + c; if (Lx >= 32 * ntn) return false;
        int pm, pj; pg8::tile_order((int)Lx, 32, ntn, pm, pj);
        const int pn = mode ? (pj < 4 ? 4 + pj : pj < 8 ? 16 + pj : 24 + pj) : (pj < 4 ? pj : pj < 16 ? pj + 4 : pj + 8);
        const char* hp = h + (size_t)pm * 256 * 2048 * 2; const char* wp = w + (size_t)pn * 256 * 2048 * 2;
        const bool sw = (pn >= 12 && pn < 16) || (pn >= 28 && pn < 32);
        u.pm = pm; u.pn = pn; u.kind = sw ? 1 : 0; u.aux = 0; u.a = sw ? wp : hp; u.b = sw ? hp : wp; return true;
    }
};
struct EpiZ {
    bf16_t* z; bf16_t* vsT; bf16_t* rvT; float* rss; bool doss;
    __device__ __forceinline__ void operator()(AccRef acc, const Unit& u, int wr, int wc, int fr, int fq) const {
        if (u.kind == 0) {
            const int pn = u.pn;
            const int act = (pn >= 36 && pn < 60) ? 2 : ((pn >= 4 && pn < 8) || (pn >= 16 && pn < 20) || (pn >= 32 && pn < 36)) ? 1 : (pn >= 24 && pn < 28) ? 3 : 0;
            const int row0 = u.pm * 256 + wr * 64 + fr, col0 = pn * 256 + wc * 32 + 8 * fq;
#pragma unroll
            for (int ai = 0; ai < 2; ++ai)
#pragma unroll
                for (int m = 0; m < 4; ++m) {
                    const int row = row0 + ai * 128 + m * 16; bf16_t* rowp = z + (size_t)row * ZW + col0; float ss = 0.f;
#pragma unroll
                    for (int bj = 0; bj < 2; ++bj) { f32x4 v0 = acc[ai][bj][m][0], v1 = acc[ai][bj][m][1];
                        if (act == 0) { ss += v0[0] * v0[0] + v0[1] * v0[1] + v0[2] * v0[2] + v0[3] * v0[3] + v1[0] * v1[0] + v1[1] * v1[1] + v1[2] * v1[2] + v1[3] * v1[3]; }
                        else if (act == 1) {
#pragma unroll
                            for (int j = 0; j < 4; ++j) { v0[j] = silu_f(v0[j]); v1[j] = silu_f(v1[j]); } }
                        else if (act == 2) {
#pragma unroll
                            for (int j = 0; j < 4; ++j) { v0[j] = fmaxf(sigm_f(v0[j]), 1e-20f); v1[j] = fmaxf(sigm_f(v1[j]), 1e-20f); } }
                        else { v0 = v0 * 0.08838834764831845f; v1 = v1 * 0.08838834764831845f; }
                        u32x4 w; w.x = cvt_pk(v0[0], v0[1]); w.y = cvt_pk(v0[2], v0[3]); w.z = cvt_pk(v1[0], v1[1]); w.w = cvt_pk(v1[2], v1[3]);
                        *(u32x4*)(rowp + bj * 128) = w; }
                    if (pn < 4 && doss) { ss += __shfl_xor(ss, 16); ss += __shfl_xor(ss, 32); if (fq == 0) atomicAdd(rss + (pn >> 1) * T + row, ss); }
                }
        } else {
            const bool isv = u.pn < 16; bf16_t* dst = isv ? vsT : rvT; const int f0 = (u.pn - (isv ? 12 : 28)) * 256 + wr * 64 + fr, tok0 = u.pm * 256 + wc * 32 + 8 * fq;
            float cs[2][2][4];
#pragma unroll
            for (int bj = 0; bj < 2; ++bj)
#pragma unroll
                for (int n = 0; n < 2; ++n)
#pragma unroll
                    for (int j = 0; j < 4; ++j) cs[bj][n][j] = 0.f;
#pragma unroll
            for (int ai = 0; ai < 2; ++ai)
#pragma unroll
                for (int m = 0; m < 4; ++m) { bf16_t* rowp = dst + (size_t)(f0 + ai * 128 + m * 16) * T + tok0;
#pragma unroll
                    for (int bj = 0; bj < 2; ++bj) { const f32x4 v0 = acc[ai][bj][m][0], v1 = acc[ai][bj][m][1];
#pragma unroll
                        for (int j = 0; j < 4; ++j) { cs[bj][0][j] += v0[j] * v0[j]; cs[bj][1][j] += v1[j] * v1[j]; }
                        u32x4 w; w.x = cvt_pk(v0[0], v0[1]); w.y = cvt_pk(v0[2], v0[3]); w.z = cvt_pk(v1[0], v1[1]); w.w = cvt_pk(v1[2], v1[3]);
                        *(u32x4*)(rowp + bj * 128) = w; } }
            if (isv && doss) {
#pragma unroll
                for (int bj = 0; bj < 2; ++bj)
#pragma unroll
                    for (int n = 0; n < 2; ++n)
#pragma unroll
                        for (int j = 0; j < 4; ++j) { float s = cs[bj][n][j]; s += __shfl_xor(s, 1); s += __shfl_xor(s, 2); s += __shfl_xor(s, 4); s += __shfl_xor(s, 8);
                            if (fr == 0) atomicAdd(rss + 2 * T + tok0 + bj * 128 + n * 4 + j, s); }
            }
        }
    }
};

__device__ __forceinline__ int deal_qk(int i, int G, int c) {
    if (G != 256) { const int L = i * G + c; return L < 320 ? L : -1; }
    if (c < 160) return i == 0 ? c : -1;
    const int r = c - 160; if (r < 64) return i < 2 ? 160 + 2 * r + i : -1;
    return i == 0 ? 288 + (r - 64) : -1;
}
__device__ __forceinline__ int deal_vt(int i, int G, int c) {
    if (G != 256) { const int L = i * G + c; return L < 128 ? L : -1; }
    if (c < 160) return -1;
    const int r = c - 160; if (r < 64) return i == 0 ? r : -1;
    return i < 2 ? 64 + 2 * (r - 64) + i : -1;
}
struct SchedQK {
    const char* z; const char* wq; const char* wk; int G, c;
    __device__ __forceinline__ bool next(int i, Unit& u) const {
        const int Lx = deal_qk(i, G, c); if (Lx < 0) return false;
        if (Lx < 192) { u.pm = Lx / 6; u.pn = Lx % 6; u.kind = 0; u.a = z + (size_t)u.pm * 256 * ZW * 2 + Z_CQ * 2; u.b = wq + (size_t)u.pn * 256 * 512 * 2; }
        else { const int r = Lx - 192; u.pm = r / 4; u.pn = r % 4; u.kind = 1; u.a = z + (size_t)u.pm * 256 * ZW * 2 + Z_CKV * 2; u.b = wk + (size_t)u.pn * 256 * 512 * 2; }
        u.aux = 0; return true;
    }
};
constexpr float QSCALE = 0.07216878364870322f * 1.4426950408889634f;
struct EpiQK {
    bf16_t* q; bf16_t* kn; const float* rss; const LAS float* rope;
    __device__ __forceinline__ void operator()(AccRef acc, const Unit& u, int wr, int wc, int fr, int fq) const {
        const int row0 = u.pm * 256 + wr * 64 + fr, col0 = u.pn * 256 + wc * 32 + 8 * fq;
        float rr[2][4];
#pragma unroll
        for (int ai = 0; ai < 2; ++ai)
#pragma unroll
            for (int m = 0; m < 4; ++m) rr[ai][m] = rss[(u.kind == 0 ? 0 : T) + row0 + ai * 128 + m * 16];
        __builtin_amdgcn_sched_barrier(0);
        if (u.kind == 0) {
#pragma unroll
            for (int ai = 0; ai < 2; ++ai)
#pragma unroll
                for (int m = 0; m < 4; ++m) {
                    const int row = row0 + ai * 128 + m * 16; const float ri = rsqrtf(rr[ai][m] * (1.f / 512.f) + EPSN) * QSCALE;
                    const int t = (row - 4096) & 2047;
#pragma unroll
                    for (int bj = 0; bj < 2; ++bj) { f32x4 v0 = acc[ai][bj][m][0] * ri, v1 = acc[ai][bj][m][1] * ri;
                        const int g0 = u.pn * 256 + bj * 128 + wc * 32, off = g0 % 192;
                        if (off >= 128 && row >= 4096) {
                            const int p = (off == 128) ? (t >> 6) : (t & 63); const LAS float* tb = rope + (p * 16 + (fq & 1) * 8) * 2;
                            const float sg = (fq & 2) ? 1.f : -1.f;
#pragma unroll
                            for (int j = 0; j < 4; ++j) { const float p0 = __shfl_xor(v0[j], 32), p1 = __shfl_xor(v1[j], 32);
                                const float c0 = tb[2 * j], s0 = tb[2 * j + 1], c1 = tb[2 * (4 + j)], s1 = tb[2 * (4 + j) + 1];
                                v0[j] = v0[j] * c0 + sg * p0 * s0; v1[j] = v1[j] * c1 + sg * p1 * s1; }
                        }
                        u32x4 w; w.x = cvt_pk(v0[0], v0[1]); w.y = cvt_pk(v0[2], v0[3]); w.z = cvt_pk(v1[0], v1[1]); w.w = cvt_pk(v1[2], v1[3]);
                        *(u32x4*)(q + (size_t)row * 1536 + col0 + bj * 128) = w; }
                }
        } else {
#pragma unroll
            for (int ai = 0; ai < 2; ++ai)
#pragma unroll
                for (int m = 0; m < 4; ++m) {
                    const int row = row0 + ai * 128 + m * 16; const float ri = rsqrtf(rr[ai][m] * (1.f / 512.f) + EPSN);
#pragma unroll
                    for (int bj = 0; bj < 2; ++bj) { const f32x4 v0 = acc[ai][bj][m][0] * ri, v1 = acc[ai][bj][m][1] * ri;
                        u32x4 w; w.x = cvt_pk(v0[0], v0[1]); w.y = cvt_pk(v0[2], v0[3]); w.z = cvt_pk(v1[0], v1[1]); w.w = cvt_pk(v1[2], v1[3]);
                        *(u32x4*)(kn + (size_t)row * 1024 + col0 + bj * 128) = w; }
                }
        }
    }
};

struct SchedVT {
    const char* z; const char* wv; int G, c;
    __device__ __forceinline__ bool next(int i, Unit& u) const {
        const int Lx = deal_vt(i, G, c); if (Lx < 0) return false;
        u.pm = Lx & 3; u.pn = Lx >> 2; u.kind = 0; u.aux = 0; u.a = wv + (size_t)u.pm * 256 * 512 * 2; u.b = z + (size_t)u.pn * 256 * ZW * 2 + Z_CKV * 2; return true;
    }
};
struct EpiVT {
    bf16_t* vt; const float* rss;
    __device__ __forceinline__ void operator()(AccRef acc, const Unit& u, int wr, int wc, int fr, int fq) const {
        const int f0 = u.pm * 256 + wr * 64 + fr, tok0 = u.pn * 256 + wc * 32 + 8 * fq;
        f32x4 ri[2][2];
#pragma unroll
        for (int bj = 0; bj < 2; ++bj)
#pragma unroll
            for (int n = 0; n < 2; ++n)
#pragma unroll
                for (int j = 0; j < 4; ++j) ri[bj][n][j] = rsqrtf(rss[T + tok0 + bj * 128 + n * 4 + j] * (1.f / 512.f) + EPSN);
#pragma unroll
        for (int ai = 0; ai < 2; ++ai)
#pragma unroll
            for (int m = 0; m < 4; ++m) { bf16_t* rowp = vt + (size_t)(f0 + ai * 128 + m * 16) * T + tok0;
#pragma unroll
                for (int bj = 0; bj < 2; ++bj) { const f32x4 v0 = acc[ai][bj][m][0] * ri[bj][0], v1 = acc[ai][bj][m][1] * ri[bj][1];
                    u32x4 w; w.x = cvt_pk(v0[0], v0[1]); w.y = cvt_pk(v0[2], v0[3]); w.z = cvt_pk(v1[0], v1[1]); w.w = cvt_pk(v1[2], v1[3]);
                    *(u32x4*)(rowp + bj * 128) = w; } }
    }
};

struct SchedC {
    const char* cc; const char* wk; const char* wv; int G, c, l;
    __device__ __forceinline__ bool next(int i, Unit& u) const {
        const int r = i * G + c; if (r >= 16) return false;
        u.aux = l;
        if (r < 8) { u.kind = 0; u.pm = r >> 2; u.pn = r & 3; u.a = cc + ((size_t)l * 512 + u.pm * 256) * 512 * 2; u.b = wk + ((size_t)l * 1024 + u.pn * 256) * 512 * 2; }
        else { const int s = r - 8; u.kind = 1; u.pm = s >> 1; u.pn = s & 1; u.a = wv + ((size_t)l * 1024 + u.pm * 256) * 512 * 2; u.b = cc + ((size_t)l * 512 + u.pn * 256) * 512 * 2; }
        return true;
    }
};
struct EpiC {
    bf16_t* kc; bf16_t* vtc;
    __device__ __forceinline__ void operator()(AccRef acc, const Unit& u, int wr, int wc, int fr, int fq) const {
        const int r0 = u.pm * 256 + wr * 64 + fr, c0 = u.pn * 256 + wc * 32 + 8 * fq;
        bf16_t* base = u.kind == 0 ? kc + (size_t)u.aux * 512 * 1024 : vtc + (size_t)u.aux * 1024 * 512; const int ld = u.kind == 0 ? 1024 : 512;
#pragma unroll
        for (int ai = 0; ai < 2; ++ai)
#pragma unroll
            for (int m = 0; m < 4; ++m) { bf16_t* rowp = base + (size_t)(r0 + ai * 128 + m * 16) * ld + c0;
#pragma unroll
                for (int bj = 0; bj < 2; ++bj) { const f32x4 v0 = acc[ai][bj][m][0], v1 = acc[ai][bj][m][1];
                    u32x4 w; w.x = cvt_pk(v0[0], v0[1]); w.y = cvt_pk(v0[2], v0[3]); w.z = cvt_pk(v1[0], v1[1]); w.w = cvt_pk(v1[2], v1[3]);
                    *(u32x4*)(rowp + bj * 128) = w; } }
    }
};

struct SchedBr {
    const char* am; const char* as; const char* ar; const char* w; int G, c;
    __device__ __forceinline__ bool next(int i, Unit& u) const {
        const int tile = (i / 3) * G + c; if (tile >= 256) return false;
        const int br = i % 3; pg8::tile_order(tile, 32, 8, u.pm, u.pn); u.kind = br; u.aux = br < 2 ? 1 : 0;
        u.a = (br == 0 ? am : br == 1 ? as : ar) + (size_t)u.pm * 256 * 1024 * 2; u.b = w + ((size_t)br * 2048 + u.pn * 256) * 1024 * 2; return true;
    }
};
struct EpiBr {
    const bf16_t* z; bf16_t* ymb;
    __device__ __forceinline__ void operator()(AccRef acc, const Unit& u, int wr, int wc, int fr, int fq) const {
        const int row0 = u.pm * 256 + wr * 64 + fr, col0 = u.pn * 256 + wc * 32 + 8 * fq;
#pragma unroll
        for (int ai = 0; ai < 2; ++ai) {
            u32x4 g0[4][2], g1[4][2];
#pragma unroll
            for (int m = 0; m < 4; ++m)
#pragma unroll
                for (int bj = 0; bj < 2; ++bj) { const bf16_t* mp = z + (size_t)(row0 + ai * 128 + m * 16) * ZW + Z_MRG + u.kind * 2048 + col0 + bj * 128;
                    g0[m][bj] = *(const u32x4*)mp; if (u.kind < 2) g1[m][bj] = *(const u32x4*)(mp + 2048); }
            __builtin_amdgcn_sched_barrier(0);
#pragma unroll
            for (int m = 0; m < 4; ++m) { const int row = row0 + ai * 128 + m * 16;
#pragma unroll
                for (int bj = 0; bj < 2; ++bj) { const int col = col0 + bj * 128;
                    const u32x4 mg = g0[m][bj];
                    f32x4 s0, s1; s0[0] = bflo(mg.x); s0[1] = bfhi(mg.x); s0[2] = bflo(mg.y); s0[3] = bfhi(mg.y); s1[0] = bflo(mg.z); s1[1] = bfhi(mg.z); s1[2] = bflo(mg.w); s1[3] = bfhi(mg.w);
                    if (u.kind < 2) { const u32x4 mn = g1[m][bj];
                        s0[0] *= __builtin_amdgcn_rcpf(bflo(mn.x)); s0[1] *= __builtin_amdgcn_rcpf(bfhi(mn.x)); s0[2] *= __builtin_amdgcn_rcpf(bflo(mn.y)); s0[3] *= __builtin_amdgcn_rcpf(bfhi(mn.y));
                        s1[0] *= __builtin_amdgcn_rcpf(bflo(mn.z)); s1[1] *= __builtin_amdgcn_rcpf(bfhi(mn.z)); s1[2] *= __builtin_amdgcn_rcpf(bflo(mn.w)); s1[3] *= __builtin_amdgcn_rcpf(bfhi(mn.w));
                        acc[ai][bj][m][0] *= s0; acc[ai][bj][m][1] *= s1; }
                    else { const f32x4 v0 = acc[ai][bj][m][0] * s0, v1 = acc[ai][bj][m][1] * s1;
                        u32x4 w; w.x = cvt_pk(v0[0], v0[1]); w.y = cvt_pk(v0[2], v0[3]); w.z = cvt_pk(v1[0], v1[1]); w.w = cvt_pk(v1[2], v1[3]);
                        *(u32x4*)(ymb + (size_t)row * DM + col) = w; }
                } }
            __builtin_amdgcn_sched_barrier(0);
        }
    }
};

struct SchedOut {
    const char* a; const char* w; int G, c;
    __device__ __forceinline__ bool next(int i, Unit& u) const {
        const int tile = i * G + c; if (tile >= 256) return false;
        pg8::tile_order(tile, 32, 8, u.pm, u.pn); u.kind = 0; u.aux = 0; u.a = a + (size_t)u.pm * 256 * 2048 * 2; u.b = w + (size_t)u.pn * 256 * 2048 * 2; return true;
    }
};
struct EpiOut {
    float* y; float* rss; bool doss;
    __device__ __forceinline__ void operator()(AccRef acc, const Unit& u, int wr, int wc, int fr, int fq) const {
        const int row0 = u.pm * 256 + wr * 64 + fr, col0 = u.pn * 256 + wc * 32 + 8 * fq;
#pragma unroll
        for (int ai = 0; ai < 2; ++ai)
#pragma unroll
            for (int m = 0; m < 4; ++m) { const int row = row0 + ai * 128 + m * 16; float ss = 0.f;
#pragma unroll
                for (int bj = 0; bj < 2; ++bj) { const f32x4 v0 = acc[ai][bj][m][0], v1 = acc[ai][bj][m][1]; float* yp = y + (size_t)row * DM + col0 + bj * 128;
                    ss += v0[0] * v0[0] + v0[1] * v0[1] + v0[2] * v0[2] + v0[3] * v0[3] + v1[0] * v1[0] + v1[1] * v1[1] + v1[2] * v1[2] + v1[3] * v1[3];
                    *(f32x4*)yp = v0; *(f32x4*)(yp + 4) = v1; }
                ss += __shfl_xor(ss, 16); ss += __shfl_xor(ss, 32); if (fq == 0 && doss) atomicAdd(rss + 3 * T + row, ss); }
    }
};
__device__ __forceinline__ void transpose_item(const float* W, int K, int N, int k0, int n0, bf16_t* dst0, const float* gk, LAS float* scr, int lane) {
    const int kr = lane >> 3, c4 = (lane & 7) * 4;
    f32x4 v[8];
#pragma unroll
    for (int i = 0; i < 8; ++i) v[i] = __builtin_nontemporal_load((const f32x4*)(W + (size_t)(k0 + 8 * i + kr) * N + n0 + c4));
    if (gk) {
#pragma unroll
        for (int i = 0; i < 8; ++i) v[i] = v[i] * gk[k0 + 8 * i + kr]; }
#pragma unroll
    for (int i = 0; i < 8; ++i) { LAS float* sp = scr + (8 * i + kr) * 33 + c4; sp[0] = v[i][0]; sp[1] = v[i][1]; sp[2] = v[i][2]; sp[3] = v[i][3]; }
    asm volatile("s_waitcnt lgkmcnt(0)" ::: "memory");
    const int c = lane & 7;
#pragma unroll
    for (int j = 0; j < 4; ++j) { const int n = (lane >> 3) + 8 * j; const LAS float* s = scr + (8 * c) * 33 + n;
        u32x4 o; o.x = cvt_pk(s[0 * 33], s[1 * 33]); o.y = cvt_pk(s[2 * 33], s[3 * 33]); o.z = cvt_pk(s[4 * 33], s[5 * 33]); o.w = cvt_pk(s[6 * 33], s[7 * 33]);
        *(u32x4*)(dst0 + (size_t)n * K + k0 + 8 * c) = o; }
    asm volatile("s_waitcnt lgkmcnt(0)" ::: "memory");
}

__device__ __forceinline__ void phase_prologue(const Ctx& X, LAS unsigned char* lds) {
    const int tid = X.tid, lane = tid & 63, wave = tid >> 6;
    const int gw = X.c * 8 + wave, NGW = X.G * 8;
    LAS float* scr = (LAS float*)(lds + wave * 8704);
    constexpr int I_IN = 32 * 482, I_UQ = 8 * 48, I_UKV = 8 * 64, I_BR = 16 * 64, I_OUT = 32 * 64;
    constexpr int PER_L = I_IN + I_UQ + 2 * I_UKV + 3 * I_BR + I_OUT;
    for (int it = gw; it < NL * PER_L; it += NGW) {
        const int l = it / PER_L; int r = it % PER_L;
        if (r < I_IN) { const int kb = r / 482, nb = r % 482, n0 = nb * 32; const int d0 = n0 < 1024 ? n0 : (n0 < 1088 ? Z_KR + (n0 - 1024) : n0 - 64);
            transpose_item(X.in[11] + (size_t)l * 2048 * INC, 2048, INC, kb * 64, n0, WSP(bf16_t, O_WIN) + ((size_t)l * ZW + d0) * 2048, nullptr, scr, lane); continue; }
        r -= I_IN;
        if (r < I_UQ) { const int kb = r / 48, nb = r % 48;
            transpose_item(X.in[14] + (size_t)l * 512 * 1536, 512, 1536, kb * 64, nb * 32, WSP(bf16_t, O_WUQ) + ((size_t)l * 1536 + nb * 32) * 512, X.in[12] + l * 512, scr, lane); continue; }
        r -= I_UQ;
        if (r < 2 * I_UKV) { const int gfold = r >= I_UKV; if (gfold) r -= I_UKV; const int kb = r / 64, nb = r % 64, n0 = nb * 32, hd = n0 >> 8, d = n0 & 255;
            bf16_t* dst = (d < 128 ? WSP(bf16_t, gfold ? O_WKG : O_WKP) : WSP(bf16_t, gfold ? O_WVG : O_WVP)) + ((size_t)l * 1024 + hd * 128 + (d & 127)) * 512;
            transpose_item(X.in[15] + (size_t)l * 512 * 2048, 512, 2048, kb * 64, n0, dst, gfold ? X.in[13] + l * 512 : nullptr, scr, lane); continue; }
        r -= 2 * I_UKV;
        if (r < 3 * I_BR) { const int br = r / I_BR; r %= I_BR; const int kb = r / 64, nb = r % 64;
            transpose_item(X.in[21 + br] + (size_t)l * 1024 * 2048, 1024, 2048, kb * 64, nb * 32, WSP(bf16_t, O_WBR) + (((size_t)l * 3 + br) * 2048 + nb * 32) * 1024, nullptr, scr, lane); continue; }
        r -= 3 * I_BR;
        { const int kb = r / 64, nb = r % 64;
            transpose_item(X.in[24] + (size_t)l * 2048 * 2048, 2048, 2048, kb * 64, nb * 32, WSP(bf16_t, O_WOUT) + ((size_t)l * 2048 + nb * 32) * 2048, nullptr, scr, lane); }
    }
    const int gt = X.c * NTHREADS + tid, NGT = X.G * NTHREADS;
    for (int i = gt; i < NL * 512 * 512 / 4; i += NGT) { const int e = i * 4, l = e / (512 * 512), rr = (e / 512) % 512, cidx = e % 512, b = rr >> 8, t = rr & 255;
        const f32x4 v = *(const f32x4*)(X.in[2] + (((size_t)b * NL + l) * 256 + t) * 512 + cidx);
        u32x2 w; w.x = cvt_pk(v[0], v[1]); w.y = cvt_pk(v[2], v[3]); *(u32x2*)(WSP(bf16_t, O_CKVC) + e) = w; }
    for (int i = gt; i < NL * 512 * 64 / 4; i += NGT) { const int e = i * 4, l = e / (512 * 64), rr = (e / 64) % 512, cidx = e % 64, b = rr >> 8, t = rr & 255;
        const f32x4 v = *(const f32x4*)(X.in[3] + (((size_t)b * NL + l) * 256 + t) * 64 + cidx);
        u32x2 w; w.x = cvt_pk(v[0], v[1]); w.y = cvt_pk(v[2], v[3]); *(u32x2*)(WSP(bf16_t, O_KRC) + e) = w; }
    for (int i = gt; i < 64 * 16; i += NGT) { const int p = i >> 4, f = i & 15; const float inv = powf(10000.f, -(float)f / 16.f); const float ang = (float)p * inv;
        WSP(float, O_ROPE)[2 * i] = cosf(ang); WSP(float, O_ROPE)[2 * i + 1] = sinf(ang); }
    for (int i = gt; i < 4 * T; i += NGT) WSP(float, O_RSS)[i] = 0.f;
    LAS float* sl = (LAS float*)(lds + 69632);
    LAS float* red = (LAS float*)(lds + 69632 + 24576);
    __syncthreads();
    for (int i = tid; i < 3 * 2048; i += NTHREADS) { const int cidx = i >> 11, k = i & 2047; const float v = cidx == 0 ? X.in[6][k] : X.in[5][(cidx - 1) * 2048 + k]; sl[i] = silu_f(v); }
    __syncthreads();
    for (int un = X.c; un < NL * 192; un += X.G) {
        const int l = un / 192, col0 = (un % 192) * 32, kg = tid >> 3, c4 = tid & 7;
        const float* wp = X.in[7] + (size_t)l * 2048 * 6144 + col0 + 4 * c4;
        f32x4 a0 = {0.f, 0.f, 0.f, 0.f}, a1 = a0, a2 = a0;
#pragma unroll 1
        for (int kb = 0; kb < 32; kb += 8) {
            f32x4 w[8];
#pragma unroll
            for (int q = 0; q < 8; ++q) w[q] = __builtin_nontemporal_load((const f32x4*)(wp + (size_t)(kg + 64 * (kb + q)) * 6144));
            __builtin_amdgcn_sched_barrier(0);
#pragma unroll
            for (int q = 0; q < 8; ++q) { const int k = kg + 64 * (kb + q); a0 += w[q] * sl[k]; a1 += w[q] * sl[2048 + k]; a2 += w[q] * sl[4096 + k]; }
        }
        LAS float* rp = red + (kg * 8 + c4) * 12;
#pragma unroll
        for (int j = 0; j < 4; ++j) { rp[j] = a0[j]; rp[4 + j] = a1[j]; rp[8 + j] = a2[j]; }
        __syncthreads();
        if (tid < 96) { const int cc = tid / 12, jj = tid % 12; float s = 0.f; for (int g = 0; g < 64; ++g) s += red[(g * 8 + cc) * 12 + jj];
            const int cidx = jj >> 2, col = col0 + 4 * cc + (jj & 3); WSP(float, O_MOD)[((size_t)l * 3 + cidx) * 6144 + col] = s + X.in[8][l * 6144 + col]; }
        __syncthreads();
    }
}

__device__ __forceinline__ void phase_rows(const Ctx& X, int l, bool upd, int ln) {
    const int tid = X.tid, lane = tid & 63, wave = tid >> 6;
    const float* mod = WSP(float, O_MOD);
    for (int row0 = (X.c * 8 + wave) * 2; row0 < T; row0 += X.G * 16) {
        f32x4 v[2][8];
#pragma unroll
        for (int rr = 0; rr < 2; ++rr) { const int row = row0 + rr;
            const float* xsrc = (upd && l > 0) || (!upd && ln > 0) ? WSP(float, O_X) + (size_t)row * DM : (row < 4096 ? X.in[0] + (size_t)row * DM : X.in[1] + (size_t)(row - 4096) * DM);
#pragma unroll
            for (int j = 0; j < 8; ++j) v[rr][j] = *(const f32x4*)(xsrc + j * 256 + lane * 4); }
        const int cidx = row0 < 4096 ? 0 : 1 + ((row0 - 4096) >> 11);
        if (upd) {
            const float* gate = mod + ((size_t)l * 3 + cidx) * 6144 + 4096; const float* gp = X.in[10] + l * 2048;
            f32x4 gg[8], y[8];
#pragma unroll
            for (int j = 0; j < 8; ++j) { const int c = j * 256 + lane * 4; gg[j] = *(const f32x4*)(gate + c); y[j] = *(const f32x4*)(gp + c); }
            const float ri0 = rsqrtf(WSP(float, O_RSS)[3 * T + row0] * (1.f / 2048.f) + EPSN), ri1 = rsqrtf(WSP(float, O_RSS)[3 * T + row0 + 1] * (1.f / 2048.f) + EPSN);
            __builtin_amdgcn_sched_barrier(0);
#pragma unroll
            for (int j = 0; j < 8; ++j) gg[j] = gg[j] * y[j];
#pragma unroll
            for (int rr = 0; rr < 2; ++rr) { const int row = row0 + rr; const float ri = rr ? ri1 : ri0; const float* yp = WSP(float, O_Y) + (size_t)row * DM;
#pragma unroll
                for (int j = 0; j < 8; ++j) y[j] = *(const f32x4*)(yp + j * 256 + lane * 4);
                __builtin_amdgcn_sched_barrier(0);
                float* xdst = (l == NL - 1) ? X.out + (row < 4096 ? OUT_YP + (size_t)row * DM : OUT_YS + (size_t)(row - 4096) * DM) : WSP(float, O_X) + (size_t)row * DM;
#pragma unroll
                for (int j = 0; j < 8; ++j) { v[rr][j] += gg[j] * (y[j] * ri); *(f32x4*)(xdst + j * 256 + lane * 4) = v[rr][j]; }
                __builtin_amdgcn_sched_barrier(0); }
        }
        __builtin_amdgcn_sched_barrier(0);
        if (ln < NL) {
            const float* sh = mod + ((size_t)ln * 3 + cidx) * 6144; const float* sc = sh + 2048; const float* gp = X.in[9] + ln * 2048;
            f32x4 s[8], b[8], g[8];
#pragma unroll
            for (int j = 0; j < 8; ++j) { const int c = j * 256 + lane * 4; s[j] = *(const f32x4*)(sc + c); b[j] = *(const f32x4*)(sh + c); g[j] = *(const f32x4*)(gp + c); }
            float ss0 = 0.f, ss1 = 0.f;
#pragma unroll
            for (int j = 0; j < 8; ++j) { ss0 += v[0][j][0] * v[0][j][0] + v[0][j][1] * v[0][j][1] + v[0][j][2] * v[0][j][2] + v[0][j][3] * v[0][j][3];
                ss1 += v[1][j][0] * v[1][j][0] + v[1][j][1] * v[1][j][1] + v[1][j][2] * v[1][j][2] + v[1][j][3] * v[1][j][3]; }
            ss0 = wave_sum(ss0); ss1 = wave_sum(ss1); const float ri0 = rsqrtf(ss0 * (1.f / 2048.f) + EPSN), ri1 = rsqrtf(ss1 * (1.f / 2048.f) + EPSN);
            __builtin_amdgcn_sched_barrier(0);
            bf16_t* hp = WSP(bf16_t, O_H) + (size_t)row0 * DM;
#pragma unroll
            for (int j = 0; j < 8; ++j) { const int c = j * 256 + lane * 4;
                const f32x4 gs = g[j] * (s[j] + 1.f);
                const f32x4 h0 = v[0][j] * ri0 * gs + b[j], h1 = v[1][j] * ri1 * gs + b[j];
                u32x2 w; w.x = cvt_pk(h0[0], h0[1]); w.y = cvt_pk(h0[2], h0[3]); *(u32x2*)(hp + c) = w;
                w.x = cvt_pk(h1[0], h1[1]); w.y = cvt_pk(h1[2], h1[3]); *(u32x2*)(hp + DM + c) = w; }
        }
    }
}

__device__ __forceinline__ void phase_misc(const Ctx& X, int l) {
    const int tid = X.tid, lane = tid & 63, wave = tid >> 6;
    const bf16_t* z = WSP(bf16_t, O_Z);
    for (int row = X.c * 8 + wave; row < 4096; row += X.G * 8) {
        const bf16_t* zr = z + (size_t)row * ZW;
        const int b = row >> 8, t = row & 255;
        const float ri = rsqrtf(WSP(float, O_RSS)[T + row] * (1.f / 512.f) + EPSN);
        const u32x4 w = *(const u32x4*)(zr + Z_CKV + lane * 8); const float* g = X.in[13] + l * 512 + lane * 8;
        const f32x4 g0 = *(const f32x4*)g, g1 = *(const f32x4*)(g + 4);
        float* o = X.out + OUT_CKV + (((size_t)b * NL + l) * 256 + t) * 512 + lane * 8;
        f32x4 o0, o1; o0[0] = bflo(w.x) * ri * g0[0]; o0[1] = bfhi(w.x) * ri * g0[1]; o0[2] = bflo(w.y) * ri * g0[2]; o0[3] = bfhi(w.y) * ri * g0[3];
        o1[0] = bflo(w.z) * ri * g1[0]; o1[1] = bfhi(w.z) * ri * g1[1]; o1[2] = bflo(w.w) * ri * g1[2]; o1[3] = bfhi(w.w) * ri * g1[3];
        *(f32x4*)o = o0; *(f32x4*)(o + 4) = o1;
    }
}
__device__ __forceinline__ void phase_krope(const Ctx& X, int l) {
    const int tid = X.tid, lane = tid & 63, wave = tid >> 6;
    const bf16_t* z = WSP(bf16_t, O_Z); const float* rope = WSP(float, O_ROPE);
    for (int row = X.c * 8 + wave; row < T; row += X.G * 8) {
        float kr = bf2f(z[(size_t)row * ZW + Z_KR + lane]);
        if (row < 4096) { const int b = row >> 8, t = row & 255; X.out[OUT_KR + (((size_t)b * NL + l) * 256 + t) * 64 + lane] = kr; }
        else {
            const int t = (row - 4096) & 2047; const int p = lane < 32 ? (t >> 6) : (t & 63); const int f = lane & 15;
            const float cs = rope[(p * 16 + f) * 2], sn = rope[(p * 16 + f) * 2 + 1];
            const float pr = __shfl_xor(kr, 16);
            kr = (lane & 16) ? kr * cs + pr * sn : kr * cs - pr * sn;
        }
        const float nb = __shfl_down(kr, 1);
        if ((lane & 1) == 0) *(unsigned*)(WSP(bf16_t, O_KR) + (size_t)row * 64 + lane) = cvt_pk(kr, nb);
    }
}
constexpr int PB = 272;
constexpr int BUFB = 128 * PB;
constexpr int PO = 132;
__device__ __forceinline__ void mma128(const LAS unsigned char* As, const LAS unsigned char* Bs, f32x16 (&acc)[2], int wr, int wc, int lane) {
    const int r32 = lane & 31, hi = lane >> 5;
    const LAS unsigned char* ap = As + (32 * wr + r32) * PB + hi * 16;
    const LAS unsigned char* bp = Bs + (64 * wc + r32) * PB + hi * 16;
#pragma unroll 2
    for (int s = 0; s < 8; ++s) {
        const bf16x8 a = *(const LAS bf16x8*)(ap + s * 32);
        const bf16x8 b0 = *(const LAS bf16x8*)(bp + s * 32);
        const bf16x8 b1 = *(const LAS bf16x8*)(bp + 32 * PB + s * 32);
        acc[0] = __builtin_amdgcn_mfma_f32_32x32x16_bf16(a, b0, acc[0], 0, 0, 0);
        acc[1] = __builtin_amdgcn_mfma_f32_32x32x16_bf16(a, b1, acc[1], 0, 0, 0);
    }
}
__device__ __forceinline__ int crow(int r, int hi) { return (r & 3) + 8 * (r >> 2) + 4 * hi; }
__device__ __forceinline__ void stage_tile(LAS unsigned char* dst, const bf16_t* src, size_t ld, int tid) {
#pragma unroll
    for (int i = 0; i < 4; ++i) { const int c = tid + i * NTHREADS, r = c >> 4, ch = c & 15;
        *(LAS u32x4*)(dst + r * PB + ch * 16) = *(const u32x4*)(src + (size_t)r * ld + ch * 8); }
}
__device__ __forceinline__ float log_sigmoid_f(float x) { return -log1pf(expf(-x)); }

__device__ __forceinline__ void sgu_item(const Ctx& X, LAS unsigned char* lds, int l, int item) {
    int tid_ = X.tid; asm volatile("" : "+v"(tid_));
    const int tid = tid_, lane = tid & 63, wave = tid >> 6, wr = wave >> 1, wc = wave & 1;
    const int n = item >> 3, g = item & 7, tok0 = n * 128;
    LAS unsigned char* As = lds; LAS unsigned char* Bs = lds + BUFB; LAS float* Os = (LAS float*)(lds + 2 * BUFB);
    const float* ws = X.in[17] + ((size_t)l * 8 + g) * 16384; const float* rss = WSP(float, O_RSS) + 2 * T + tok0;
    { f32x4 w0[4], w1[4], s0[4], s1[4];
#pragma unroll
      for (int i = 0; i < 4; ++i) { const int c = tid + i * NTHREADS, r = c >> 4, ch = c & 15;
          w0[i] = *(const f32x4*)(ws + r * 128 + ch * 8); w1[i] = *(const f32x4*)(ws + r * 128 + ch * 8 + 4); s0[i] = *(const f32x4*)(rss + ch * 8); s1[i] = *(const f32x4*)(rss + ch * 8 + 4); }
      __builtin_amdgcn_sched_barrier(0);
#pragma unroll
      for (int i = 0; i < 4; ++i) { const int c = tid + i * NTHREADS, r = c >> 4, ch = c & 15;
          u32x4 o; o.x = cvt_pk(w0[i][0] * rsqrtf(s0[i][0] * (1.f / 1024.f) + EPSN), w0[i][1] * rsqrtf(s0[i][1] * (1.f / 1024.f) + EPSN));
          o.y = cvt_pk(w0[i][2] * rsqrtf(s0[i][2] * (1.f / 1024.f) + EPSN), w0[i][3] * rsqrtf(s0[i][3] * (1.f / 1024.f) + EPSN));
          o.z = cvt_pk(w1[i][0] * rsqrtf(s1[i][0] * (1.f / 1024.f) + EPSN), w1[i][1] * rsqrtf(s1[i][1] * (1.f / 1024.f) + EPSN));
          o.w = cvt_pk(w1[i][2] * rsqrtf(s1[i][2] * (1.f / 1024.f) + EPSN), w1[i][3] * rsqrtf(s1[i][3] * (1.f / 1024.f) + EPSN));
          *(LAS u32x4*)(As + r * PB + ch * 16) = o; } }
    stage_tile(Bs, WSP(bf16_t, O_VST) + (size_t)(g * 128) * T + tok0, T, tid);
    const int p = tid >> 2, cseg = (tid & 3) * 32; const bf16_t* zr = WSP(bf16_t, O_Z) + (size_t)(tok0 + p) * ZW;
    u32x4 uu4[4], gg4[4]; f32x4 gs4[8];
#pragma unroll
    for (int i = 0; i < 4; ++i) { uu4[i] = *(const u32x4*)(zr + Z_U + g * 128 + cseg + i * 8); gg4[i] = *(const u32x4*)(zr + Z_GPS + g * 128 + cseg + i * 8); }
#pragma unroll
    for (int i = 0; i < 8; ++i) gs4[i] = *(const f32x4*)(X.in[16] + l * 1024 + g * 128 + cseg + i * 4);
    const float bs = X.in[18][((size_t)l * 128 + p) * 8 + g];
    __syncthreads();
    f32x16 acc[2]; acc[0] = (f32x16)(0.f); acc[1] = (f32x16)(0.f);
    mma128(As, Bs, acc, wr, wc, lane);
    { const int hi = lane >> 5, cb = 64 * wc + (lane & 31);
#pragma unroll
      for (int t = 0; t < 2; ++t)
#pragma unroll
        for (int r = 0; r < 16; ++r) Os[(32 * wr + crow(r, hi)) * PO + cb + 32 * t] = acc[t][r]; }
    __syncthreads();
    {
      bf16_t* op = WSP(bf16_t, O_AS) + (size_t)(tok0 + p) * 1024 + g * 128 + cseg;
#pragma unroll
      for (int i = 0; i < 4; ++i) {
          const u32x4 uu = uu4[i], gg = gg4[i];
          const f32x4 s0 = *(const LAS f32x4*)(Os + p * PO + cseg + i * 8), s1 = *(const LAS f32x4*)(Os + p * PO + cseg + i * 8 + 4);
          const f32x4 g0 = gs4[2 * i], g1 = gs4[2 * i + 1];
          u32x4 o; o.x = cvt_pk((s0[0] * g0[0] + bs) * bflo(uu.x) * bflo(gg.x), (s0[1] * g0[1] + bs) * bfhi(uu.x) * bfhi(gg.x));
          o.y = cvt_pk((s0[2] * g0[2] + bs) * bflo(uu.y) * bflo(gg.y), (s0[3] * g0[3] + bs) * bfhi(uu.y) * bfhi(gg.y));
          o.z = cvt_pk((s1[0] * g1[0] + bs) * bflo(uu.z) * bflo(gg.z), (s1[1] * g1[1] + bs) * bfhi(uu.z) * bfhi(gg.z));
          o.w = cvt_pk((s1[2] * g1[2] + bs) * bflo(uu.w) * bflo(gg.w), (s1[3] * g1[3] + bs) * bfhi(uu.w) * bfhi(gg.w));
          *(u32x4*)(op + i * 8) = o; } }
    __syncthreads();
}

__device__ __forceinline__ void retstate_item(const Ctx& X, LAS unsigned char* lds, int l, int item) {
    int tid_ = X.tid; asm volatile("" : "+v"(tid_));
    const int tid = tid_, lane = tid & 63, wave = tid >> 6, wr = wave >> 1, wc = wave & 1;
    const int n = item >> 3, hd = item & 7, tok0 = n * 128;
    LAS unsigned char* As = lds; LAS unsigned char* Bf = lds + BUFB; LAS unsigned char* Bb = lds + 2 * BUFB;
    const float lgf = log_sigmoid_f(X.in[19][(l * 2 + 0) * 8 + hd]) * 1.4426950408889634f, lgb = log_sigmoid_f(X.in[19][(l * 2 + 1) * 8 + hd]) * 1.4426950408889634f;
    stage_tile(As, WSP(bf16_t, O_RVT) + (size_t)(hd * 128) * T + tok0, T, tid);
    { const bf16_t* kz = WSP(bf16_t, O_Z) + (size_t)tok0 * ZW + Z_RK + hd * 128;
      const int j0 = 2 * lane;
      const float wf0 = exp2f(lgf * (float)(127 - j0)), wf1 = exp2f(lgf * (float)(126 - j0)), wb0 = exp2f(lgb * (float)j0), wb1 = exp2f(lgb * (float)(j0 + 1));
      u32x4 wa[2], wb[2];
#pragma unroll
      for (int i = 0; i < 2; ++i) { const int d0 = (wave * 2 + i) * 8; wa[i] = *(const u32x4*)(kz + (size_t)j0 * ZW + d0); wb[i] = *(const u32x4*)(kz + (size_t)(j0 + 1) * ZW + d0); }
#pragma unroll
      for (int i = 0; i < 2; ++i) { const int d0 = (wave * 2 + i) * 8;
          const float ka[8] = {bflo(wa[i].x), bfhi(wa[i].x), bflo(wa[i].y), bfhi(wa[i].y), bflo(wa[i].z), bfhi(wa[i].z), bflo(wa[i].w), bfhi(wa[i].w)};
          const float kb[8] = {bflo(wb[i].x), bfhi(wb[i].x), bflo(wb[i].y), bfhi(wb[i].y), bflo(wb[i].z), bfhi(wb[i].z), bflo(wb[i].w), bfhi(wb[i].w)};
#pragma unroll
          for (int e = 0; e < 8; ++e) { *(LAS unsigned*)(Bf + (d0 + e) * PB + j0 * 2) = cvt_pk(ka[e] * wf0, kb[e] * wf1); *(LAS unsigned*)(Bb + (d0 + e) * PB + j0 * 2) = cvt_pk(ka[e] * wb0, kb[e] * wb1); } } }
    __syncthreads();
    f32x16 af[2], ab[2]; af[0] = (f32x16)(0.f); af[1] = (f32x16)(0.f); ab[0] = (f32x16)(0.f); ab[1] = (f32x16)(0.f);
    mma128(As, Bf, af, wr, wc, lane); mma128(As, Bb, ab, wr, wc, lane);
    float* st = WSP(float, O_ST) + ((size_t)(n * 8 + hd) * 2) * 16384;
    { const int hi = lane >> 5, cb = 64 * wc + (lane & 31);
#pragma unroll
      for (int t = 0; t < 2; ++t)
#pragma unroll
        for (int r = 0; r < 16; ++r) { const int e = 32 * wr + crow(r, hi); st[e * 128 + cb + 32 * t] = af[t][r]; st[16384 + e * 128 + cb + 32 * t] = ab[t][r]; } }
    __syncthreads();
}

__device__ __forceinline__ void retout_item(const Ctx& X, LAS unsigned char* lds, int l, int item) {
    int tid_ = X.tid; asm volatile("" : "+v"(tid_));
    const int tid = tid_, lane = tid & 63, wave = tid >> 6, wr = wave >> 1, wc = wave & 1;
    const int n = item >> 3, hd = item & 7, tok0 = n * 128;
    LAS unsigned char* B0 = lds; LAS unsigned char* B1 = lds + BUFB; LAS unsigned char* B2 = lds + 2 * BUFB; LAS unsigned char* B3 = lds + 3 * BUFB;
    LAS unsigned char* B4 = lds + 4 * BUFB;
    const float lgf = log_sigmoid_f(X.in[19][(l * 2 + 0) * 8 + hd]) * 1.4426950408889634f, lgb = log_sigmoid_f(X.in[19][(l * 2 + 1) * 8 + hd]) * 1.4426950408889634f;
    const bf16_t* z = WSP(bf16_t, O_Z); const bf16_t* pf = WSP(bf16_t, O_PF) + (size_t)(n * 8 + hd) * 2 * 16384;
    (void)B4;
    stage_tile(B0, z + (size_t)tok0 * ZW + Z_RQ + hd * 128, ZW, tid);
    stage_tile(B1, z + (size_t)tok0 * ZW + Z_RK + hd * 128, ZW, tid);
    stage_tile(B3, WSP(bf16_t, O_RVT) + (size_t)(hd * 128) * T + tok0, T, tid);
    u32x4 pfr[2][4];
#pragma unroll
    for (int d = 0; d < 2; ++d)
#pragma unroll
        for (int i = 0; i < 4; ++i) { const int c = tid + i * NTHREADS; pfr[d][i] = *(const u32x4*)(pf + d * 16384 + (size_t)(c >> 4) * 128 + (c & 15) * 8); }
    const int p_ = tid >> 2, cseg_ = (tid & 3) * 32;
    u32x4 gpr[4]; f32x4 grr[8];
#pragma unroll
    for (int q = 0; q < 4; ++q) gpr[q] = *(const u32x4*)(z + (size_t)(tok0 + p_) * ZW + Z_GPR + hd * 128 + cseg_ + q * 8);
#pragma unroll
    for (int q = 0; q < 8; ++q) grr[q] = *(const f32x4*)(X.in[20] + l * 1024 + hd * 128 + cseg_ + q * 4);
    __syncthreads();
    const int hi = lane >> 5, cb = 64 * wc + (lane & 31);
    { f32x16 aw[2]; aw[0] = (f32x16)(0.f); aw[1] = (f32x16)(0.f);
      mma128(B0, B1, aw, wr, wc, lane);
#pragma unroll
      for (int t = 0; t < 2; ++t)
#pragma unroll
        for (int r = 0; r < 16; ++r) { const int i = 32 * wr + crow(r, hi), j = cb + 32 * t; const float dd = (float)(i - j);
            const float dec = (i >= j) ? __builtin_amdgcn_exp2f(lgf * dd) : __builtin_amdgcn_exp2f(-lgb * dd);
            *(LAS bf16_t*)(B2 + i * PB + j * 2) = (bf16_t)(cvt_pk(aw[t][r] * dec, 0.f) & 0xffffu); } }
    __syncthreads();
#pragma unroll
    for (int i = 0; i < 4; ++i) { const int c = tid + i * NTHREADS; *(LAS u32x4*)(B1 + (c >> 4) * PB + (c & 15) * 16) = pfr[0][i]; }
    f32x16 ao[2]; ao[0] = (f32x16)(0.f); ao[1] = (f32x16)(0.f);
    mma128(B2, B3, ao, wr, wc, lane);
    __syncthreads();
#pragma unroll
    for (int i = 0; i < 4; ++i) { const int c = tid + i * NTHREADS; *(LAS u32x4*)(B3 + (c >> 4) * PB + (c & 15) * 16) = pfr[1][i]; }
    f32x16 ac[2]; ac[0] = (f32x16)(0.f); ac[1] = (f32x16)(0.f);
    mma128(B0, B1, ac, wr, wc, lane);
#pragma unroll
    for (int t = 0; t < 2; ++t)
#pragma unroll
        for (int r = 0; r < 16; ++r) { const int i = 32 * wr + crow(r, hi); ao[t][r] += ac[t][r] * __builtin_amdgcn_exp2f(lgf * (float)(i + 1)); }
    __syncthreads();
    ac[0] = (f32x16)(0.f); ac[1] = (f32x16)(0.f);
    mma128(B0, B3, ac, wr, wc, lane);
    LAS float* Os = (LAS float*)(lds + BUFB);
#pragma unroll
    for (int t = 0; t < 2; ++t)
#pragma unroll
        for (int r = 0; r < 16; ++r) { const int i = 32 * wr + crow(r, hi); Os[i * PO + cb + 32 * t] = ao[t][r] + ac[t][r] * __builtin_amdgcn_exp2f(lgb * (float)(128 - i)); }
    __syncthreads();
    { const int p = tid >> 2, cseg = (tid & 3) * 32; f32x4 v[8]; float s = 0.f;
#pragma unroll
      for (int q = 0; q < 8; ++q) { v[q] = *(const LAS f32x4*)(Os + p * PO + cseg + q * 4); s += v[q][0] + v[q][1] + v[q][2] + v[q][3]; }
      s += __shfl_xor(s, 1); s += __shfl_xor(s, 2); const float mu = s * (1.f / 128.f); float s2 = 0.f;
#pragma unroll
      for (int q = 0; q < 8; ++q) { v[q] = v[q] - mu; s2 += v[q][0] * v[q][0] + v[q][1] * v[q][1] + v[q][2] * v[q][2] + v[q][3] * v[q][3]; }
      s2 += __shfl_xor(s2, 1); s2 += __shfl_xor(s2, 2); const float rs = rsqrtf(s2 * (1.f / 128.f) + EPSN);

      bf16_t* op = WSP(bf16_t, O_AR) + (size_t)(tok0 + p) * 1024 + hd * 128 + cseg;
#pragma unroll
      for (int q = 0; q < 4; ++q) { const u32x4 gg = gpr[q]; const f32x4 g0 = grr[2 * q], g1 = grr[2 * q + 1]; const f32x4 a = v[2 * q] * rs * g0, b = v[2 * q + 1] * rs * g1;
          u32x4 o; o.x = cvt_pk(a[0] * bflo(gg.x), a[1] * bfhi(gg.x)); o.y = cvt_pk(a[2] * bflo(gg.y), a[3] * bfhi(gg.y)); o.z = cvt_pk(b[0] * bflo(gg.z), b[1] * bfhi(gg.z)); o.w = cvt_pk(b[2] * bflo(gg.w), b[3] * bfhi(gg.w));
          *(u32x4*)(op + q * 8) = o; } }
    __syncthreads();
}

__device__ __forceinline__ void phase_prefix(const Ctx& X, int l) {
    const int tid = X.tid;
    const float* stb = WSP(float, O_ST); bf16_t* pf = WSP(bf16_t, O_PF);
    for (int it = X.c; it < 256; it += X.G) {
        const int chain = it >> 3, sl = it & 7, b = chain >> 4, hd = (chain >> 1) & 7, dir = chain & 1;
        const int e = sl * 16 + (tid >> 5), d4 = (tid & 31) * 4, n0 = 32 + b * 16;
        const float gc = exp2f(128.f * 1.4426950408889634f * log_sigmoid_f(X.in[19][(l * 2 + dir) * 8 + hd]));
        f32x4 S[16];
#pragma unroll
        for (int j = 0; j < 16; ++j) S[j] = *(const f32x4*)(stb + ((size_t)((n0 + j) * 8 + hd) * 2 + dir) * 16384 + e * 128 + d4);
        const float* s0 = X.in[4] + ((((size_t)b * NL + l) * 2 + dir) * 8 + hd) * 16384;
        f32x4 R; R[0] = s0[(size_t)(d4 + 0) * 128 + e]; R[1] = s0[(size_t)(d4 + 1) * 128 + e]; R[2] = s0[(size_t)(d4 + 2) * 128 + e]; R[3] = s0[(size_t)(d4 + 3) * 128 + e];
#pragma unroll
        for (int jj = 0; jj < 16; ++jj) { const int j = dir ? 15 - jj : jj;
            u32x2 o; o.x = cvt_pk(R[0], R[1]); o.y = cvt_pk(R[2], R[3]);
            *(u32x2*)(pf + ((size_t)((n0 + j) * 8 + hd) * 2 + dir) * 16384 + e * 128 + d4) = o;
            R = R * gc + S[j]; }
    }
    for (int it = X.c; it < 256; it += X.G) {
        const int s = it >> 4, hd = (it >> 1) & 7, dir = it & 1, n0 = s * 2;
        const float gc = exp2f(128.f * 1.4426950408889634f * log_sigmoid_f(X.in[19][(l * 2 + dir) * 8 + hd]));
        float* o = X.out + OUT_RET + ((((size_t)s * NL + l) * 2 + dir) * 8 + hd) * 16384;
        const int nfirst = dir ? n0 + 1 : n0, nsecond = dir ? n0 : n0 + 1;
#pragma unroll
        for (int k = 0; k < 8; ++k) { const int idx = (k * NTHREADS + tid) * 4, e = idx >> 7, d4 = idx & 127;
            const f32x4 Sa = *(const f32x4*)(stb + ((size_t)(nfirst * 8 + hd) * 2 + dir) * 16384 + idx), Sb = *(const f32x4*)(stb + ((size_t)(nsecond * 8 + hd) * 2 + dir) * 16384 + idx);
            u32x2 z0; z0.x = 0u; z0.y = 0u; u32x2 w; w.x = cvt_pk(Sa[0], Sa[1]); w.y = cvt_pk(Sa[2], Sa[3]);
            *(u32x2*)(pf + ((size_t)(nfirst * 8 + hd) * 2 + dir) * 16384 + idx) = z0;
            *(u32x2*)(pf + ((size_t)(nsecond * 8 + hd) * 2 + dir) * 16384 + idx) = w;
            const f32x4 f = Sa * gc + Sb;
            o[(size_t)(d4 + 0) * 128 + e] = f[0]; o[(size_t)(d4 + 1) * 128 + e] = f[1]; o[(size_t)(d4 + 2) * 128 + e] = f[2]; o[(size_t)(d4 + 3) * 128 + e] = f[3]; }
    }
}
constexpr int KPB = 400;
constexpr int VPB = 272;
constexpr int ATT_KB = 128 * KPB;
__device__ __forceinline__ float xmax16(float x) { const unsigned u = __float_as_uint(x); auto r = __builtin_amdgcn_permlane16_swap(u, u, false, false); return fmaxf(__uint_as_float(r[0]), __uint_as_float(r[1])); }
__device__ __forceinline__ float xmax32(float x) { const unsigned u = __float_as_uint(x); auto r = __builtin_amdgcn_permlane32_swap(u, u, false, false); return fmaxf(__uint_as_float(r[0]), __uint_as_float(r[1])); }
__device__ __forceinline__ float xsum16(float x) { const unsigned u = __float_as_uint(x); auto r = __builtin_amdgcn_permlane16_swap(u, u, false, false); return __uint_as_float(r[0]) + __uint_as_float(r[1]); }
__device__ __forceinline__ float xsum32(float x) { const unsigned u = __float_as_uint(x); auto r = __builtin_amdgcn_permlane32_swap(u, u, false, false); return __uint_as_float(r[0]) + __uint_as_float(r[1]); }
__device__ __forceinline__ void attn_unit(const Ctx& X, LAS unsigned char* lds, int l, int unit) {
    int tid_ = X.tid; asm volatile("" : "+v"(tid_));
    const int tid = tid_, lane = tid & 63, wave = tid >> 6, qi = lane & 15, g = lane >> 4;
    const int rbw = wave & 3, kh = wave >> 2;
    int tokb, ncache, nnew, hd, qb, bc = 0;
    if (unit < 256) { bc = unit >> 7; hd = (unit >> 4) & 7; qb = unit & 15; tokb = 4096 + bc * 2048; ncache = 256; nnew = 2048; }
    else { const int r = unit - 256; const int s = r >> 4; hd = (r >> 1) & 7; qb = r & 1; tokb = s * 256; ncache = 0; nnew = 256; }
    const int nct = ncache >> 7, ntile = (ncache + nnew) >> 7;
    const bf16_t* KN = WSP(bf16_t, O_KN); const bf16_t* KR = WSP(bf16_t, O_KR); const bf16_t* VT = WSP(bf16_t, O_VT);
    const bf16_t* KC = WSP(bf16_t, O_KC) + (size_t)l * 512 * 1024; const bf16_t* KRC = WSP(bf16_t, O_KRC) + (size_t)l * 512 * 64; const bf16_t* VTC = WSP(bf16_t, O_VTC) + (size_t)l * 1024 * 512;
    const int tokq = tokb + qb * 128 + rbw * 32 + qi;
    LAS unsigned char* qb_l = lds + ATT_KB + 128 * VPB;
    const LAS unsigned char* qbase = qb_l + (32 * rbw + qi) * KPB + 16 * g;
    LAS unsigned char* kb = lds; LAS unsigned char* vb = lds + ATT_KB;
    u32x4 sk[4], sr[2], sv[4];
#define ATT_LOAD(j) do { const int _j = (j); const bf16_t *kn_, *kr_, *vt_; size_t ldv_; \
        if (_j < nct) { const int r0 = bc * 256 + _j * 128; kn_ = KC + (size_t)r0 * 1024 + hd * 128; kr_ = KRC + (size_t)r0 * 64; vt_ = VTC + (size_t)(hd * 128) * 512 + r0; ldv_ = 512; } \
        else { const int r0 = tokb + (_j - nct) * 128; kn_ = KN + (size_t)r0 * 1024 + hd * 128; kr_ = KR + (size_t)r0 * 64; vt_ = VT + (size_t)(hd * 128) * T + r0; ldv_ = T; } \
        _Pragma("unroll") for (int i = 0; i < 4; ++i) { const int c = tid + i * NTHREADS; sk[i] = *(const u32x4*)(kn_ + (size_t)(c >> 4) * 1024 + (c & 15) * 8); sv[i] = *(const u32x4*)(vt_ + (size_t)(c >> 4) * ldv_ + (c & 15) * 8); } \
        _Pragma("unroll") for (int i = 0; i < 2; ++i) { const int c = tid + i * NTHREADS; sr[i] = *(const u32x4*)(kr_ + (size_t)(c >> 3) * 64 + (c & 7) * 8); } } while (0)
#define ATT_STORE() do { \
        _Pragma("unroll") for (int i = 0; i < 4; ++i) { const int c = tid + i * NTHREADS; *(LAS u32x4*)(kb + (c >> 4) * KPB + (c & 15) * 16) = sk[i]; *(LAS u32x4*)(vb + (c >> 4) * VPB + (c & 15) * 16) = sv[i]; } \
        _Pragma("unroll") for (int i = 0; i < 2; ++i) { const int c = tid + i * NTHREADS; *(LAS u32x4*)(kb + (c >> 3) * KPB + 256 + (c & 7) * 16) = sr[i]; } } while (0)
    f32x4 O[2][8];
#pragma unroll
    for (int rb = 0; rb < 2; ++rb)
#pragma unroll
        for (int u = 0; u < 8; ++u) O[rb][u] = (f32x4){0.f, 0.f, 0.f, 0.f};
    float mrun[2] = {-INFINITY, -INFINITY}, lrun[2] = {0.f, 0.f};
    const LAS unsigned char* kbase = kb + (64 * kh + qi) * KPB + 16 * g;
    const LAS unsigned char* vbase = vb + qi * VPB + (64 * kh + 4 * g) * 2;
    ATT_LOAD(0);
    u32x4 qst[6];
    { const bf16_t* qp = WSP(bf16_t, O_Q) + (size_t)(tokb + qb * 128) * 1536 + hd * 192;
#pragma unroll
      for (int i = 0; i < 6; ++i) { const int c = tid + i * NTHREADS, r = c / 24, ch = c % 24; qst[i] = *(const u32x4*)(qp + (size_t)r * 1536 + ch * 8); } }
#pragma unroll
    for (int i = 0; i < 6; ++i) { const int c = tid + i * NTHREADS, r = c / 24, ch = c % 24; *(LAS u32x4*)(qb_l + r * KPB + ch * 16) = qst[i]; }
    ATT_STORE();
    __syncthreads();
    for (int j = 0; j < ntile; ++j) {
        if (j + 1 < ntile) ATT_LOAD(j + 1);
        f32x4 S[2][4];
#pragma unroll
        for (int t = 0; t < 4; ++t) { S[0][t] = (f32x4){0.f, 0.f, 0.f, 0.f}; S[1][t] = (f32x4){0.f, 0.f, 0.f, 0.f}; }
#pragma unroll
        for (int s = 0; s < 6; ++s) { const bf16x8 q0 = *(const LAS bf16x8*)(qbase + 64 * s), q1 = *(const LAS bf16x8*)(qbase + 16 * KPB + 64 * s);
#pragma unroll
            for (int t = 0; t < 4; ++t) { const bf16x8 a = *(const LAS bf16x8*)(kbase + 16 * t * KPB + 64 * s);
                S[0][t] = __builtin_amdgcn_mfma_f32_16x16x32_bf16(a, q0, S[0][t], 0, 0, 0);
                S[1][t] = __builtin_amdgcn_mfma_f32_16x16x32_bf16(a, q1, S[1][t], 0, 0, 0); } }
        __builtin_amdgcn_s_setprio(1);
        bf16x8 pb[2][2];
#pragma unroll
        for (int rb = 0; rb < 2; ++rb) {
            float mx = S[rb][0][0];
#pragma unroll
            for (int t = 0; t < 4; ++t)
#pragma unroll
                for (int i = 0; i < 4; ++i) mx = fmaxf(mx, S[rb][t][i]);
            if (!__all(mx - mrun[rb] <= 11.f)) { mx = xmax32(xmax16(mx)); const float mnew_ = fmaxf(mrun[rb], mx), alpha = __builtin_amdgcn_exp2f(mrun[rb] - mnew_); mrun[rb] = mnew_; lrun[rb] *= alpha;
#pragma unroll
                for (int u = 0; u < 8; ++u) O[rb][u] = O[rb][u] * alpha; }
            const float mnew = mrun[rb];
            float ps = 0.f;
#pragma unroll
            for (int t = 0; t < 4; ++t)
#pragma unroll
                for (int i = 0; i < 4; ++i) { S[rb][t][i] = __builtin_amdgcn_exp2f(S[rb][t][i] - mnew); ps += S[rb][t][i]; }
            lrun[rb] += ps;
#pragma unroll
            for (int c = 0; c < 2; ++c) { u32x4 pw; pw.x = cvt_pk(S[rb][2 * c][0], S[rb][2 * c][1]); pw.y = cvt_pk(S[rb][2 * c][2], S[rb][2 * c][3]); pw.z = cvt_pk(S[rb][2 * c + 1][0], S[rb][2 * c + 1][1]); pw.w = cvt_pk(S[rb][2 * c + 1][2], S[rb][2 * c + 1][3]);
                pb[rb][c] = __builtin_bit_cast(bf16x8, pw); }
        }
        __builtin_amdgcn_s_setprio(0);
#pragma unroll
        for (int c = 0; c < 2; ++c)
#pragma unroll
            for (int u = 0; u < 8; ++u) { const LAS unsigned char* vp = vbase + 16 * u * VPB + 64 * c;
                const u32x2 lo = *(const LAS u32x2*)vp, hi2 = *(const LAS u32x2*)(vp + 32);
                u32x4 aw; aw.x = lo.x; aw.y = lo.y; aw.z = hi2.x; aw.w = hi2.y; const bf16x8 av = __builtin_bit_cast(bf16x8, aw);
                O[0][u] = __builtin_amdgcn_mfma_f32_16x16x32_bf16(av, pb[0][c], O[0][u], 0, 0, 0);
                O[1][u] = __builtin_amdgcn_mfma_f32_16x16x32_bf16(av, pb[1][c], O[1][u], 0, 0, 0); }
        __syncthreads();
        if (j + 1 < ntile) { ATT_STORE(); __syncthreads(); }
    }
    lrun[0] = xsum32(xsum16(lrun[0])); lrun[1] = xsum32(xsum16(lrun[1]));
    LAS float* xch = (LAS float*)lds + (size_t)rbw * 68 * 64 + lane;
    if (kh == 1) {
#pragma unroll
        for (int rb = 0; rb < 2; ++rb) {
#pragma unroll
            for (int u = 0; u < 8; ++u)
#pragma unroll
                for (int i = 0; i < 4; ++i) xch[(rb * 34 + u * 4 + i) * 64] = O[rb][u][i];
            xch[(rb * 34 + 32) * 64] = mrun[rb]; xch[(rb * 34 + 33) * 64] = lrun[rb]; }
    }
    __syncthreads();
    if (kh == 0) {
#pragma unroll
        for (int rb = 0; rb < 2; ++rb) {
            const float m1 = xch[(rb * 34 + 32) * 64], l1 = xch[(rb * 34 + 33) * 64];
            const float m = fmaxf(mrun[rb], m1), a0 = __builtin_amdgcn_exp2f(mrun[rb] - m), a1 = __builtin_amdgcn_exp2f(m1 - m);
            const float il = 1.f / (lrun[rb] * a0 + l1 * a1);
            const int tq = tokq + 16 * rb;
            const bf16_t* gp = WSP(bf16_t, O_Z) + (size_t)tq * ZW + Z_GPM + hd * 128 + 4 * g; bf16_t* op = WSP(bf16_t, O_AM) + (size_t)tq * 1024 + hd * 128 + 4 * g;
#pragma unroll
            for (int u = 0; u < 8; ++u) { const u32x2 gg = *(const u32x2*)(gp + 16 * u); f32x4 o;
#pragma unroll
                for (int i = 0; i < 4; ++i) o[i] = (O[rb][u][i] * a0 + xch[(rb * 34 + u * 4 + i) * 64] * a1) * il;
                u32x2 w; w.x = cvt_pk(o[0] * bflo(gg.x), o[1] * bfhi(gg.x)); w.y = cvt_pk(o[2] * bflo(gg.y), o[3] * bfhi(gg.y));
                *(u32x2*)(op + 16 * u) = w; } }
    }
    __syncthreads();
#undef ATT_LOAD
#undef ATT_STORE
}
constexpr int NPHASE = 2 + 7 * NL;
#define REOPAQUE(X) do { unsigned long long w_ = (unsigned long long)args.ws, o_ = (unsigned long long)args.out, i_ = (unsigned long long)__builtin_amdgcn_kernarg_segment_ptr(); int t_ = threadIdx.x, c_ = blockIdx.x, g_ = gridDim.x; \
    asm volatile("" : "+s"(w_), "+s"(o_), "+s"(i_), "+v"(t_), "+s"(c_), "+s"(g_)); X.ws = (unsigned char*)(GAS unsigned char*)w_; X.out = (float*)(GAS float*)o_; X.in.p = (CPtr64)i_; X.tid = t_; X.c = c_; X.G = g_; } while (0)
#ifndef PROBE_SP
#define PROBE_SP -1
#endif
#ifndef RPTM
#define RPTM 0
#endif
#define NREP(k) ((((RPTM) >> (k)) & 1) + 1)
#ifndef PHM
#define PHM 0xffff
#endif
__global__ void __launch_bounds__(NTHREADS, 2) mk_fwd(Args args) {
    extern __shared__ __attribute__((aligned(16))) unsigned char lds_raw[];
    LAS unsigned char* lds = (LAS unsigned char*)lds_raw;
    cg::grid_group grid = cg::this_grid();
    volatile LAS unsigned* bst = (volatile LAS unsigned*)(lds + LDS_BYTES - 64);
    if (threadIdx.x < 16) bst[threadIdx.x] = 0u;
    __syncthreads();
    XcdBarrier xbar = xcd_barrier_post((unsigned*)(args.ws + O_BAR), bst);
#if PROBE_SP >= 0
    unsigned long long pacc = 0ull;
#endif
    for (int ph = args.ph_lo; ph < args.ph_hi; ++ph) {
#if PROBE_SP >= 0
        const unsigned long long pt0 = __builtin_amdgcn_s_memrealtime();
#endif
        Ctx X; REOPAQUE(X);
        const int tid = X.tid;
        const char* ws = (const char*)X.ws;
        if (ph == 0) { for (int rep = 0; rep < NREP(0); ++rep) if (PHM & 1) phase_prologue(X, lds); }
        else if (ph == 1) { for (int rep = 0; rep < NREP(1); ++rep) {
            if (PHM & 4) phase_rows(X, 0, false, 0); }
        } else {
            const int l = (ph - 2) / 7, sp7 = (ph - 2) % 7, sp = sp7 < 2 ? sp7 : sp7 - 1;
            if (sp7 == 2) { phase_prefix(X, l); REOPAQUE(X); phase_krope(X, l); }
            else if (sp == 0) {
                SchedZ S{ws + O_H, ws + O_WIN + (size_t)l * ZW * 2048 * 2, X.G, X.c, 0}; EpiZ E{WSP(bf16_t, O_Z), WSP(bf16_t, O_VST), WSP(bf16_t, O_RVT), WSP(float, O_RSS), true};
                if (PHM & 8) pg8::gemm_phase(lds, tid, 2048, 2048, 2048, S, E);
            } else if (sp == 1) {
                for (int i = tid; i < 2048; i += NTHREADS) ((LAS float*)(lds + 131072))[i] = WSP(float, O_ROPE)[i];
                __syncthreads();
                { SchedZ S{ws + O_H, ws + O_WIN + (size_t)l * ZW * 2048 * 2, X.G, X.c, 1}; EpiZ E{WSP(bf16_t, O_Z), WSP(bf16_t, O_VST), WSP(bf16_t, O_RVT), WSP(float, O_RSS), true};
                  if (PHM & 8) pg8::gemm_phase(lds, tid, 2048, 2048, 2048, S, E); }
                REOPAQUE(X);
                { const char* ws2 = (const char*)X.ws;
                  SchedQK S{ws2 + O_Z, ws2 + O_WUQ + (size_t)l * 1536 * 512 * 2, ws2 + O_WKG + (size_t)l * 1024 * 512 * 2, X.G, X.c}; EpiQK E{WSP(bf16_t, O_Q), WSP(bf16_t, O_KN), WSP(float, O_RSS), (const LAS float*)(lds + 131072)};
                  if (PHM & 16) pg8::gemm_phase(lds, X.tid, 512, ZW, 512, S, E); }
                { const char* ws2 = (const char*)X.ws;
                  SchedVT S{ws2 + O_Z, ws2 + O_WVG + (size_t)l * 1024 * 512 * 2, X.G, X.c}; EpiVT E{WSP(bf16_t, O_VT), WSP(float, O_RSS)};
                  if (PHM & 32) pg8::gemm_phase(lds, X.tid, 512, 512, ZW, S, E); }
                REOPAQUE(X);
                { const char* ws2 = (const char*)X.ws;
                  SchedC S2{ws2 + O_CKVC, ws2 + O_WKP, ws2 + O_WVP, X.G, X.c, l}; EpiC E2{WSP(bf16_t, O_KC), WSP(bf16_t, O_VTC)};
                  if (PHM & 2) pg8::gemm_phase(lds, X.tid, 512, 512, 512, S2, E2); }
                REOPAQUE(X); if (PHM & 64) phase_misc(X, l);
                REOPAQUE(X);
                { int i0, i1;
                  if (X.G == 256) { const int c = X.c; if (c < 16) { i0 = 2 * c; i1 = i0 + 2; } else if (c < 96) { i0 = 32 + 4 * (c - 16); i1 = i0 + 4; } else if (c < 160) { i0 = 352 + 3 * (c - 96); i1 = i0 + 3; } else { i0 = 544 + 5 * (c - 160); i1 = i0 + 5; } }
                  else { const int per = (1024 + X.G - 1) / X.G; i0 = X.c * per; i1 = i0 + per < 1024 ? i0 + per : 1024; }
                  for (int it = i0; it < i1; ++it) { if (it < 512) { if (PHM & 128) sgu_item(X, lds, l, it); } else { if (PHM & 256) retstate_item(X, lds, l, it - 512); } } }
            } else if (sp == 2) { for (int rep = 0; rep < NREP(4); ++rep) {
                for (int i = X.c * NTHREADS + tid; i < T; i += X.G * NTHREADS) WSP(float, O_RSS)[3 * T + i] = 0.f;
#if PROBE_SP == 200 || PROBE_SP == 201
                const unsigned long long pa0 = __builtin_amdgcn_s_memrealtime();
#endif
                for (int r2 = 0; r2 < NREP(7); ++r2)
                for (int it = X.c; it < 512; it += X.G) if (PHM & 512) {
                    const int x = it & 7, slot = (it & 255) >> 3;
                    const int un = it < 256 ? (((x * 2 + (slot >> 4)) << 4) | (slot & 15)) : 256 + (((x * 16 + (slot >> 1)) << 1) | (slot & 1));
                    attn_unit(X, lds, l, un); }
#if PROBE_SP == 200
                pacc += __builtin_amdgcn_s_memrealtime() - pa0;
#endif
                REOPAQUE(X);
#if PROBE_SP == 201
                const unsigned long long pa1 = __builtin_amdgcn_s_memrealtime();
#endif
                for (int r2 = 0; r2 < NREP(8); ++r2)
                for (int it = X.c; it < 512; it += X.G) if (PHM & 1024) retout_item(X, lds, l, (it < 256) ? 256 + it : it - 256); }
#if PROBE_SP == 201
                pacc += __builtin_amdgcn_s_memrealtime() - pa1;
#endif
            } else if (sp == 3) { for (int rep = 0; rep < NREP(5); ++rep) {
                SchedBr S{ws + O_AM, ws + O_AS, ws + O_AR, ws + O_WBR + (size_t)l * 3 * 2048 * 1024 * 2, X.G, X.c}; EpiBr E{WSP(bf16_t, O_Z), WSP(bf16_t, O_YMB)};
                if (PHM & 2048) pg8::gemm_phase(lds, tid, 1024, 1024, 1024, S, E); }
            } else if (sp == 4) { for (int rep = 0; rep < NREP(6); ++rep) {
                for (int i = X.c * NTHREADS + tid; i < 3 * T; i += X.G * NTHREADS) WSP(float, O_RSS)[i] = 0.f;
                SchedOut S{ws + O_YMB, ws + O_WOUT + (size_t)l * 2048 * 2048 * 2, X.G, X.c}; EpiOut E{WSP(float, O_Y), WSP(float, O_RSS), rep == 0};
                if (PHM & 4096) pg8::gemm_phase(lds, tid, 2048, 2048, 2048, S, E); }
            } else {
                if (PHM & 8192) phase_rows(X, l, true, l + 1);
            }
        }
        if (ph + 1 < args.ph_hi) { if (ph == 0) { __syncthreads(); grid.sync(); } else { REOPAQUE(X); xbar.bar = (unsigned*)(X.ws + O_BAR); xcd_barrier(xbar); } }
#if PROBE_SP >= 0
        if (PROBE_SP < 200) { const bool hit = (PROBE_SP >= 100) ? (ph == PROBE_SP - 100) : (ph >= 2 && (ph - 2) % 7 == PROBE_SP); if (hit) pacc += __builtin_amdgcn_s_memrealtime() - pt0; }
#endif
    }
#if PROBE_SP == 300
    for (int k = 0; k < 20; ++k) xcd_barrier(xbar);
#endif
#if PROBE_SP >= 0
    if (blockIdx.x == 0 && threadIdx.x == 0) { const unsigned long long t1 = __builtin_amdgcn_s_memrealtime(); while (__builtin_amdgcn_s_memrealtime() - t1 < pacc) __builtin_amdgcn_s_sleep(8); }
#endif
}

extern "C" void kernel_launch(void* const* d_in, const int* in_sizes, int n_in, void* d_out, int out_size, void* d_ws, size_t ws_size, hipStream_t stream) {
    static int grid = 0;
    if (grid == 0) {
        if (n_in != 25 || ws_size < WS_END) { fprintf(stderr, "kernel_launch: unexpected n_in %d / ws %zu (need %zu)\n", n_in, ws_size, (size_t)WS_END); grid = -1; return; }
        int dev = 0, cus = 0, per_cu = 0;
        (void)hipGetDevice(&dev); (void)hipDeviceGetAttribute(&cus, hipDeviceAttributeMultiprocessorCount, dev);
        (void)hipFuncSetAttribute((const void*)mk_fwd, hipFuncAttributeMaxDynamicSharedMemorySize, LDS_BYTES);
        (void)hipOccupancyMaxActiveBlocksPerMultiprocessor(&per_cu, (const void*)mk_fwd, NTHREADS, LDS_BYTES);
        if (per_cu < 1) { fprintf(stderr, "kernel_launch: occupancy query says %d blocks per CU\n", per_cu); per_cu = 1; }
        grid = cus * per_cu;
    }
    if (grid < 0) return;
    Args a{};
    for (int i = 0; i < 25; ++i) a.in[i] = (const float*)d_in[i];
    a.out = (float*)d_out; a.ws = (unsigned char*)d_ws;
#if MK_MULTI
    for (int ph = 0; ph < NPHASE; ++ph) { a.ph_lo = ph; a.ph_hi = ph + 1; hipLaunchKernelGGL(mk_fwd, dim3(grid), dim3(NTHREADS), LDS_BYTES, stream, a); }
#else
    a.ph_lo = 0; a.ph_hi = NPHASE;
    (void)hipMemsetAsync((unsigned char*)d_ws + O_BAR, 0, 16384, stream);
    void* kargs[] = {&a};
    hipError_t e = hipLaunchCooperativeKernel((const void*)mk_fwd, dim3(grid), dim3(NTHREADS), kargs, LDS_BYTES, stream);
    if (e != hipSuccess) fprintf(stderr, "cooperative launch failed: %s (grid %d)\n", hipGetErrorString(e), grid);
#endif
}
```

```cpp
#define MK_MULTI 0
#define RPTM 0
#define PROBE_SP -1
#include <hip/hip_runtime.h>
#include <hip/hip_cooperative_groups.h>
#include <cstdio>
namespace cg = cooperative_groups;

#define LAS __attribute__((address_space(3)))
#define GAS __attribute__((address_space(1)))
typedef unsigned short bf16_t;
typedef short bf16x8 __attribute__((ext_vector_type(8)));
typedef float f32x4 __attribute__((ext_vector_type(4)));
typedef float f32x16 __attribute__((ext_vector_type(16)));
typedef unsigned u32x4 __attribute__((ext_vector_type(4)));
typedef unsigned u32x2 __attribute__((ext_vector_type(2)));

constexpr int NTHREADS = 512;
constexpr int LDS_BYTES = 147456;
constexpr int T = 8192, DM = 2048, ZW = 15616, NL = 4, INC = 15424;
constexpr float EPSN = 1e-6f;
constexpr int Z_CQ = 0, Z_CKV = 512, Z_GPM = 1024, Z_U = 2048, Z_VS = 3072, Z_GPS = 4096, Z_RQ = 5120, Z_RK = 6144, Z_RV = 7168, Z_GPR = 8192, Z_MRG = 9216, Z_KR = 15360;
constexpr size_t OUT_YP = 0, OUT_YS = 8388608, OUT_CKV = 16777216, OUT_KR = 25165824, OUT_RET = 26214400;

constexpr size_t O_WIN = 0,                         S_WIN = (size_t)NL * ZW * 2048 * 2;
constexpr size_t O_WUQ = O_WIN + S_WIN,             S_WUQ = (size_t)NL * 1536 * 512 * 2;
constexpr size_t O_WKG = O_WUQ + S_WUQ,             S_WK = (size_t)NL * 1024 * 512 * 2;
constexpr size_t O_WVG = O_WKG + S_WK;
constexpr size_t O_WKP = O_WVG + S_WK;
constexpr size_t O_WVP = O_WKP + S_WK;
constexpr size_t O_WBR = O_WVP + S_WK,              S_WBR = (size_t)NL * 3 * 2048 * 1024 * 2;
constexpr size_t O_WOUT = O_WBR + S_WBR,            S_WOUT = (size_t)NL * 2048 * 2048 * 2;
constexpr size_t O_CKVC = O_WOUT + S_WOUT,          S_CKVC = (size_t)NL * 512 * 512 * 2;
constexpr size_t O_KRC = O_CKVC + S_CKVC,           S_KRC = (size_t)NL * 512 * 64 * 2;
constexpr size_t O_KC = O_KRC + S_KRC,              S_KC = (size_t)NL * 512 * 1024 * 2;
constexpr size_t O_VTC = O_KC + S_KC;
constexpr size_t O_MOD = O_VTC + S_KC,              S_MOD = (size_t)NL * 3 * 6144 * 4;
constexpr size_t O_ROPE = O_MOD + S_MOD,            S_ROPE = 64 * 16 * 8;
constexpr size_t O_RSS = O_ROPE + S_ROPE,           S_RSS = (size_t)4 * T * 4;
constexpr size_t O_H = O_RSS + S_RSS,               S_H = (size_t)T * DM * 2;
constexpr size_t O_X = O_H + S_H,                   S_X = (size_t)T * DM * 4;
constexpr size_t O_Z = O_X + S_X,                   S_Z = (size_t)T * ZW * 2;
constexpr size_t O_VST = O_Z + S_Z,                 S_T16 = (size_t)1024 * T * 2;
constexpr size_t O_RVT = O_VST + S_T16;
constexpr size_t O_VT = O_RVT + S_T16;
constexpr size_t O_KN = O_VT + S_T16;
constexpr size_t O_AM = O_KN + S_T16;
constexpr size_t O_AS = O_AM + S_T16;
constexpr size_t O_AR = O_AS + S_T16;
constexpr size_t O_Q = O_AR + S_T16,                S_Q = (size_t)T * 1536 * 2;
constexpr size_t O_KR = O_Q + S_Q,                  S_KR = (size_t)T * 64 * 2;
constexpr size_t O_ST = O_KR + S_KR,                S_ST = (size_t)64 * 8 * 2 * 16384 * 4;
constexpr size_t O_YMF = O_ST + S_ST;
constexpr size_t O_YMB = O_YMF + S_X;
constexpr size_t O_Y = O_YMB + S_H;
constexpr size_t O_PF = O_Y + S_X,                  S_PF = (size_t)64 * 8 * 2 * 16384 * 2;
constexpr size_t O_BAR = O_PF + S_PF;
constexpr size_t WS_END = O_BAR + 16384;

struct Args { const float* in[25]; float* out; unsigned char* ws; int ph_lo, ph_hi; };

__device__ __forceinline__ unsigned cvt_pk(float lo, float hi) { unsigned r; asm volatile("v_cvt_pk_bf16_f32 %0, %1, %2" : "=v"(r) : "v"(lo), "v"(hi)); return r; }
__device__ __forceinline__ float bf2f(unsigned short b) { return __uint_as_float(((unsigned)b) << 16); }
__device__ __forceinline__ float bflo(unsigned w) { return __uint_as_float(w << 16); }
__device__ __forceinline__ float bfhi(unsigned w) { return __uint_as_float(w & 0xffff0000u); }
__device__ __forceinline__ float sigm_f(float x) { return __builtin_amdgcn_rcpf(1.f + __builtin_amdgcn_exp2f(x * -1.4426950408889634f)); }
__device__ __forceinline__ float silu_f(float x) { return x * sigm_f(x); }
__device__ __forceinline__ float wave_sum(float v) {
#pragma unroll
    for (int o = 1; o < 64; o <<= 1) v += __shfl_xor(v, o);
    return v;
}

namespace pg8 {
constexpr int BM = 256, BK = 64, HALF = 128, HTB = HALF * BK * 2, STAGE_BYTES = 8 * HTB, NXCD = 8, WGM = 8;
__host__ __device__ __forceinline__ int lds_byte(int r, int c) { const int st = (r >> 4) * 2 + (c >> 5), rr = r & 15, cc = c & 31, ob = rr * 64 + cc * 2; return st * 1024 + (ob ^ (((ob >> 9) & 1) << 5)); }
__host__ __device__ __forceinline__ void stage_rc(int b, int& R, int& C) { const int st = b / 1024, sb = b % 1024, swz = sb ^ (((sb >> 9) & 1) << 5); R = (st >> 1) * 16 + swz / 64; C = (st & 1) * 32 + (swz % 64) / 2; }
__host__ __device__ __forceinline__ int perm32(int rho) { const int n = rho >> 4, i = rho & 15; return 8 * (i >> 2) + 4 * n + (i & 3); }

struct Unit { const char* a; const char* b; int pm, pn, kind, aux; };

__device__ __forceinline__ void tile_order(int L, int nM, int nN, int& pm, int& pn) {
    const int nwg = nM * nN; int wgid = L; { const int q = nwg / NXCD, r = nwg % NXCD, xcd = wgid % NXCD, off = wgid / NXCD; wgid = (xcd < r ? xcd * (q + 1) : r * (q + 1) + (xcd - r) * q) + off; }
    const int nig = WGM * nN, gid = wgid / nig, fm = gid * WGM, gsz = (nM - fm) < WGM ? (nM - fm) : WGM;
    pm = fm + ((wgid % nig) % gsz); pn = (wgid % nig) / gsz;
}

template <class Epi, class Sched>
__device__ __forceinline__ void gemm_phase(LAS unsigned char* lds, const int tid, const int K, const int lda, const int ldb, const Sched& S, const Epi& E) {
    const int  wid = __builtin_amdgcn_readfirstlane(tid >> 6), lane = tid & 63, wr = wid >> 2, wc = wid & 3, fr = lane & 15, fq = lane >> 4;
    const int nt = K / BK;
    unsigned voffA[2], voffB[2];
#pragma unroll
    for (int i = 0; i < 2; ++i) { int R, C; stage_rc(tid * 16 + i * 8192, R, C); const int Rb = (R & ~31) + perm32(R & 31);
        voffA[i] = (unsigned)(R * lda + C) * 2u; voffB[i] = (unsigned)(Rb * ldb + C) * 2u; }
    const size_t kstep = (size_t)(BK * 2);
    const size_t hstepA = (size_t)HALF * lda * 2, hstepB = (size_t)HALF * ldb * 2;
    const unsigned ldsw = (unsigned)wid * 1024u;
    const int aoff = lds_byte(wr * 64 + fr, fq * 8), boff = lds_byte(wc * 32 + fr, fq * 8);
#define PG8_SA(b, h) (((b) * 2 + (h)) * HTB)
#define PG8_SB(b, h) ((4 + (b) * 2 + (h)) * HTB)
#define PG8_STAGE(bufoff, gbase, voff) do { _Pragma("unroll") for (int _i = 0; _i < 2; ++_i) \
        __builtin_amdgcn_global_load_lds((const unsigned*)((const char*)(gbase) + (voff)[_i]), (LAS unsigned*)(lds + (bufoff) + ldsw + _i * 8192), 16, 0, 0); } while (0)
#define PG8_LDA(dst, b, h) do { _Pragma("unroll") for (int m = 0; m < 4; ++m) _Pragma("unroll") for (int k = 0; k < 2; ++k) dst[m][k] = *(const LAS bf16x8*)(lds + PG8_SA(b, h) + aoff + m * 2048 + k * 1024); } while (0)
#define PG8_LDB(dst, b, h) do { _Pragma("unroll") for (int n = 0; n < 2; ++n) _Pragma("unroll") for (int k = 0; k < 2; ++k) dst[n][k] = *(const LAS bf16x8*)(lds + PG8_SB(b, h) + boff + n * 2048 + k * 1024); } while (0)
#define PG8_MMA(ai, bj, At, Bt) do { __builtin_amdgcn_s_setprio(1); _Pragma("unroll") for (int m = 0; m < 4; ++m) _Pragma("unroll") for (int n = 0; n < 2; ++n) _Pragma("unroll") for (int k = 0; k < 2; ++k) \
        acc[ai][bj][m][n] = __builtin_amdgcn_mfma_f32_16x16x32_bf16(Bt[n][k], At[m][k], acc[ai][bj][m][n], 0, 0, 0); __builtin_amdgcn_s_setprio(0); } while (0)
#define PG8_WAIT_V(n) asm volatile("s_waitcnt vmcnt(" #n ")" ::: "memory")
#define PG8_WAIT_L(n) asm volatile("s_waitcnt lgkmcnt(" #n ")" ::: "memory")
#define PG8_BAR __builtin_amdgcn_s_barrier()
#define PG8_SCHED __builtin_amdgcn_sched_barrier(0)
    Unit cur, nxt; int ui = 0;
    if (!S.next(0, cur)) return;
    f32x4 acc[2][2][4][2];
#pragma unroll
    for (int a = 0; a < 2; ++a)
#pragma unroll
        for (int b = 0; b < 2; ++b)
#pragma unroll
            for (int m = 0; m < 4; ++m)
#pragma unroll
                for (int n = 0; n < 2; ++n) acc[a][b][m][n] = (f32x4){0.f, 0.f, 0.f, 0.f};
    bf16x8 At[4][2], B0[2][2], B1[2][2];
    const char* cA = cur.a; const char* cB = cur.b;
    PG8_STAGE(PG8_SB(0, 0), cB, voffB); PG8_STAGE(PG8_SA(0, 0), cA, voffA); PG8_STAGE(PG8_SB(0, 1), cB + hstepB, voffB); PG8_STAGE(PG8_SA(0, 1), cA + hstepA, voffA);
    if (wr == 1) PG8_BAR;
    PG8_WAIT_V(4); PG8_BAR;
    PG8_STAGE(PG8_SB(1, 0), cB + kstep, voffB); PG8_STAGE(PG8_SA(1, 0), cA + kstep, voffA); PG8_STAGE(PG8_SB(1, 1), cB + hstepB + kstep, voffB);
    PG8_WAIT_V(6); PG8_BAR;
    for (;;) {
        const bool has_next = S.next(ui + 1, nxt);
        const char* nA = has_next ? nxt.a : cA; const char* nB = has_next ? nxt.b : cB;
        for (int t = 0; t < nt; t += 2) {
            const bool last = (t == nt - 2);
            const char* a1 = cA + (size_t)(t + 1) * kstep;
            const char* a2 = last ? nA : cA + (size_t)(t + 2) * kstep; const char* b2 = last ? nB : cB + (size_t)(t + 2) * kstep;
            const char* a3 = a2 + kstep; const char* b3 = b2 + kstep;
            PG8_LDB(B0, 0, 0); PG8_SCHED; PG8_LDA(At, 0, 0); PG8_STAGE(PG8_SA(1, 1), a1 + hstepA, voffA);
            PG8_WAIT_L(8); PG8_BAR; PG8_WAIT_L(0); PG8_MMA(0, 0, At, B0); PG8_BAR; PG8_SCHED;
            PG8_LDB(B1, 0, 1); PG8_STAGE(PG8_SB(0, 0), b2, voffB);
            PG8_BAR; PG8_WAIT_L(0); PG8_MMA(0, 1, At, B1); PG8_BAR;
            PG8_LDA(At, 0, 1); PG8_STAGE(PG8_SA(0, 0), a2, voffA);
            PG8_BAR; PG8_WAIT_L(0); PG8_MMA(1, 0, At, B0); PG8_BAR; PG8_SCHED;
            PG8_STAGE(PG8_SB(0, 1), b2 + hstepB, voffB);
            PG8_WAIT_V(6); PG8_BAR; PG8_MMA(1, 1, At, B1); PG8_BAR;
            PG8_LDB(B0, 1, 0); PG8_SCHED; PG8_LDA(At, 1, 0); PG8_STAGE(PG8_SA(0, 1), a2 + hstepA, voffA);
            PG8_WAIT_L(8); PG8_BAR; PG8_WAIT_L(0); PG8_MMA(0, 0, At, B0); PG8_BAR; PG8_SCHED;
            PG8_LDB(B1, 1, 1); PG8_STAGE(PG8_SB(1, 0), b3, voffB);
            PG8_BAR; PG8_WAIT_L(0); PG8_MMA(0, 1, At, B1); PG8_BAR;
            PG8_LDA(At, 1, 1); PG8_STAGE(PG8_SA(1, 0), a3, voffA);
            PG8_BAR; PG8_WAIT_L(0); PG8_MMA(1, 0, At, B0); PG8_BAR; PG8_SCHED;
            PG8_STAGE(PG8_SB(1, 1), b3 + hstepB, voffB);
            PG8_WAIT_V(6); PG8_BAR; PG8_MMA(1, 1, At, B1); PG8_BAR;
        }
        E(acc, cur, wr, wc, fr, fq);
        if (!has_next) break;
        if (cur.aux != 1)
#pragma unroll
        for (int a = 0; a < 2; ++a)
#pragma unroll
            for (int b = 0; b < 2; ++b)
#pragma unroll
                for (int m = 0; m < 4; ++m)
#pragma unroll
                    for (int n = 0; n < 2; ++n) acc[a][b][m][n] = (f32x4){0.f, 0.f, 0.f, 0.f};
        cur = nxt; cA = nA; cB = nB; ++ui;
    }
    PG8_WAIT_V(0);
    if (wr == 0) PG8_BAR;
    PG8_BAR;
#undef PG8_SA
#undef PG8_SB
#undef PG8_STAGE
#undef PG8_LDA
#undef PG8_LDB
#undef PG8_MMA
#undef PG8_WAIT_V
#undef PG8_WAIT_L
#undef PG8_BAR
#undef PG8_SCHED
}
}
typedef f32x4 (&AccRef)[2][2][4][2];

#define XB_TMO      128
#define XB_XCNT(j)  (256  + 64 * (j))
#define XB_XSUB(j)  (1280 + 64 * (j))
#define XB_XGEN(j)  (2304 + 64 * (j))
#define XB_TOP      3328
#define XB_TOPGEN   3392
#define XCD_BAR_WORDS 3456
#define XB_SPIN_CAP (1u << 22)
__device__ __forceinline__ unsigned xb_ld(unsigned* p)              { return __hip_atomic_load(p, __ATOMIC_RELAXED, __HIP_MEMORY_SCOPE_AGENT); }
__device__ __forceinline__ unsigned xb_add(unsigned* p, unsigned v) { return __hip_atomic_fetch_add(p, v, __ATOMIC_RELAXED, __HIP_MEMORY_SCOPE_AGENT); }
__device__ __forceinline__ unsigned xb_xcc_id() { return (unsigned)__builtin_amdgcn_s_getreg((3 << 11) | 20) & 0xFu; }
#define XB_SPIN(cond, bar) do { unsigned _sp = 0; while (cond) { __builtin_amdgcn_s_sleep(1); \
    if ((++_sp & 255u) == 0u) { if (xb_ld(&(bar)[XB_TMO])) break; if (_sp > XB_SPIN_CAP) { atomicAdd(&(bar)[XB_TMO], 1u); break; } } } } while (0)
struct XcdBarrier { unsigned* bar; unsigned x; volatile LAS unsigned* st; };
__device__ __forceinline__ XcdBarrier xcd_barrier_post(unsigned* bar, volatile LAS unsigned* st) {
    XcdBarrier b; b.bar = bar; b.x = xb_xcc_id(); b.st = st;
    if (threadIdx.x == 0) (void)xb_add(&bar[XB_XCNT(b.x)], 1u);
    return b;
}
__device__ __forceinline__ void xcd_barrier_complete(unsigned* bar, unsigned x, unsigned& nloc, unsigned& nx) {
    const unsigned G = gridDim.x * gridDim.y * gridDim.z;
    unsigned sum, cnt, mine, sp = 0u;
    for (;;) {
        sum = 0u; cnt = 0u; mine = 0u;
#pragma unroll
        for (unsigned j = 0; j < 16; ++j) { const unsigned c = xb_ld(&bar[XB_XCNT(j)]); sum += c; cnt += (c > 0u) ? 1u : 0u; }
        mine = xb_ld(&bar[XB_XCNT(x)]);
        if (sum == G) break;
        __builtin_amdgcn_s_sleep(1);
        if ((++sp & 255u) == 0u) { if (xb_ld(&bar[XB_TMO])) break; if (sp > XB_SPIN_CAP) { atomicAdd(&bar[XB_TMO], 1u); break; } }
    }
    nloc = mine > 0u ? mine : 1u; nx = cnt > 0u ? cnt : 1u;
}
__device__ __forceinline__ void xcd_barrier(const XcdBarrier& b) {
    asm volatile("s_waitcnt vmcnt(0)" ::: "memory");
    __syncthreads();
    if (threadIdx.x == 0) {
        unsigned* bar = b.bar;
        __builtin_amdgcn_s_waitcnt(0);
        unsigned nloc = b.st[0], nx = b.st[1];
        if (nloc == 0u) { xcd_barrier_complete(bar, b.x, nloc, nx); b.st[0] = nloc; b.st[1] = nx; }
        const unsigned old = xb_add(&bar[XB_XSUB(b.x)], 1u);
        const unsigned gen = old / nloc;
        if (old + 1u == (gen + 1u) * nloc) {
            __builtin_amdgcn_fence(__ATOMIC_RELEASE, "agent");
            asm volatile("s_waitcnt vmcnt(0)" ::: "memory");
            const unsigned og = xb_add(&bar[XB_TOP], 1u);
            const unsigned tg = og / nx;
            if (og + 1u == (tg + 1u) * nx) xb_add(&bar[XB_TOPGEN], 1u);
            else XB_SPIN(xb_ld(&bar[XB_TOPGEN]) == tg, bar);
            __builtin_amdgcn_fence(__ATOMIC_ACQUIRE, "agent");
            xb_add(&bar[XB_XGEN(b.x)], 1u);
            asm volatile("s_waitcnt vmcnt(0)" ::: "memory");
        } else {
            XB_SPIN(xb_ld(&bar[XB_XGEN(b.x)]) == gen, bar);
            __builtin_amdgcn_fence(__ATOMIC_ACQUIRE, "agent");
            asm volatile("s_waitcnt vmcnt(0)" ::: "memory");
        }
    }
    __syncthreads();
}
using pg8::Unit;
typedef const unsigned long long __attribute__((address_space(4)))* CPtr64;
struct InTab { CPtr64 p; __device__ __forceinline__ const float* operator[](int i) const { return (const float*)(GAS const float*)p[i]; } };
struct Ctx {
    unsigned char* ws; float* out; InTab in;
    int G, c, tid;
};
#define WSP(T_, off) ((T_*)(X.ws + (off)))

struct SchedZ {
    const char* h; const char* w; int G, c, mode;
    __device__ __forceinline__ bool next(int i, Unit& u) const {
        const int ntn = mode ? 37 : 24; const long Lx = (long)i * G + c; if (Lx >= 32 * ntn) return false;
        int pm, pj; pg8::tile_order((int)Lx, 32, ntn, pm, pj);
        const int pn = mode ? (pj < 4 ? 4 + pj : pj < 8 ? 16 + pj : 24 + pj) : (pj < 4 ? pj : pj < 16 ? pj + 4 : pj + 8);
        const char* hp = h + (size_t)pm * 256 * 2048 * 2; const char* wp = w + (size_t)pn * 256 * 2048 * 2;
        const bool sw = (pn >= 12 && pn < 16) || (pn >= 28 && pn < 32);
        u.pm = pm; u.pn = pn; u.kind = sw ? 1 : 0; u.aux = 0; u.a = sw ? wp : hp; u.b = sw ? hp : wp; return true;
    }
};
struct EpiZ {
    bf16_t* z; bf16_t* vsT; bf16_t* rvT; float* rss; bool doss;
    __device__ __forceinline__ void operator()(AccRef acc, const Unit& u, int wr, int wc, int fr, int fq) const {
        if (u.kind == 0) {
            const int pn = u.pn;
            const int act = (pn >= 36 && pn < 60) ? 2 : ((pn >= 4 && pn < 8) || (pn >= 16 && pn < 20) || (pn >= 32 && pn < 36)) ? 1 : (pn >= 24 && pn < 28) ? 3 : 0;
            const int row0 = u.pm * 256 + wr * 64 + fr, col0 = pn * 256 + wc * 32 + 8 * fq;
#pragma unroll
            for (int ai = 0; ai < 2; ++ai)
#pragma unroll
                for (int m = 0; m < 4; ++m) {
                    const int row = row0 + ai * 128 + m * 16; bf16_t* rowp = z + (size_t)row * ZW + col0; float ss = 0.f;
#pragma unroll
                    for (int bj = 0; bj < 2; ++bj) { f32x4 v0 = acc[ai][bj][m][0], v1 = acc[ai][bj][m][1];
                        if (act == 0) { ss += v0[0] * v0[0] + v0[1] * v0[1] + v0[2] * v0[2] + v0[3] * v0[3] + v1[0] * v1[0] + v1[1] * v1[1] + v1[2] * v1[2] + v1[3] * v1[3]; }
                        else if (act == 1) {
#pragma unroll
                            for (int j = 0; j < 4; ++j) { v0[j] = silu_f(v0[j]); v1[j] = silu_f(v1[j]); } }
                        else if (act == 2) {
#pragma unroll
                            for (int j = 0; j < 4; ++j) { v0[j] = fmaxf(sigm_f(v0[j]), 1e-20f); v1[j] = fmaxf(sigm_f(v1[j]), 1e-20f); } }
                        else { v0 = v0 * 0.08838834764831845f; v1 = v1 * 0.08838834764831845f; }
                        u32x4 w; w.x = cvt_pk(v0[0], v0[1]); w.y = cvt_pk(v0[2], v0[3]); w.z = cvt_pk(v1[0], v1[1]); w.w = cvt_pk(v1[2], v1[3]);
                        *(u32x4*)(rowp + bj * 128) = w; }
                    if (pn < 4 && doss) { ss += __shfl_xor(ss, 16); ss += __shfl_xor(ss, 32); if (fq == 0) atomicAdd(rss + (pn >> 1) * T + row, ss); }
                }
        } else {
            const bool isv = u.pn < 16; bf16_t* dst = isv ? vsT : rvT; const int f0 = (u.pn - (isv ? 12 : 28)) * 256 + wr * 64 + fr, tok0 = u.pm * 256 + wc * 32 + 8 * fq;
            float cs[2][2][4];
#pragma unroll
            for (int bj = 0; bj < 2; ++bj)
#pragma unroll
                for (int n = 0; n < 2; ++n)
#pragma unroll
                    for (int j = 0; j < 4; ++j) cs[bj][n][j] = 0.f;
#pragma unroll
            for (int ai = 0; ai < 2; ++ai)
#pragma unroll
                for (int m = 0; m < 4; ++m) { bf16_t* rowp = dst + (size_t)(f0 + ai * 128 + m * 16) * T + tok0;
#pragma unroll
                    for (int bj = 0; bj < 2; ++bj) { const f32x4 v0 = acc[ai][bj][m][0], v1 = acc[ai][bj][m][1];
#pragma unroll
                        for (int j = 0; j < 4; ++j) { cs[bj][0][j] += v0[j] * v0[j]; cs[bj][1][j] += v1[j] * v1[j]; }
                        u32x4 w; w.x = cvt_pk(v0[0], v0[1]); w.y = cvt_pk(v0[2], v0[3]); w.z = cvt_pk(v1[0], v1[1]); w.w = cvt_pk(v1[2], v1[3]);
                        *(u32x4*)(rowp + bj * 128) = w; } }
            if (isv && doss) {
#pragma unroll
                for (int bj = 0; bj < 2; ++bj)
#pragma unroll
                    for (int n = 0; n < 2; ++n)
#pragma unroll
                        for (int j = 0; j < 4; ++j) { float s = cs[bj][n][j]; s += __shfl_xor(s, 1); s += __shfl_xor(s, 2); s += __shfl_xor(s, 4); s += __shfl_xor(s, 8);
                            if (fr == 0) atomicAdd(rss + 2 * T + tok0 + bj * 128 + n * 4 + j, s); }
            }
        }
    }
};

__device__ __forceinline__ int deal_qk(int i, int G, int c) {
    if (G != 256) { const int L = i * G + c; return L < 320 ? L : -1; }
    if (c < 160) return i == 0 ? c : -1;
    const int r = c - 160; if (r < 64) return i < 2 ? 160 + 2 * r + i : -1;
    return i == 0 ? 288 + (r - 64) : -1;
}
__device__ __forceinline__ int deal_vt(int i, int G, int c) {
    if (G != 256) { const int L = i * G + c; return L < 128 ? L : -1; }
    if (c < 160) return -1;
    const int r = c - 160; if (r < 64) return i == 0 ? r : -1;
    return i < 2 ? 64 + 2 * (r - 64) + i : -1;
}
struct SchedQK {
    const char* z; const char* wq; const char* wk; int G, c;
    __device__ __forceinline__ bool next(int i, Unit& u) const {
        const int Lx = deal_qk(i, G, c); if (Lx < 0) return false;
        if (Lx < 192) { u.pm = Lx / 6; u.pn = Lx % 6; u.kind = 0; u.a = z + (size_t)u.pm * 256 * ZW * 2 + Z_CQ * 2; u.b = wq + (size_t)u.pn * 256 * 512 * 2; }
        else { const int r = Lx - 192; u.pm = r / 4; u.pn = r % 4; u.kind = 1; u.a = z + (size_t)u.pm * 256 * ZW * 2 + Z_CKV * 2; u.b = wk + (size_t)u.pn * 256 * 512 * 2; }
        u.aux = 0; return true;
    }
};
constexpr float QSCALE = 0.07216878364870322f * 1.4426950408889634f;
struct EpiQK {
    bf16_t* q; bf16_t* kn; const float* rss; const LAS float* rope;
    __device__ __forceinline__ void operator()(AccRef acc, const Unit& u, int wr, int wc, int fr, int fq) const {
        const int row0 = u.pm * 256 + wr * 64 + fr, col0 = u.pn * 256 + wc * 32 + 8 * fq;
        float rr[2][4];
#pragma unroll
        for (int ai = 0; ai < 2; ++ai)
#pragma unroll
            for (int m = 0; m < 4; ++m) rr[ai][m] = rss[(u.kind == 0 ? 0 : T) + row0 + ai * 128 + m * 16];
        __builtin_amdgcn_sched_barrier(0);
        if (u.kind == 0) {
#pragma unroll
            for (int ai = 0; ai < 2; ++ai)
#pragma unroll
                for (int m = 0; m < 4; ++m) {
                    const int row = row0 + ai * 128 + m * 16; const float ri = rsqrtf(rr[ai][m] * (1.f / 512.f) + EPSN) * QSCALE;
                    const int t = (row - 4096) & 2047;
#pragma unroll
                    for (int bj = 0; bj < 2; ++bj) { f32x4 v0 = acc[ai][bj][m][0] * ri, v1 = acc[ai][bj][m][1] * ri;
                        const int g0 = u.pn * 256 + bj * 128 + wc * 32, off = g0 % 192;
                        if (off >= 128 && row >= 4096) {
                            const int p = (off == 128) ? (t >> 6) : (t & 63); const LAS float* tb = rope + (p * 16 + (fq & 1) * 8) * 2;
                            const float sg = (fq & 2) ? 1.f : -1.f;
#pragma unroll
                            for (int j = 0; j < 4; ++j) { const float p0 = __shfl_xor(v0[j], 32), p1 = __shfl_xor(v1[j], 32);
                                const float c0 = tb[2 * j], s0 = tb[2 * j + 1], c1 = tb[2 * (4 + j)], s1 = tb[2 * (4 + j) + 1];
                                v0[j] = v0[j] * c0 + sg * p0 * s0; v1[j] = v1[j] * c1 + sg * p1 * s1; }
                        }
                        u32x4 w; w.x = cvt_pk(v0[0], v0[1]); w.y = cvt_pk(v0[2], v0[3]); w.z = cvt_pk(v1[0], v1[1]); w.w = cvt_pk(v1[2], v1[3]);
                        *(u32x4*)(q + (size_t)row * 1536 + col0 + bj * 128) = w; }
                }
        } else {
#pragma unroll
            for (int ai = 0; ai < 2; ++ai)
#pragma unroll
                for (int m = 0; m < 4; ++m) {
                    const int row = row0 + ai * 128 + m * 16; const float ri = rsqrtf(rr[ai][m] * (1.f / 512.f) + EPSN);
#pragma unroll
                    for (int bj = 0; bj < 2; ++bj) { const f32x4 v0 = acc[ai][bj][m][0] * ri, v1 = acc[ai][bj][m][1] * ri;
                        u32x4 w; w.x = cvt_pk(v0[0], v0[1]); w.y = cvt_pk(v0[2], v0[3]); w.z = cvt_pk(v1[0], v1[1]); w.w = cvt_pk(v1[2], v1[3]);
                        *(u32x4*)(kn + (size_t)row * 1024 + col0 + bj * 128) = w; }
                }
        }
    }
};

struct SchedVT {
    const char* z; const char* wv; int G, c;
    __device__ __forceinline__ bool next(int i, Unit& u) const {
        const int Lx = deal_vt(i, G, c); if (Lx < 0) return false;
        u.pm = Lx & 3; u.pn = Lx >> 2; u.kind = 0; u.aux = 0; u.a = wv + (size_t)u.pm * 256 * 512 * 2; u.b = z + (size_t)u.pn * 256 * ZW * 2 + Z_CKV * 2; return true;
    }
};
struct EpiVT {
    bf16_t* vt; const float* rss;
    __device__ __forceinline__ void operator()(AccRef acc, const Unit& u, int wr, int wc, int fr, int fq) const {
        const int f0 = u.pm * 256 + wr * 64 + fr, tok0 = u.pn * 256 + wc * 32 + 8 * fq;
        f32x4 ri[2][2];
#pragma unroll
        for (int bj = 0; bj < 2; ++bj)
#pragma unroll
            for (int n = 0; n < 2; ++n)
#pragma unroll
                for (int j = 0; j < 4; ++j) ri[bj][n][j] = rsqrtf(rss[T + tok0 + bj * 128 + n * 4 + j] * (1.f / 512.f) + EPSN);
#pragma unroll
        for (int ai = 0; ai < 2; ++ai)
#pragma unroll
            for (int m = 0; m < 4; ++m) { bf16_t* rowp = vt + (size_t)(f0 + ai * 128 + m * 16) * T + tok0;
#pragma unroll
                for (int bj = 0; bj < 2; ++bj) { const f32x4 v0 = acc[ai][bj][m][0] * ri[bj][0], v1 = acc[ai][bj][m][1] * ri[bj][1];
                    u32x4 w; w.x = cvt_pk(v0[0], v0[1]); w.y = cvt_pk(v0[2], v0[3]); w.z = cvt_pk(v1[0], v1[1]); w.w = cvt_pk(v1[2], v1[3]);
                    *(u32x4*)(rowp + bj * 128) = w; } }
    }
};

struct SchedC {
    const char* cc; const char* wk; const char* wv; int G, c, l;
    __device__ __forceinline__ bool next(int i, Unit& u) const {
        const int r = i * G + c; if (r >= 16) return false;
        u.aux = l;
        if (r < 8) { u.kind = 0; u.pm = r >> 2; u.pn = r & 3; u.a = cc + ((size_t)l * 512 + u.pm * 256) * 512 * 2; u.b = wk + ((size_t)l * 1024 + u.pn * 256) * 512 * 2; }
        else { const int s = r - 8; u.kind = 1; u.pm = s >> 1; u.pn = s & 1; u.a = wv + ((size_t)l * 1024 + u.pm * 256) * 512 * 2; u.b = cc + ((size_t)l * 512 + u.pn * 256) * 512 * 2; }
        return true;
    }
};
struct EpiC {
    bf16_t* kc; bf16_t* vtc;
    __device__ __forceinline__ void operator()(AccRef acc, const Unit& u, int wr, int wc, int fr, int fq) const {
        const int r0 = u.pm * 256 + wr * 64 + fr, c0 = u.pn * 256 + wc * 32 + 8 * fq;
        bf16_t* base = u.kind == 0 ? kc + (size_t)u.aux * 512 * 1024 : vtc + (size_t)u.aux * 1024 * 512; const int ld = u.kind == 0 ? 1024 : 512;
#pragma unroll
        for (int ai = 0; ai < 2; ++ai)
#pragma unroll
            for (int m = 0; m < 4; ++m) { bf16_t* rowp = base + (size_t)(r0 + ai * 128 + m * 16) * ld + c0;
#pragma unroll
                for (int bj = 0; bj < 2; ++bj) { const f32x4 v0 = acc[ai][bj][m][0], v1 = acc[ai][bj][m][1];
                    u32x4 w; w.x = cvt_pk(v0[0], v0[1]); w.y = cvt_pk(v0[2], v0[3]); w.z = cvt_pk(v1[0], v1[1]); w.w = cvt_pk(v1[2], v1[3]);
                    *(u32x4*)(rowp + bj * 128) = w; } }
    }
};

struct SchedBr {
    const char* am; const char* as; const char* ar; const char* w; int G, c;
    __device__ __forceinline__ bool next(int i, Unit& u) const {
        const int tile = (i / 3) * G + c; if (tile >= 256) return false;
        const int br = i % 3; pg8::tile_order(tile, 32, 8, u.pm, u.pn); u.kind = br; u.aux = br < 2 ? 1 : 0;
        u.a = (br == 0 ? am : br == 1 ? as : ar) + (size_t)u.pm * 256 * 1024 * 2; u.b = w + ((size_t)br * 2048 + u.pn * 256) * 1024 * 2; return true;
    }
};
struct EpiBr {
    const bf16_t* z; bf16_t* ymb;
    __device__ __forceinline__ void operator()(AccRef acc, const Unit& u, int wr, int wc, int fr, int fq) const {
        const int row0 = u.pm * 256 + wr * 64 + fr, col0 = u.pn * 256 + wc * 32 + 8 * fq;
#pragma unroll
        for (int ai = 0; ai < 2; ++ai) {
            u32x4 g0[4][2], g1[4][2];
#pragma unroll
            for (int m = 0; m < 4; ++m)
#pragma unroll
                for (int bj = 0; bj < 2; ++bj) { const bf16_t* mp = z + (size_t)(row0 + ai * 128 + m * 16) * ZW + Z_MRG + u.kind * 2048 + col0 + bj * 128;
                    g0[m][bj] = *(const u32x4*)mp; if (u.kind < 2) g1[m][bj] = *(const u32x4*)(mp + 2048); }
            __builtin_amdgcn_sched_barrier(0);
#pragma unroll
            for (int m = 0; m < 4; ++m) { const int row = row0 + ai * 128 + m * 16;
#pragma unroll
                for (int bj = 0; bj < 2; ++bj) { const int col = col0 + bj * 128;
                    const u32x4 mg = g0[m][bj];
                    f32x4 s0, s1; s0[0] = bflo(mg.x); s0[1] = bfhi(mg.x); s0[2] = bflo(mg.y); s0[3] = bfhi(mg.y); s1[0] = bflo(mg.z); s1[1] = bfhi(mg.z); s1[2] = bflo(mg.w); s1[3] = bfhi(mg.w);
                    if (u.kind < 2) { const u32x4 mn = g1[m][bj];
                        s0[0] *= __builtin_amdgcn_rcpf(bflo(mn.x)); s0[1] *= __builtin_amdgcn_rcpf(bfhi(mn.x)); s0[2] *= __builtin_amdgcn_rcpf(bflo(mn.y)); s0[3] *= __builtin_amdgcn_rcpf(bfhi(mn.y));
                        s1[0] *= __builtin_amdgcn_rcpf(bflo(mn.z)); s1[1] *= __builtin_amdgcn_rcpf(bfhi(mn.z)); s1[2] *= __builtin_amdgcn_rcpf(bflo(mn.w)); s1[3] *= __builtin_amdgcn_rcpf(bfhi(mn.w));
                        acc[ai][bj][m][0] *= s0; acc[ai][bj][m][1] *= s1; }
                    else { const f32x4 v0 = acc[ai][bj][m][0] * s0, v1 = acc[ai][bj][m][1] * s1;
                        u32x4 w; w.x = cvt_pk(v0[0], v0[1]); w.y = cvt_pk(v0[2], v0[3]); w.z = cvt_pk(v1[0], v1[1]); w.w = cvt_pk(v1[2], v1[3]);
                        *(u32x4*)(ymb + (size_t)row * DM + col) = w; }
                } }
            __builtin_amdgcn_sched_barrier(0);
        }
    }
};

struct SchedOut {
    const char* a; const char* w; int G, c;
    __device__ __forceinline__ bool next(int i, Unit& u) const {
        const int tile = i * G + c; if (tile >= 256) return false;
        pg8::tile_order(tile, 32, 8, u.pm, u.pn); u.kind = 0; u.aux = 0; u.a = a + (size_t)u.pm * 256 * 2048 * 2; u.b = w + (size_t)u.pn * 256 * 2048 * 2; return true;
    }
};
struct EpiOut {
    float* y; float* rss; bool doss;
    __device__ __forceinline__ void operator()(AccRef acc, const Unit& u, int wr, int wc, int fr, int fq) const {
        const int row0 = u.pm * 256 + wr * 64 + fr, col0 = u.pn * 256 + wc * 32 + 8 * fq;
#pragma unroll
        for (int ai = 0; ai < 2; ++ai)
#pragma unroll
            for (int m = 0; m < 4; ++m) { const int row = row0 + ai * 128 + m * 16; float ss = 0.f;
#pragma unroll
                for (int bj = 0; bj < 2; ++bj) { const f32x4 v0 = acc[ai][bj][m][0], v1 = acc[ai][bj][m][1]; float* yp = y + (size_t)row * DM + col0 + bj * 128;
                    ss += v0[0] * v0[0] + v0[1] * v0[1] + v0[2] * v0[2] + v0[3] * v0[3] + v1[0] * v1[0] + v1[1] * v1[1] + v1[2] * v1[2] + v1[3] * v1[3];
                    *(f32x4*)yp = v0; *(f32x4*)(yp + 4) = v1; }
                ss += __shfl_xor(ss, 16); ss += __shfl_xor(ss, 32); if (fq == 0 && doss) atomicAdd(rss + 3 * T + row, ss); }
    }
};
__device__ __forceinline__ void transpose_item(const float* W, int K, int N, int k0, int n0, bf16_t* dst0, const float* gk, LAS float* scr, int lane) {
    const int kr = lane >> 3, c4 = (lane & 7) * 4;
    f32x4 v[8];
#pragma unroll
    for (int i = 0; i < 8; ++i) v[i] = __builtin_nontemporal_load((const f32x4*)(W + (size_t)(k0 + 8 * i + kr) * N + n0 + c4));
    if (gk) {
#pragma unroll
        for (int i = 0; i < 8; ++i) v[i] = v[i] * gk[k0 + 8 * i + kr]; }
#pragma unroll
    for (int i = 0; i < 8; ++i) { LAS float* sp = scr + (8 * i + kr) * 33 + c4; sp[0] = v[i][0]; sp[1] = v[i][1]; sp[2] = v[i][2]; sp[3] = v[i][3]; }
    asm volatile("s_waitcnt lgkmcnt(0)" ::: "memory");
    const int c = lane & 7;
#pragma unroll
    for (int j = 0; j < 4; ++j) { const int n = (lane >> 3) + 8 * j; const LAS float* s = scr + (8 * c) * 33 + n;
        u32x4 o; o.x = cvt_pk(s[0 * 33], s[1 * 33]); o.y = cvt_pk(s[2 * 33], s[3 * 33]); o.z = cvt_pk(s[4 * 33], s[5 * 33]); o.w = cvt_pk(s[6 * 33], s[7 * 33]);
        *(u32x4*)(dst0 + (size_t)n * K + k0 + 8 * c) = o; }
    asm volatile("s_waitcnt lgkmcnt(0)" ::: "memory");
}

__device__ __forceinline__ void phase_prologue(const Ctx& X, LAS unsigned char* lds) {
    const int tid = X.tid, lane = tid & 63, wave = tid >> 6;
    const int gw = X.c * 8 + wave, NGW = X.G * 8;
    LAS float* scr = (LAS float*)(lds + wave * 8704);
    constexpr int I_IN = 32 * 482, I_UQ = 8 * 48, I_UKV = 8 * 64, I_BR = 16 * 64, I_OUT = 32 * 64;
    constexpr int PER_L = I_IN + I_UQ + 2 * I_UKV + 3 * I_BR + I_OUT;
    for (int it = gw; it < NL * PER_L; it += NGW) {
        const int l = it / PER_L; int r = it % PER_L;
        if (r < I_IN) { const int kb = r / 482, nb = r % 482, n0 = nb * 32; const int d0 = n0 < 1024 ? n0 : (n0 < 1088 ? Z_KR + (n0 - 1024) : n0 - 64);
            transpose_item(X.in[11] + (size_t)l * 2048 * INC, 2048, INC, kb * 64, n0, WSP(bf16_t, O_WIN) + ((size_t)l * ZW + d0) * 2048, nullptr, scr, lane); continue; }
        r -= I_IN;
        if (r < I_UQ) { const int kb = r / 48, nb = r % 48;
            transpose_item(X.in[14] + (size_t)l * 512 * 1536, 512, 1536, kb * 64, nb * 32, WSP(bf16_t, O_WUQ) + ((size_t)l * 1536 + nb * 32) * 512, X.in[12] + l * 512, scr, lane); continue; }
        r -= I_UQ;
        if (r < 2 * I_UKV) { const int gfold = r >= I_UKV; if (gfold) r -= I_UKV; const int kb = r / 64, nb = r % 64, n0 = nb * 32, hd = n0 >> 8, d = n0 & 255;
            bf16_t* dst = (d < 128 ? WSP(bf16_t, gfold ? O_WKG : O_WKP) : WSP(bf16_t, gfold ? O_WVG : O_WVP)) + ((size_t)l * 1024 + hd * 128 + (d & 127)) * 512;
            transpose_item(X.in[15] + (size_t)l * 512 * 2048, 512, 2048, kb * 64, n0, dst, gfold ? X.in[13] + l * 512 : nullptr, scr, lane); continue; }
        r -= 2 * I_UKV;
        if (r < 3 * I_BR) { const int br = r / I_BR; r %= I_BR; const int kb = r / 64, nb = r % 64;
            transpose_item(X.in[21 + br] + (size_t)l * 1024 * 2048, 1024, 2048, kb * 64, nb * 32, WSP(bf16_t, O_WBR) + (((size_t)l * 3 + br) * 2048 + nb * 32) * 1024, nullptr, scr, lane); continue; }
        r -= 3 * I_BR;
        { const int kb = r / 64, nb = r % 64;
            transpose_item(X.in[24] + (size_t)l * 2048 * 2048, 2048, 2048, kb * 64, nb * 32, WSP(bf16_t, O_WOUT) + ((size_t)l * 2048 + nb * 32) * 2048, nullptr, scr, lane); }
    }
    const int gt = X.c * NTHREADS + tid, NGT = X.G * NTHREADS;
    for (int i = gt; i < NL * 512 * 512 / 4; i += NGT) { const int e = i * 4, l = e / (512 * 512), rr = (e / 512) % 512, cidx = e % 512, b = rr >> 8, t = rr & 255;
        const f32x4 v = *(const f32x4*)(X.in[2] + (((size_t)b * NL + l) * 256 + t) * 512 + cidx);
        u32x2 w; w.x = cvt_pk(v[0], v[1]); w.y = cvt_pk(v[2], v[3]); *(u32x2*)(WSP(bf16_t, O_CKVC) + e) = w; }
    for (int i = gt; i < NL * 512 * 64 / 4; i += NGT) { const int e = i * 4, l = e / (512 * 64), rr = (e / 64) % 512, cidx = e % 64, b = rr >> 8, t = rr & 255;
        const f32x4 v = *(const f32x4*)(X.in[3] + (((size_t)b * NL + l) * 256 + t) * 64 + cidx);
        u32x2 w; w.x = cvt_pk(v[0], v[1]); w.y = cvt_pk(v[2], v[3]); *(u32x2*)(WSP(bf16_t, O_KRC) + e) = w; }
    for (int i = gt; i < 64 * 16; i += NGT) { const int p = i >> 4, f = i & 15; const float inv = powf(10000.f, -(float)f / 16.f); const float ang = (float)p * inv;
        WSP(float, O_ROPE)[2 * i] = cosf(ang); WSP(float, O_ROPE)[2 * i + 1] = sinf(ang); }
    for (int i = gt; i < 4 * T; i += NGT) WSP(float, O_RSS)[i] = 0.f;
    LAS float* sl = (LAS float*)(lds + 69632);
    LAS float* red = (LAS float*)(lds + 69632 + 24576);
    __syncthreads();
    for (int i = tid; i < 3 * 2048; i += NTHREADS) { const int cidx = i >> 11, k = i & 2047; const float v = cidx == 0 ? X.in[6][k] : X.in[5][(cidx - 1) * 2048 + k]; sl[i] = silu_f(v); }
    __syncthreads();
    for (int un = X.c; un < NL * 192; un += X.G) {
        const int l = un / 192, col0 = (un % 192) * 32, kg = tid >> 3, c4 = tid & 7;
        const float* wp = X.in[7] + (size_t)l * 2048 * 6144 + col0 + 4 * c4;
        f32x4 a0 = {0.f, 0.f, 0.f, 0.f}, a1 = a0, a2 = a0;
#pragma unroll 1
        for (int kb = 0; kb < 32; kb += 8) {
            f32x4 w[8];
#pragma unroll
            for (int q = 0; q < 8; ++q) w[q] = __builtin_nontemporal_load((const f32x4*)(wp + (size_t)(kg + 64 * (kb + q)) * 6144));
            __builtin_amdgcn_sched_barrier(0);
#pragma unroll
            for (int q = 0; q < 8; ++q) { const int k = kg + 64 * (kb + q); a0 += w[q] * sl[k]; a1 += w[q] * sl[2048 + k]; a2 += w[q] * sl[4096 + k]; }
        }
        LAS float* rp = red + (kg * 8 + c4) * 12;
#pragma unroll
        for (int j = 0; j < 4; ++j) { rp[j] = a0[j]; rp[4 + j] = a1[j]; rp[8 + j] = a2[j]; }
        __syncthreads();
        if (tid < 96) { const int cc = tid / 12, jj = tid % 12; float s = 0.f; for (int g = 0; g < 64; ++g) s += red[(g * 8 + cc) * 12 + jj];
            const int cidx = jj >> 2, col = col0 + 4 * cc + (jj & 3); WSP(float, O_MOD)[((size_t)l * 3 + cidx) * 6144 + col] = s + X.in[8][l * 6144 + col]; }
        __syncthreads();
    }
}

__device__ __forceinline__ void phase_rows(const Ctx& X, int l, bool upd, int ln) {
    const int tid = X.tid, lane = tid & 63, wave = tid >> 6;
    const float* mod = WSP(float, O_MOD);
    for (int row0 = (X.c * 8 + wave) * 2; row0 < T; row0 += X.G * 16) {
        f32x4 v[2][8];
#pragma unroll
        for (int rr = 0; rr < 2; ++rr) { const int row = row0 + rr;
            const float* xsrc = (upd && l > 0) || (!upd && ln > 0) ? WSP(float, O_X) + (size_t)row * DM : (row < 4096 ? X.in[0] + (size_t)row * DM : X.in[1] + (size_t)(row - 4096) * DM);
#pragma unroll
            for (int j = 0; j < 8; ++j) v[rr][j] = *(const f32x4*)(xsrc + j * 256 + lane * 4); }
        const int cidx = row0 < 4096 ? 0 : 1 + ((row0 - 4096) >> 11);
        if (upd) {
            const float* gate = mod + ((size_t)l * 3 + cidx) * 6144 + 4096; const float* gp = X.in[10] + l * 2048;
            f32x4 gg[8], y[8];
#pragma unroll
            for (int j = 0; j < 8; ++j) { const int c = j * 256 + lane * 4; gg[j] = *(const f32x4*)(gate + c); y[j] = *(const f32x4*)(gp + c); }
            const float ri0 = rsqrtf(WSP(float, O_RSS)[3 * T + row0] * (1.f / 2048.f) + EPSN), ri1 = rsqrtf(WSP(float, O_RSS)[3 * T + row0 + 1] * (1.f / 2048.f) + EPSN);
            __builtin_amdgcn_sched_barrier(0);
#pragma unroll
            for (int j = 0; j < 8; ++j) gg[j] = gg[j] * y[j];
#pragma unroll
            for (int rr = 0; rr < 2; ++rr) { const int row = row0 + rr; const float ri = rr ? ri1 : ri0; const float* yp = WSP(float, O_Y) + (size_t)row * DM;
#pragma unroll
                for (int j = 0; j < 8; ++j) y[j] = *(const f32x4*)(yp + j * 256 + lane * 4);
                __builtin_amdgcn_sched_barrier(0);
                float* xdst = (l == NL - 1) ? X.out + (row < 4096 ? OUT_YP + (size_t)row * DM : OUT_YS + (size_t)(row - 4096) * DM) : WSP(float, O_X) + (size_t)row * DM;
#pragma unroll
                for (int j = 0; j < 8; ++j) { v[rr][j] += gg[j] * (y[j] * ri); *(f32x4*)(xdst + j * 256 + lane * 4) = v[rr][j]; }
                __builtin_amdgcn_sched_barrier(0); }
        }
        __builtin_amdgcn_sched_barrier(0);
        if (ln < NL) {
            const float* sh = mod + ((size_t)ln * 3 + cidx) * 6144; const float* sc = sh + 2048; const float* gp = X.in[9] + ln * 2048;
            f32x4 s[8], b[8], g[8];
#pragma unroll
            for (int j = 0; j < 8; ++j) { const int c = j * 256 + lane * 4; s[j] = *(const f32x4*)(sc + c); b[j] = *(const f32x4*)(sh + c); g[j] = *(const f32x4*)(gp + c); }
            float ss0 = 0.f, ss1 = 0.f;
#pragma unroll
            for (int j = 0; j < 8; ++j) { ss0 += v[0][j][0] * v[0][j][0] + v[0][j][1] * v[0][j][1] + v[0][j][2] * v[0][j][2] + v[0][j][3] * v[0][j][3];
                ss1 += v[1][j][0] * v[1][j][0] + v[1][j][1] * v[1][j][1] + v[1][j][2] * v[1][j][2] + v[1][j][3] * v[1][j][3]; }
            ss0 = wave_sum(ss0); ss1 = wave_sum(ss1); const float ri0 = rsqrtf(ss0 * (1.f / 2048.f) + EPSN), ri1 = rsqrtf(ss1 * (1.f / 2048.f) + EPSN);
            __builtin_amdgcn_sched_barrier(0);
            bf16_t* hp = WSP(bf16_t, O_H) + (size_t)row0 * DM;
#pragma unroll
            for (int j = 0; j < 8; ++j) { const int c = j * 256 + lane * 4;
                const f32x4 gs = g[j] * (s[j] + 1.f);
                const f32x4 h0 = v[0][j] * ri0 * gs + b[j], h1 = v[1][j] * ri1 * gs + b[j];
                u32x2 w; w.x = cvt_pk(h0[0], h0[1]); w.y = cvt_pk(h0[2], h0[3]); *(u32x2*)(hp + c) = w;
                w.x = cvt_pk(h1[0], h1[1]); w.y = cvt_pk(h1[2], h1[3]); *(u32x2*)(hp + DM + c) = w; }
        }
    }
}

__device__ __forceinline__ void phase_misc(const Ctx& X, int l) {
    const int tid = X.tid, lane = tid & 63, wave = tid >> 6;
    const bf16_t* z = WSP(bf16_t, O_Z);
    for (int row = X.c * 8 + wave; row < 4096; row += X.G * 8) {
        const bf16_t* zr = z + (size_t)row * ZW;
        const int b = row >> 8, t = row & 255;
        const float ri = rsqrtf(WSP(float, O_RSS)[T + row] * (1.f / 512.f) + EPSN);
        const u32x4 w = *(const u32x4*)(zr + Z_CKV + lane * 8); const float* g = X.in[13] + l * 512 + lane * 8;
        const f32x4 g0 = *(const f32x4*)g, g1 = *(const f32x4*)(g + 4);
        float* o = X.out + OUT_CKV + (((size_t)b * NL + l) * 256 + t) * 512 + lane * 8;
        f32x4 o0, o1; o0[0] = bflo(w.x) * ri * g0[0]; o0[1] = bfhi(w.x) * ri * g0[1]; o0[2] = bflo(w.y) * ri * g0[2]; o0[3] = bfhi(w.y) * ri * g0[3];
        o1[0] = bflo(w.z) * ri * g1[0]; o1[1] = bfhi(w.z) * ri * g1[1]; o1[2] = bflo(w.w) * ri * g1[2]; o1[3] = bfhi(w.w) * ri * g1[3];
        *(f32x4*)o = o0; *(f32x4*)(o + 4) = o1;
    }
}
__device__ __forceinline__ void phase_krope(const Ctx& X, int l) {
    const int tid = X.tid, lane = tid & 63, wave = tid >> 6;
    const bf16_t* z = WSP(bf16_t, O_Z); const float* rope = WSP(float, O_ROPE);
    for (int row = X.c * 8 + wave; row < T; row += X.G * 8) {
        float kr = bf2f(z[(size_t)row * ZW + Z_KR + lane]);
        if (row < 4096) { const int b = row >> 8, t = row & 255; X.out[OUT_KR + (((size_t)b * NL + l) * 256 + t) * 64 + lane] = kr; }
        else {
            const int t = (row - 4096) & 2047; const int p = lane < 32 ? (t >> 6) : (t & 63); const int f = lane & 15;
            const float cs = rope[(p * 16 + f) * 2], sn = rope[(p * 16 + f) * 2 + 1];
            const float pr = __shfl_xor(kr, 16);
            kr = (lane & 16) ? kr * cs + pr * sn : kr * cs - pr * sn;
        }
        const float nb = __shfl_down(kr, 1);
        if ((lane & 1) == 0) *(unsigned*)(WSP(bf16_t, O_KR) + (size_t)row * 64 + lane) = cvt_pk(kr, nb);
    }
}
constexpr int PB = 272;
constexpr int BUFB = 128 * PB;
constexpr int PO = 132;
__device__ __forceinline__ void mma128(const LAS unsigned char* As, const LAS unsigned char* Bs, f32x16 (&acc)[2], int wr, int wc, int lane) {
    const int r32 = lane & 31, hi = lane >> 5;
    const LAS unsigned char* ap = As + (32 * wr + r32) * PB + hi * 16;
    const LAS unsigned char* bp = Bs + (64 * wc + r32) * PB + hi * 16;
#pragma unroll 2
    for (int s = 0; s < 8; ++s) {
        const bf16x8 a = *(const LAS bf16x8*)(ap + s * 32);
        const bf16x8 b0 = *(const LAS bf16x8*)(bp + s * 32);
        const bf16x8 b1 = *(const LAS bf16x8*)(bp + 32 * PB + s * 32);
        acc[0] = __builtin_amdgcn_mfma_f32_32x32x16_bf16(a, b0, acc[0], 0, 0, 0);
        acc[1] = __builtin_amdgcn_mfma_f32_32x32x16_bf16(a, b1, acc[1], 0, 0, 0);
    }
}
__device__ __forceinline__ int crow(int r, int hi) { return (r & 3) + 8 * (r >> 2) + 4 * hi; }
__device__ __forceinline__ void stage_tile(LAS unsigned char* dst, const bf16_t* src, size_t ld, int tid) {
#pragma unroll
    for (int i = 0; i < 4; ++i) { const int c = tid + i * NTHREADS, r = c >> 4, ch = c & 15;
        *(LAS u32x4*)(dst + r * PB + ch * 16) = __builtin_nontemporal_load((const u32x4*)(src + (size_t)r * ld + ch * 8)); }
}
__device__ __forceinline__ float log_sigmoid_f(float x) { return -log1pf(expf(-x)); }

__device__ __forceinline__ void sgu_item(const Ctx& X, LAS unsigned char* lds, int l, int item) {
    int tid_ = X.tid; asm volatile("" : "+v"(tid_));
    const int tid = tid_, lane = tid & 63, wave = tid >> 6, wr = wave >> 1, wc = wave & 1;
    const int n = item >> 3, g = item & 7, tok0 = n * 128;
    LAS unsigned char* As = lds; LAS unsigned char* Bs = lds + BUFB; LAS float* Os = (LAS float*)(lds + 2 * BUFB);
    const float* ws = X.in[17] + ((size_t)l * 8 + g) * 16384; const float* rss = WSP(float, O_RSS) + 2 * T + tok0;
    { f32x4 w0[4], w1[4], s0[4], s1[4];
#pragma unroll
      for (int i = 0; i < 4; ++i) { const int c = tid + i * NTHREADS, r = c >> 4, ch = c & 15;
          w0[i] = *(const f32x4*)(ws + r * 128 + ch * 8); w1[i] = *(const f32x4*)(ws + r * 128 + ch * 8 + 4); s0[i] = *(const f32x4*)(rss + ch * 8); s1[i] = *(const f32x4*)(rss + ch * 8 + 4); }
      __builtin_amdgcn_sched_barrier(0);
#pragma unroll
      for (int i = 0; i < 4; ++i) { const int c = tid + i * NTHREADS, r = c >> 4, ch = c & 15;
          u32x4 o; o.x = cvt_pk(w0[i][0] * rsqrtf(s0[i][0] * (1.f / 1024.f) + EPSN), w0[i][1] * rsqrtf(s0[i][1] * (1.f / 1024.f) + EPSN));
          o.y = cvt_pk(w0[i][2] * rsqrtf(s0[i][2] * (1.f / 1024.f) + EPSN), w0[i][3] * rsqrtf(s0[i][3] * (1.f / 1024.f) + EPSN));
          o.z = cvt_pk(w1[i][0] * rsqrtf(s1[i][0] * (1.f / 1024.f) + EPSN), w1[i][1] * rsqrtf(s1[i][1] * (1.f / 1024.f) + EPSN));
          o.w = cvt_pk(w1[i][2] * rsqrtf(s1[i][2] * (1.f / 1024.f) + EPSN), w1[i][3] * rsqrtf(s1[i][3] * (1.f / 1024.f) + EPSN));
          *(LAS u32x4*)(As + r * PB + ch * 16) = o; } }
    stage_tile(Bs, WSP(bf16_t, O_VST) + (size_t)(g * 128) * T + tok0, T, tid);
    const int p = tid >> 2, cseg = (tid & 3) * 32; const bf16_t* zr = WSP(bf16_t, O_Z) + (size_t)(tok0 + p) * ZW;
    u32x4 uu4[4], gg4[4]; f32x4 gs4[8];
#pragma unroll
    for (int i = 0; i < 4; ++i) { uu4[i] = *(const u32x4*)(zr + Z_U + g * 128 + cseg + i * 8); gg4[i] = *(const u32x4*)(zr + Z_GPS + g * 128 + cseg + i * 8); }
#pragma unroll
    for (int i = 0; i < 8; ++i) gs4[i] = *(const f32x4*)(X.in[16] + l * 1024 + g * 128 + cseg + i * 4);
    const float bs = X.in[18][((size_t)l * 128 + p) * 8 + g];
    __syncthreads();
    f32x16 acc[2]; acc[0] = (f32x16)(0.f); acc[1] = (f32x16)(0.f);
    mma128(As, Bs, acc, wr, wc, lane);
    { const int hi = lane >> 5, cb = 64 * wc + (lane & 31);
#pragma unroll
      for (int t = 0; t < 2; ++t)
#pragma unroll
        for (int r = 0; r < 16; ++r) Os[(32 * wr + crow(r, hi)) * PO + cb + 32 * t] = acc[t][r]; }
    __syncthreads();
    {
      bf16_t* op = WSP(bf16_t, O_AS) + (size_t)(tok0 + p) * 1024 + g * 128 + cseg;
#pragma unroll
      for (int i = 0; i < 4; ++i) {
          const u32x4 uu = uu4[i], gg = gg4[i];
          const f32x4 s0 = *(const LAS f32x4*)(Os + p * PO + cseg + i * 8), s1 = *(const LAS f32x4*)(Os + p * PO + cseg + i * 8 + 4);
          const f32x4 g0 = gs4[2 * i], g1 = gs4[2 * i + 1];
          u32x4 o; o.x = cvt_pk((s0[0] * g0[0] + bs) * bflo(uu.x) * bflo(gg.x), (s0[1] * g0[1] + bs) * bfhi(uu.x) * bfhi(gg.x));
          o.y = cvt_pk((s0[2] * g0[2] + bs) * bflo(uu.y) * bflo(gg.y), (s0[3] * g0[3] + bs) * bfhi(uu.y) * bfhi(gg.y));
          o.z = cvt_pk((s1[0] * g1[0] + bs) * bflo(uu.z) * bflo(gg.z), (s1[1] * g1[1] + bs) * bfhi(uu.z) * bfhi(gg.z));
          o.w = cvt_pk((s1[2] * g1[2] + bs) * bflo(uu.w) * bflo(gg.w), (s1[3] * g1[3] + bs) * bfhi(uu.w) * bfhi(gg.w));
          *(u32x4*)(op + i * 8) = o; } }
    __syncthreads();
}

__device__ __forceinline__ void retstate_item(const Ctx& X, LAS unsigned char* lds, int l, int item) {
    int tid_ = X.tid; asm volatile("" : "+v"(tid_));
    const int tid = tid_, lane = tid & 63, wave = tid >> 6, wr = wave >> 1, wc = wave & 1;
    const int n = item >> 3, hd = item & 7, tok0 = n * 128;
    LAS unsigned char* As = lds; LAS unsigned char* Bf = lds + BUFB; LAS unsigned char* Bb = lds + 2 * BUFB;
    const float lgf = log_sigmoid_f(X.in[19][(l * 2 + 0) * 8 + hd]) * 1.4426950408889634f, lgb = log_sigmoid_f(X.in[19][(l * 2 + 1) * 8 + hd]) * 1.4426950408889634f;
    stage_tile(As, WSP(bf16_t, O_RVT) + (size_t)(hd * 128) * T + tok0, T, tid);
    { const bf16_t* kz = WSP(bf16_t, O_Z) + (size_t)tok0 * ZW + Z_RK + hd * 128;
      const int j0 = 2 * lane;
      const float wf0 = exp2f(lgf * (float)(127 - j0)), wf1 = exp2f(lgf * (float)(126 - j0)), wb0 = exp2f(lgb * (float)j0), wb1 = exp2f(lgb * (float)(j0 + 1));
      u32x4 wa[2], wb[2];
#pragma unroll
      for (int i = 0; i < 2; ++i) { const int d0 = (wave * 2 + i) * 8; wa[i] = *(const u32x4*)(kz + (size_t)j0 * ZW + d0); wb[i] = *(const u32x4*)(kz + (size_t)(j0 + 1) * ZW + d0); }
#pragma unroll
      for (int i = 0; i < 2; ++i) { const int d0 = (wave * 2 + i) * 8;
          const float ka[8] = {bflo(wa[i].x), bfhi(wa[i].x), bflo(wa[i].y), bfhi(wa[i].y), bflo(wa[i].z), bfhi(wa[i].z), bflo(wa[i].w), bfhi(wa[i].w)};
          const float kb[8] = {bflo(wb[i].x), bfhi(wb[i].x), bflo(wb[i].y), bfhi(wb[i].y), bflo(wb[i].z), bfhi(wb[i].z), bflo(wb[i].w), bfhi(wb[i].w)};
#pragma unroll
          for (int e = 0; e < 8; ++e) { *(LAS unsigned*)(Bf + (d0 + e) * PB + j0 * 2) = cvt_pk(ka[e] * wf0, kb[e] * wf1); *(LAS unsigned*)(Bb + (d0 + e) * PB + j0 * 2) = cvt_pk(ka[e] * wb0, kb[e] * wb1); } } }
    __syncthreads();
    f32x16 af[2], ab[2]; af[0] = (f32x16)(0.f); af[1] = (f32x16)(0.f); ab[0] = (f32x16)(0.f); ab[1] = (f32x16)(0.f);
    mma128(As, Bf, af, wr, wc, lane); mma128(As, Bb, ab, wr, wc, lane);
    float* st = WSP(float, O_ST) + ((size_t)(n * 8 + hd) * 2) * 16384;
    { const int hi = lane >> 5, cb = 64 * wc + (lane & 31);
#pragma unroll
      for (int t = 0; t < 2; ++t)
#pragma unroll
        for (int r = 0; r < 16; ++r) { const int e = 32 * wr + crow(r, hi); st[e * 128 + cb + 32 * t] = af[t][r]; st[16384 + e * 128 + cb + 32 * t] = ab[t][r]; } }
    __syncthreads();
}

__device__ __forceinline__ void retout_item(const Ctx& X, LAS unsigned char* lds, int l, int item) {
    int tid_ = X.tid; asm volatile("" : "+v"(tid_));
    const int tid = tid_, lane = tid & 63, wave = tid >> 6, wr = wave >> 1, wc = wave & 1;
    const int n = item >> 3, hd = item & 7, tok0 = n * 128;
    LAS unsigned char* B0 = lds; LAS unsigned char* B1 = lds + BUFB; LAS unsigned char* B2 = lds + 2 * BUFB; LAS unsigned char* B3 = lds + 3 * BUFB;
    LAS unsigned char* B4 = lds + 4 * BUFB;
    const float lgf = log_sigmoid_f(X.in[19][(l * 2 + 0) * 8 + hd]) * 1.4426950408889634f, lgb = log_sigmoid_f(X.in[19][(l * 2 + 1) * 8 + hd]) * 1.4426950408889634f;
    const bf16_t* z = WSP(bf16_t, O_Z); const bf16_t* pf = WSP(bf16_t, O_PF) + (size_t)(n * 8 + hd) * 2 * 16384;
    (void)B4;
    stage_tile(B0, z + (size_t)tok0 * ZW + Z_RQ + hd * 128, ZW, tid);
    stage_tile(B1, z + (size_t)tok0 * ZW + Z_RK + hd * 128, ZW, tid);
    stage_tile(B3, WSP(bf16_t, O_RVT) + (size_t)(hd * 128) * T + tok0, T, tid);
    u32x4 pfr[2][4];
#pragma unroll
    for (int d = 0; d < 2; ++d)
#pragma unroll
        for (int i = 0; i < 4; ++i) { const int c = tid + i * NTHREADS; pfr[d][i] = *(const u32x4*)(pf + d * 16384 + (size_t)(c >> 4) * 128 + (c & 15) * 8); }
    const int p_ = tid >> 2, cseg_ = (tid & 3) * 32;
    u32x4 gpr[4]; f32x4 grr[8];
#pragma unroll
    for (int q = 0; q < 4; ++q) gpr[q] = *(const u32x4*)(z + (size_t)(tok0 + p_) * ZW + Z_GPR + hd * 128 + cseg_ + q * 8);
#pragma unroll
    for (int q = 0; q < 8; ++q) grr[q] = *(const f32x4*)(X.in[20] + l * 1024 + hd * 128 + cseg_ + q * 4);
    __syncthreads();
    const int hi = lane >> 5, cb = 64 * wc + (lane & 31);
    { f32x16 aw[2]; aw[0] = (f32x16)(0.f); aw[1] = (f32x16)(0.f);
      mma128(B0, B1, aw, wr, wc, lane);
#pragma unroll
      for (int t = 0; t < 2; ++t)
#pragma unroll
        for (int r = 0; r < 16; ++r) { const int i = 32 * wr + crow(r, hi), j = cb + 32 * t; const float dd = (float)(i - j);
            const float dec = (i >= j) ? __builtin_amdgcn_exp2f(lgf * dd) : __builtin_amdgcn_exp2f(-lgb * dd);
            *(LAS bf16_t*)(B2 + i * PB + j * 2) = (bf16_t)(cvt_pk(aw[t][r] * dec, 0.f) & 0xffffu); } }
    __syncthreads();
#pragma unroll
    for (int i = 0; i < 4; ++i) { const int c = tid + i * NTHREADS; *(LAS u32x4*)(B1 + (c >> 4) * PB + (c & 15) * 16) = pfr[0][i]; }
    f32x16 ao[2]; ao[0] = (f32x16)(0.f); ao[1] = (f32x16)(0.f);
    mma128(B2, B3, ao, wr, wc, lane);
    __syncthreads();
#pragma unroll
    for (int i = 0; i < 4; ++i) { const int c = tid + i * NTHREADS; *(LAS u32x4*)(B3 + (c >> 4) * PB + (c & 15) * 16) = pfr[1][i]; }
    f32x16 ac[2]; ac[0] = (f32x16)(0.f); ac[1] = (f32x16)(0.f);
    mma128(B0, B1, ac, wr, wc, lane);
#pragma unroll
    for (int t = 0; t < 2; ++t)
#pragma unroll
        for (int r = 0; r < 16; ++r) { const int i = 32 * wr + crow(r, hi); ao[t][r] += ac[t][r] * __builtin_amdgcn_exp2f(lgf * (float)(i + 1)); }
    __syncthreads();
    ac[0] = (f32x16)(0.f); ac[1] = (f32x16)(0.f);
    mma128(B0, B3, ac, wr, wc, lane);
    LAS float* Os = (LAS float*)(lds + BUFB);
#pragma unroll
    for (int t = 0; t < 2; ++t)
#pragma unroll
        for (int r = 0; r < 16; ++r) { const int i = 32 * wr + crow(r, hi); Os[i * PO + cb + 32 * t] = ao[t][r] + ac[t][r] * __builtin_amdgcn_exp2f(lgb * (float)(128 - i)); }
    __syncthreads();
    { const int p = tid >> 2, cseg = (tid & 3) * 32; f32x4 v[8]; float s = 0.f;
#pragma unroll
      for (int q = 0; q < 8; ++q) { v[q] = *(const LAS f32x4*)(Os + p * PO + cseg + q * 4); s += v[q][0] + v[q][1] + v[q][2] + v[q][3]; }
      s += __shfl_xor(s, 1); s += __shfl_xor(s, 2); const float mu = s * (1.f / 128.f); float s2 = 0.f;
#pragma unroll
      for (int q = 0; q < 8; ++q) { v[q] = v[q] - mu; s2 += v[q][0] * v[q][0] + v[q][1] * v[q][1] + v[q][2] * v[q][2] + v[q][3] * v[q][3]; }
      s2 += __shfl_xor(s2, 1); s2 += __shfl_xor(s2, 2); const float rs = rsqrtf(s2 * (1.f / 128.f) + EPSN);

      bf16_t* op = WSP(bf16_t, O_AR) + (size_t)(tok0 + p) * 1024 + hd * 128 + cseg;
#pragma unroll
      for (int q = 0; q < 4; ++q) { const u32x4 gg = gpr[q]; const f32x4 g0 = grr[2 * q], g1 = grr[2 * q + 1]; const f32x4 a = v[2 * q] * rs * g0, b = v[2 * q + 1] * rs * g1;
          u32x4 o; o.x = cvt_pk(a[0] * bflo(gg.x), a[1] * bfhi(gg.x)); o.y = cvt_pk(a[2] * bflo(gg.y), a[3] * bfhi(gg.y)); o.z = cvt_pk(b[0] * bflo(gg.z), b[1] * bfhi(gg.z)); o.w = cvt_pk(b[2] * bflo(gg.w), b[3] * bfhi(gg.w));
          *(u32x4*)(op + q * 8) = o; } }
    __syncthreads();
}

__device__ __forceinline__ void phase_prefix(const Ctx& X, int l) {
    const int tid = X.tid;
    const float* stb = WSP(float, O_ST); bf16_t* pf = WSP(bf16_t, O_PF);
    for (int it = X.c; it < 256; it += X.G) {
        const int chain = it >> 3, sl = it & 7, b = chain >> 4, hd = (chain >> 1) & 7, dir = chain & 1;
        const int e = sl * 16 + (tid >> 5), d4 = (tid & 31) * 4, n0 = 32 + b * 16;
        const float gc = exp2f(128.f * 1.4426950408889634f * log_sigmoid_f(X.in[19][(l * 2 + dir) * 8 + hd]));
        f32x4 S[16];
#pragma unroll
        for (int j = 0; j < 16; ++j) S[j] = *(const f32x4*)(stb + ((size_t)((n0 + j) * 8 + hd) * 2 + dir) * 16384 + e * 128 + d4);
        const float* s0 = X.in[4] + ((((size_t)b * NL + l) * 2 + dir) * 8 + hd) * 16384;
        f32x4 R; R[0] = s0[(size_t)(d4 + 0) * 128 + e]; R[1] = s0[(size_t)(d4 + 1) * 128 + e]; R[2] = s0[(size_t)(d4 + 2) * 128 + e]; R[3] = s0[(size_t)(d4 + 3) * 128 + e];
#pragma unroll
        for (int jj = 0; jj < 16; ++jj) { const int j = dir ? 15 - jj : jj;
            u32x2 o; o.x = cvt_pk(R[0], R[1]); o.y = cvt_pk(R[2], R[3]);
            *(u32x2*)(pf + ((size_t)((n0 + j) * 8 + hd) * 2 + dir) * 16384 + e * 128 + d4) = o;
            R = R * gc + S[j]; }
    }
    for (int it = X.c; it < 256; it += X.G) {
        const int s = it >> 4, hd = (it >> 1) & 7, dir = it & 1, n0 = s * 2;
        const float gc = exp2f(128.f * 1.4426950408889634f * log_sigmoid_f(X.in[19][(l * 2 + dir) * 8 + hd]));
        float* o = X.out + OUT_RET + ((((size_t)s * NL + l) * 2 + dir) * 8 + hd) * 16384;
        const int nfirst = dir ? n0 + 1 : n0, nsecond = dir ? n0 : n0 + 1;
#pragma unroll
        for (int k = 0; k < 8; ++k) { const int idx = (k * NTHREADS + tid) * 4, e = idx >> 7, d4 = idx & 127;
            const f32x4 Sa = *(const f32x4*)(stb + ((size_t)(nfirst * 8 + hd) * 2 + dir) * 16384 + idx), Sb = *(const f32x4*)(stb + ((size_t)(nsecond * 8 + hd) * 2 + dir) * 16384 + idx);
            u32x2 z0; z0.x = 0u; z0.y = 0u; u32x2 w; w.x = cvt_pk(Sa[0], Sa[1]); w.y = cvt_pk(Sa[2], Sa[3]);
            *(u32x2*)(pf + ((size_t)(nfirst * 8 + hd) * 2 + dir) * 16384 + idx) = z0;
            *(u32x2*)(pf + ((size_t)(nsecond * 8 + hd) * 2 + dir) * 16384 + idx) = w;
            const f32x4 f = Sa * gc + Sb;
            o[(size_t)(d4 + 0) * 128 + e] = f[0]; o[(size_t)(d4 + 1) * 128 + e] = f[1]; o[(size_t)(d4 + 2) * 128 + e] = f[2]; o[(size_t)(d4 + 3) * 128 + e] = f[3]; }
    }
}
constexpr int KPB = 400;
constexpr int VPB = 272;
constexpr int ATT_KB = 128 * KPB;
__device__ __forceinline__ float xmax16(float x) { const unsigned u = __float_as_uint(x); auto r = __builtin_amdgcn_permlane16_swap(u, u, false, false); return fmaxf(__uint_as_float(r[0]), __uint_as_float(r[1])); }
__device__ __forceinline__ float xmax32(float x) { const unsigned u = __float_as_uint(x); auto r = __builtin_amdgcn_permlane32_swap(u, u, false, false); return fmaxf(__uint_as_float(r[0]), __uint_as_float(r[1])); }
__device__ __forceinline__ float xsum16(float x) { const unsigned u = __float_as_uint(x); auto r = __builtin_amdgcn_permlane16_swap(u, u, false, false); return __uint_as_float(r[0]) + __uint_as_float(r[1]); }
__device__ __forceinline__ float xsum32(float x) { const unsigned u = __float_as_uint(x); auto r = __builtin_amdgcn_permlane32_swap(u, u, false, false); return __uint_as_float(r[0]) + __uint_as_float(r[1]); }
__device__ __forceinline__ void attn_unit(const Ctx& X, LAS unsigned char* lds, int l, int unit) {
    int tid_ = X.tid; asm volatile("" : "+v"(tid_));
    const int tid = tid_, lane = tid & 63, wave = tid >> 6, qi = lane & 15, g = lane >> 4;
    const int rbw = wave & 3, kh = wave >> 2;
    int tokb, ncache, nnew, hd, qb, bc = 0;
    if (unit < 256) { bc = unit >> 7; hd = (unit >> 4) & 7; qb = unit & 15; tokb = 4096 + bc * 2048; ncache = 256; nnew = 2048; }
    else { const int r = unit - 256; const int s = r >> 4; hd = (r >> 1) & 7; qb = r & 1; tokb = s * 256; ncache = 0; nnew = 256; }
    const int nct = ncache >> 7, ntile = (ncache + nnew) >> 7;
    const bf16_t* KN = WSP(bf16_t, O_KN); const bf16_t* KR = WSP(bf16_t, O_KR); const bf16_t* VT = WSP(bf16_t, O_VT);
    const bf16_t* KC = WSP(bf16_t, O_KC) + (size_t)l * 512 * 1024; const bf16_t* KRC = WSP(bf16_t, O_KRC) + (size_t)l * 512 * 64; const bf16_t* VTC = WSP(bf16_t, O_VTC) + (size_t)l * 1024 * 512;
    const int tokq = tokb + qb * 128 + rbw * 32 + qi;
    LAS unsigned char* qb_l = lds + ATT_KB + 128 * VPB;
    const LAS unsigned char* qbase = qb_l + (32 * rbw + qi) * KPB + 16 * g;
    LAS unsigned char* kb = lds; LAS unsigned char* vb = lds + ATT_KB;
    u32x4 sk[4], sr[2], sv[4];
#define ATT_LOAD(j) do { const int _j = (j); const bf16_t *kn_, *kr_, *vt_; size_t ldv_; \
        if (_j < nct) { const int r0 = bc * 256 + _j * 128; kn_ = KC + (size_t)r0 * 1024 + hd * 128; kr_ = KRC + (size_t)r0 * 64; vt_ = VTC + (size_t)(hd * 128) * 512 + r0; ldv_ = 512; } \
        else { const int r0 = tokb + (_j - nct) * 128; kn_ = KN + (size_t)r0 * 1024 + hd * 128; kr_ = KR + (size_t)r0 * 64; vt_ = VT + (size_t)(hd * 128) * T + r0; ldv_ = T; } \
        _Pragma("unroll") for (int i = 0; i < 4; ++i) { const int c = tid + i * NTHREADS; sk[i] = *(const u32x4*)(kn_ + (size_t)(c >> 4) * 1024 + (c & 15) * 8); sv[i] = *(const u32x4*)(vt_ + (size_t)(c >> 4) * ldv_ + (c & 15) * 8); } \
        _Pragma("unroll") for (int i = 0; i < 2; ++i) { const int c = tid + i * NTHREADS; sr[i] = *(const u32x4*)(kr_ + (size_t)(c >> 3) * 64 + (c & 7) * 8); } } while (0)
#define ATT_STORE() do { \
        _Pragma("unroll") for (int i = 0; i < 4; ++i) { const int c = tid + i * NTHREADS; *(LAS u32x4*)(kb + (c >> 4) * KPB + (c & 15) * 16) = sk[i]; *(LAS u32x4*)(vb + (c >> 4) * VPB + (c & 15) * 16) = sv[i]; } \
        _Pragma("unroll") for (int i = 0; i < 2; ++i) { const int c = tid + i * NTHREADS; *(LAS u32x4*)(kb + (c >> 3) * KPB + 256 + (c & 7) * 16) = sr[i]; } } while (0)
    f32x4 O[2][8];
#pragma unroll
    for (int rb = 0; rb < 2; ++rb)
#pragma unroll
        for (int u = 0; u < 8; ++u) O[rb][u] = (f32x4){0.f, 0.f, 0.f, 0.f};
    float mrun[2] = {-INFINITY, -INFINITY}, lrun[2] = {0.f, 0.f};
    const LAS unsigned char* kbase = kb + (64 * kh + qi) * KPB + 16 * g;
    const LAS unsigned char* vbase = vb + qi * VPB + (64 * kh + 4 * g) * 2;
    ATT_LOAD(0);
    u32x4 qst[6];
    { const bf16_t* qp = WSP(bf16_t, O_Q) + (size_t)(tokb + qb * 128) * 1536 + hd * 192;
#pragma unroll
      for (int i = 0; i < 6; ++i) { const int c = tid + i * NTHREADS, r = c / 24, ch = c % 24; qst[i] = *(const u32x4*)(qp + (size_t)r * 1536 + ch * 8); } }
#pragma unroll
    for (int i = 0; i < 6; ++i) { const int c = tid + i * NTHREADS, r = c / 24, ch = c % 24; *(LAS u32x4*)(qb_l + r * KPB + ch * 16) = qst[i]; }
    ATT_STORE();
    __syncthreads();
    for (int j = 0; j < ntile; ++j) {
        if (j + 1 < ntile) ATT_LOAD(j + 1);
        f32x4 S[2][4];
#pragma unroll
        for (int t = 0; t < 4; ++t) { S[0][t] = (f32x4){0.f, 0.f, 0.f, 0.f}; S[1][t] = (f32x4){0.f, 0.f, 0.f, 0.f}; }
#pragma unroll
        for (int s = 0; s < 6; ++s) { const bf16x8 q0 = *(const LAS bf16x8*)(qbase + 64 * s), q1 = *(const LAS bf16x8*)(qbase + 16 * KPB + 64 * s);
#pragma unroll
            for (int t = 0; t < 4; ++t) { const bf16x8 a = *(const LAS bf16x8*)(kbase + 16 * t * KPB + 64 * s);
                S[0][t] = __builtin_amdgcn_mfma_f32_16x16x32_bf16(a, q0, S[0][t], 0, 0, 0);
                S[1][t] = __builtin_amdgcn_mfma_f32_16x16x32_bf16(a, q1, S[1][t], 0, 0, 0); } }
        bf16x8 pb[2][2];
#pragma unroll
        for (int rb = 0; rb < 2; ++rb) {
            float mx = S[rb][0][0];
#pragma unroll
            for (int t = 0; t < 4; ++t)
#pragma unroll
                for (int i = 0; i < 4; ++i) mx = fmaxf(mx, S[rb][t][i]);
            if (!__all(mx - mrun[rb] <= 11.f)) { mx = xmax32(xmax16(mx)); const float mnew_ = fmaxf(mrun[rb], mx), alpha = __builtin_amdgcn_exp2f(mrun[rb] - mnew_); mrun[rb] = mnew_; lrun[rb] *= alpha;
#pragma unroll
                for (int u = 0; u < 8; ++u) O[rb][u] = O[rb][u] * alpha; }
            const float mnew = mrun[rb];
            float ps = 0.f;
#pragma unroll
            for (int t = 0; t < 4; ++t)
#pragma unroll
                for (int i = 0; i < 4; ++i) { S[rb][t][i] = __builtin_amdgcn_exp2f(S[rb][t][i] - mnew); ps += S[rb][t][i]; }
            lrun[rb] += ps;
#pragma unroll
            for (int c = 0; c < 2; ++c) { u32x4 pw; pw.x = cvt_pk(S[rb][2 * c][0], S[rb][2 * c][1]); pw.y = cvt_pk(S[rb][2 * c][2], S[rb][2 * c][3]); pw.z = cvt_pk(S[rb][2 * c + 1][0], S[rb][2 * c + 1][1]); pw.w = cvt_pk(S[rb][2 * c + 1][2], S[rb][2 * c + 1][3]);
                pb[rb][c] = __builtin_bit_cast(bf16x8, pw); }
        }
#pragma unroll
        for (int c = 0; c < 2; ++c)
#pragma unroll
            for (int u = 0; u < 8; ++u) { const LAS unsigned char* vp = vbase + 16 * u * VPB + 64 * c;
                const u32x2 lo = *(const LAS u32x2*)vp, hi2 = *(const LAS u32x2*)(vp + 32);
                u32x4 aw; aw.x = lo.x; aw.y = lo.y; aw.z = hi2.x; aw.w = hi2.y; const bf16x8 av = __builtin_bit_cast(bf16x8, aw);
                O[0][u] = __builtin_amdgcn_mfma_f32_16x16x32_bf16(av, pb[0][c], O[0][u], 0, 0, 0);
                O[1][u] = __builtin_amdgcn_mfma_f32_16x16x32_bf16(av, pb[1][c], O[1][u], 0, 0, 0); }
        __syncthreads();
        if (j + 1 < ntile) { ATT_STORE(); __syncthreads(); }
    }
    lrun[0] = xsum32(xsum16(lrun[0])); lrun[1] = xsum32(xsum16(lrun[1]));
    LAS float* xch = (LAS float*)lds + (size_t)rbw * 68 * 64 + lane;
    if (kh == 1) {
#pragma unroll
        for (int rb = 0; rb < 2; ++rb) {
#pragma unroll
            for (int u = 0; u < 8; ++u)
#pragma unroll
                for (int i = 0; i < 4; ++i) xch[(rb * 34 + u * 4 + i) * 64] = O[rb][u][i];
            xch[(rb * 34 + 32) * 64] = mrun[rb]; xch[(rb * 34 + 33) * 64] = lrun[rb]; }
    }
    __syncthreads();
    if (kh == 0) {
#pragma unroll
        for (int rb = 0; rb < 2; ++rb) {
            const float m1 = xch[(rb * 34 + 32) * 64], l1 = xch[(rb * 34 + 33) * 64];
            const float m = fmaxf(mrun[rb], m1), a0 = __builtin_amdgcn_exp2f(mrun[rb] - m), a1 = __builtin_amdgcn_exp2f(m1 - m);
            const float il = 1.f / (lrun[rb] * a0 + l1 * a1);
            const int tq = tokq + 16 * rb;
            const bf16_t* gp = WSP(bf16_t, O_Z) + (size_t)tq * ZW + Z_GPM + hd * 128 + 4 * g; bf16_t* op = WSP(bf16_t, O_AM) + (size_t)tq * 1024 + hd * 128 + 4 * g;
#pragma unroll
            for (int u = 0; u < 8; ++u) { const u32x2 gg = *(const u32x2*)(gp + 16 * u); f32x4 o;
#pragma unroll
                for (int i = 0; i < 4; ++i) o[i] = (O[rb][u][i] * a0 + xch[(rb * 34 + u * 4 + i) * 64] * a1) * il;
                u32x2 w; w.x = cvt_pk(o[0] * bflo(gg.x), o[1] * bfhi(gg.x)); w.y = cvt_pk(o[2] * bflo(gg.y), o[3] * bfhi(gg.y));
                *(u32x2*)(op + 16 * u) = w; } }
    }
    __syncthreads();
#undef ATT_LOAD
#undef ATT_STORE
}
constexpr int NPHASE = 2 + 7 * NL;
#define REOPAQUE(X) do { unsigned long long w_ = (unsigned long long)args.ws, o_ = (unsigned long long)args.out, i_ = (unsigned long long)__builtin_amdgcn_kernarg_segment_ptr(); int t_ = threadIdx.x, c_ = blockIdx.x, g_ = gridDim.x; \
    asm volatile("" : "+s"(w_), "+s"(o_), "+s"(i_), "+v"(t_), "+s"(c_), "+s"(g_)); X.ws = (unsigned char*)(GAS unsigned char*)w_; X.out = (float*)(GAS float*)o_; X.in.p = (CPtr64)i_; X.tid = t_; X.c = c_; X.G = g_; } while (0)
#ifndef PROBE_SP
#define PROBE_SP -1
#endif
#ifndef RPTM
#define RPTM 0
#endif
#define NREP(k) ((((RPTM) >> (k)) & 1) + 1)
#ifndef PHM
#define PHM 0xffff
#endif
__global__ void __launch_bounds__(NTHREADS, 2) mk_fwd(Args args) {
    extern __shared__ __attribute__((aligned(16))) unsigned char lds_raw[];
    LAS unsigned char* lds = (LAS unsigned char*)lds_raw;
    cg::grid_group grid = cg::this_grid();
    volatile LAS unsigned* bst = (volatile LAS unsigned*)(lds + LDS_BYTES - 64);
    if (threadIdx.x < 16) bst[threadIdx.x] = 0u;
    __syncthreads();
    XcdBarrier xbar = xcd_barrier_post((unsigned*)(args.ws + O_BAR), bst);
#if PROBE_SP >= 0
    unsigned long long pacc = 0ull;
#endif
    for (int ph = args.ph_lo; ph < args.ph_hi; ++ph) {
#if PROBE_SP >= 0
        const unsigned long long pt0 = __builtin_amdgcn_s_memrealtime();
#endif
        Ctx X; REOPAQUE(X);
        const int tid = X.tid;
        const char* ws = (const char*)X.ws;
        if (ph == 0) { for (int rep = 0; rep < NREP(0); ++rep) if (PHM & 1) phase_prologue(X, lds); }
        else if (ph == 1) { for (int rep = 0; rep < NREP(1); ++rep) {
            if (PHM & 4) phase_rows(X, 0, false, 0); }
        } else {
            const int l = (ph - 2) / 7, sp7 = (ph - 2) % 7, sp = sp7 < 2 ? sp7 : sp7 - 1;
            if (sp7 == 2) { phase_prefix(X, l); REOPAQUE(X); phase_krope(X, l); }
            else if (sp == 0) {
                SchedZ S{ws + O_H, ws + O_WIN + (size_t)l * ZW * 2048 * 2, X.G, X.c, 0}; EpiZ E{WSP(bf16_t, O_Z), WSP(bf16_t, O_VST), WSP(bf16_t, O_RVT), WSP(float, O_RSS), true};
                if (PHM & 8) pg8::gemm_phase(lds, tid, 2048, 2048, 2048, S, E);
            } else if (sp == 1) {
                for (int i = tid; i < 2048; i += NTHREADS) ((LAS float*)(lds + 131072))[i] = WSP(float, O_ROPE)[i];
                __syncthreads();
                { SchedZ S{ws + O_H, ws + O_WIN + (size_t)l * ZW * 2048 * 2, X.G, X.c, 1}; EpiZ E{WSP(bf16_t, O_Z), WSP(bf16_t, O_VST), WSP(bf16_t, O_RVT), WSP(float, O_RSS), true};
                  if (PHM & 8) pg8::gemm_phase(lds, tid, 2048, 2048, 2048, S, E); }
                REOPAQUE(X);
                { const char* ws2 = (const char*)X.ws;
                  SchedQK S{ws2 + O_Z, ws2 + O_WUQ + (size_t)l * 1536 * 512 * 2, ws2 + O_WKG + (size_t)l * 1024 * 512 * 2, X.G, X.c}; EpiQK E{WSP(bf16_t, O_Q), WSP(bf16_t, O_KN), WSP(float, O_RSS), (const LAS float*)(lds + 131072)};
                  if (PHM & 16) pg8::gemm_phase(lds, X.tid, 512, ZW, 512, S, E); }
                { const char* ws2 = (const char*)X.ws;
                  SchedVT S{ws2 + O_Z, ws2 + O_WVG + (size_t)l * 1024 * 512 * 2, X.G, X.c}; EpiVT E{WSP(bf16_t, O_VT), WSP(float, O_RSS)};
                  if (PHM & 32) pg8::gemm_phase(lds, X.tid, 512, 512, ZW, S, E); }
                REOPAQUE(X);
                { const char* ws2 = (const char*)X.ws;
                  SchedC S2{ws2 + O_CKVC, ws2 + O_WKP, ws2 + O_WVP, X.G, X.c, l}; EpiC E2{WSP(bf16_t, O_KC), WSP(bf16_t, O_VTC)};
                  if (PHM & 2) pg8::gemm_phase(lds, X.tid, 512, 512, 512, S2, E2); }
                REOPAQUE(X); if (PHM & 64) phase_misc(X, l);
                REOPAQUE(X);
                { int i0, i1;
                  if (X.G == 256) { const int c = X.c; if (c < 16) { i0 = 2 * c; i1 = i0 + 2; } else if (c < 96) { i0 = 32 + 4 * (c - 16); i1 = i0 + 4; } else if (c < 160) { i0 = 352 + 3 * (c - 96); i1 = i0 + 3; } else { i0 = 544 + 5 * (c - 160); i1 = i0 + 5; } }
                  else { const int per = (1024 + X.G - 1) / X.G; i0 = X.c * per; i1 = i0 + per < 1024 ? i0 + per : 1024; }
                  for (int it = i0; it < i1; ++it) { if (it < 512) { if (PHM & 128) sgu_item(X, lds, l, it); } else { if (PHM & 256) retstate_item(X, lds, l, it - 512); } } }
            } else if (sp == 2) { for (int rep = 0; rep < NREP(4); ++rep) {
                for (int i = X.c * NTHREADS + tid; i < T; i += X.G * NTHREADS) WSP(float, O_RSS)[3 * T + i] = 0.f;
#if PROBE_SP == 200 || PROBE_SP == 201
                const unsigned long long pa0 = __builtin_amdgcn_s_memrealtime();
#endif
                for (int r2 = 0; r2 < NREP(7); ++r2)
                for (int it = X.c; it < 512; it += X.G) if (PHM & 512) {
                    const int x = it & 7, slot = (it & 255) >> 3;
                    const int un = it < 256 ? (((x * 2 + (slot >> 4)) << 4) | (slot & 15)) : 256 + (((x * 16 + (slot >> 1)) << 1) | (slot & 1));
                    attn_unit(X, lds, l, un); }
#if PROBE_SP == 200
                pacc += __builtin_amdgcn_s_memrealtime() - pa0;
#endif
                REOPAQUE(X);
#if PROBE_SP == 201
                const unsigned long long pa1 = __builtin_amdgcn_s_memrealtime();
#endif
                for (int r2 = 0; r2 < NREP(8); ++r2)
                for (int it = X.c; it < 512; it += X.G) if (PHM & 1024) retout_item(X, lds, l, (it < 256) ? 256 + it : it - 256); }
#if PROBE_SP == 201
                pacc += __builtin_amdgcn_s_memrealtime() - pa1;
#endif
            } else if (sp == 3) { for (int rep = 0; rep < NREP(5); ++rep) {
                SchedBr S{ws + O_AM, ws + O_AS, ws + O_AR, ws + O_WBR + (size_t)l * 3 * 2048 * 1024 * 2, X.G, X.c}; EpiBr E{WSP(bf16_t, O_Z), WSP(bf16_t, O_YMB)};
                if (PHM & 2048) pg8::gemm_phase(lds, tid, 1024, 1024, 1024, S, E); }
            } else if (sp == 4) { for (int rep = 0; rep < NREP(6); ++rep) {
                for (int i = X.c * NTHREADS + tid; i < 3 * T; i += X.G * NTHREADS) WSP(float, O_RSS)[i] = 0.f;
                SchedOut S{ws + O_YMB, ws + O_WOUT + (size_t)l * 2048 * 2048 * 2, X.G, X.c}; EpiOut E{WSP(float, O_Y), WSP(float, O_RSS), rep == 0};
                if (PHM & 4096) pg8::gemm_phase(lds, tid, 2048, 2048, 2048, S, E); }
            } else {
                if (PHM & 8192) phase_rows(X, l, true, l + 1);
            }
        }
        if (ph + 1 < args.ph_hi) { if (ph == 0) { __syncthreads(); grid.sync(); } else { REOPAQUE(X); xbar.bar = (unsigned*)(X.ws + O_BAR); xcd_barrier(xbar); } }
#if PROBE_SP >= 0
        if (PROBE_SP < 200) { const bool hit = (PROBE_SP >= 100) ? (ph == PROBE_SP - 100) : (ph >= 2 && (ph - 2) % 7 == PROBE_SP); if (hit) pacc += __builtin_amdgcn_s_memrealtime() - pt0; }
#endif
    }
#if PROBE_SP == 300
    for (int k = 0; k < 20; ++k) xcd_barrier(xbar);
#endif
#if PROBE_SP >= 0
    if (blockIdx.x == 0 && threadIdx.x == 0) { const unsigned long long t1 = __builtin_amdgcn_s_memrealtime(); while (__builtin_amdgcn_s_memrealtime() - t1 < pacc) __builtin_amdgcn_s_sleep(8); }
#endif
}

extern "C" void kernel_launch(void* const* d_in, const int* in_sizes, int n_in, void* d_out, int out_size, void* d_ws, size_t ws_size, hipStream_t stream) {
    static int grid = 0;
    if (grid == 0) {
        if (n_in != 25 || ws_size < WS_END) { fprintf(stderr, "kernel_launch: unexpected n_in %d / ws %zu (need %zu)\n", n_in, ws_size, (size_t)WS_END); grid = -1; return; }
        int dev = 0, cus = 0, per_cu = 0;
        (void)hipGetDevice(&dev); (void)hipDeviceGetAttribute(&cus, hipDeviceAttributeMultiprocessorCount, dev);
        (void)hipFuncSetAttribute((const void*)mk_fwd, hipFuncAttributeMaxDynamicSharedMemorySize, LDS_BYTES);
        (void)hipOccupancyMaxActiveBlocksPerMultiprocessor(&per_cu, (const void*)mk_fwd, NTHREADS, LDS_BYTES);
        if (per_cu < 1) { fprintf(stderr, "kernel_launch: occupancy query says %d blocks per CU\n", per_cu); per_cu = 1; }
        grid = cus * per_cu;
    }
    if (grid < 0) return;
    Args a{};
    for (int i = 0; i < 25; ++i) a.in[i] = (const float*)d_in[i];
    a.out = (float*)d_out; a.ws = (unsigned char*)d_ws;
#if MK_MULTI
    for (int ph = 0; ph < NPHASE; ++ph) { a.ph_lo = ph; a.ph_hi = ph + 1; hipLaunchKernelGGL(mk_fwd, dim3(grid), dim3(NTHREADS), LDS_BYTES, stream, a); }
#else
    a.ph_lo = 0; a.ph_hi = NPHASE;
    (void)hipMemsetAsync((unsigned char*)d_ws + O_BAR, 0, 16384, stream);
    void* kargs[] = {&a};
    hipError_t e = hipLaunchCooperativeKernel((const void*)mk_fwd, dim3(grid), dim3(NTHREADS), kargs, LDS_BYTES, stream);
    if (e != hipSuccess) fprintf(stderr, "cooperative launch failed: %s (grid %d)\n", hipGetErrorString(e), grid);
#endif
}
```

```cpp
#define MK_MULTI 0
#define RPTM 0
#define PROBE_SP -1
#include <hip/hip_runtime.h>
#include <hip/hip_cooperative_groups.h>
#include <cstdio>
namespace cg = cooperative_groups;

#define LAS __attribute__((address_space(3)))
#define GAS __attribute__((address_space(1)))
typedef unsigned short bf16_t;
typedef short bf16x8 __attribute__((ext_vector_type(8)));
typedef float f32x4 __attribute__((ext_vector_type(4)));
typedef float f32x16 __attribute__((ext_vector_type(16)));
typedef unsigned u32x4 __attribute__((ext_vector_type(4)));
typedef unsigned u32x2 __attribute__((ext_vector_type(2)));

constexpr int NTHREADS = 512;
constexpr int LDS_BYTES = 147456;
constexpr int T = 8192, DM = 2048, ZW = 15616, NL = 4, INC = 15424;
constexpr float EPSN = 1e-6f;
constexpr int Z_CQ = 0, Z_CKV = 512, Z_GPM = 1024, Z_U = 2048, Z_VS = 3072, Z_GPS = 4096, Z_RQ = 5120, Z_RK = 6144, Z_RV = 7168, Z_GPR = 8192, Z_MRG = 9216, Z_KR = 15360;
constexpr size_t OUT_YP = 0, OUT_YS = 8388608, OUT_CKV = 16777216, OUT_KR = 25165824, OUT_RET = 26214400;

constexpr size_t O_WIN = 0,                         S_WIN = (size_t)NL * ZW * 2048 * 2;
constexpr size_t O_WUQ = O_WIN + S_WIN,             S_WUQ = (size_t)NL * 1536 * 512 * 2;
constexpr size_t O_WKG = O_WUQ + S_WUQ,             S_WK = (size_t)NL * 1024 * 512 * 2;
constexpr size_t O_WVG = O_WKG + S_WK;
constexpr size_t O_WKP = O_WVG + S_WK;
constexpr size_t O_WVP = O_WKP + S_WK;
constexpr size_t O_WBR = O_WVP + S_WK,              S_WBR = (size_t)NL * 3 * 2048 * 1024 * 2;
constexpr size_t O_WOUT = O_WBR + S_WBR,            S_WOUT = (size_t)NL * 2048 * 2048 * 2;
constexpr size_t O_CKVC = O_WOUT + S_WOUT,          S_CKVC = (size_t)NL * 512 * 512 * 2;
constexpr size_t O_KRC = O_CKVC + S_CKVC,           S_KRC = (size_t)NL * 512 * 64 * 2;
constexpr size_t O_KC = O_KRC + S_KRC,              S_KC = (size_t)NL * 512 * 1024 * 2;
constexpr size_t O_VTC = O_KC + S_KC;
constexpr size_t O_MOD = O_VTC + S_KC,              S_MOD = (size_t)NL * 3 * 6144 * 4;
constexpr size_t O_ROPE = O_MOD + S_MOD,            S_ROPE = 64 * 16 * 8;
constexpr size_t O_RSS = O_ROPE + S_ROPE,           S_RSS = (size_t)4 * T * 4;
constexpr size_t O_H = O_RSS + S_RSS,               S_H = (size_t)T * DM * 2;
constexpr size_t O_X = O_H + S_H,                   S_X = (size_t)T * DM * 4;
constexpr size_t O_Z = O_X + S_X,                   S_Z = (size_t)T * ZW * 2;
constexpr size_t O_VST = O_Z + S_Z,                 S_T16 = (size_t)1024 * T * 2;
constexpr size_t O_RVT = O_VST + S_T16;
constexpr size_t O_VT = O_RVT + S_T16;
constexpr size_t O_KN = O_VT + S_T16;
constexpr size_t O_AM = O_KN + S_T16;
constexpr size_t O_AS = O_AM + S_T16;
constexpr size_t O_AR = O_AS + S_T16;
constexpr size_t O_Q = O_AR + S_T16,                S_Q = (size_t)T * 1536 * 2;
constexpr size_t O_KR = O_Q + S_Q,                  S_KR = (size_t)T * 64 * 2;
constexpr size_t O_ST = O_KR + S_KR,                S_ST = (size_t)64 * 8 * 2 * 16384 * 4;
constexpr size_t O_YMF = O_ST + S_ST;
constexpr size_t O_YMB = O_YMF + S_X;
constexpr size_t O_Y = O_YMB + S_H;
constexpr size_t O_PF = O_Y + S_X,                  S_PF = (size_t)64 * 8 * 2 * 16384 * 2;
constexpr size_t O_BAR = O_PF + S_PF;
constexpr size_t WS_END = O_BAR + 16384;

struct Args { const float* in[25]; float* out; unsigned char* ws; int ph_lo, ph_hi; };

__device__ __forceinline__ unsigned cvt_pk(float lo, float hi) { unsigned r; asm volatile("v_cvt_pk_bf16_f32 %0, %1, %2" : "=v"(r) : "v"(lo), "v"(hi)); return r; }
__device__ __forceinline__ float bf2f(unsigned short b) { return __uint_as_float(((unsigned)b) << 16); }
__device__ __forceinline__ float bflo(unsigned w) { return __uint_as_float(w << 16); }
__device__ __forceinline__ float bfhi(unsigned w) { return __uint_as_float(w & 0xffff0000u); }
__device__ __forceinline__ float sigm_f(float x) { return __builtin_amdgcn_rcpf(1.f + __builtin_amdgcn_exp2f(x * -1.4426950408889634f)); }
__device__ __forceinline__ float silu_f(float x) { return x * sigm_f(x); }
__device__ __forceinline__ float wave_sum(float v) {
#pragma unroll
    for (int o = 1; o < 64; o <<= 1) v += __shfl_xor(v, o);
    return v;
}

namespace pg8 {
constexpr int BM = 256, BK = 64, HALF = 128, HTB = HALF * BK * 2, STAGE_BYTES = 8 * HTB, NXCD = 8, WGM = 8;
__host__ __device__ __forceinline__ int lds_byte(int r, int c) { const int st = (r >> 4) * 2 + (c >> 5), rr = r & 15, cc = c & 31, ob = rr * 64 + cc * 2; return st * 1024 + (ob ^ (((ob >> 9) & 1) << 5)); }
__host__ __device__ __forceinline__ void stage_rc(int b, int& R, int& C) { const int st = b / 1024, sb = b % 1024, swz = sb ^ (((sb >> 9) & 1) << 5); R = (st >> 1) * 16 + swz / 64; C = (st & 1) * 32 + (swz % 64) / 2; }
__host__ __device__ __forceinline__ int perm32(int rho) { const int n = rho >> 4, i = rho & 15; return 8 * (i >> 2) + 4 * n + (i & 3); }

struct Unit { const char* a; const char* b; int pm, pn, kind, aux; };

__device__ __forceinline__ void tile_order(int L, int nM, int nN, int& pm, int& pn) {
    const int nwg = nM * nN; int wgid = L; { const int q = nwg / NXCD, r = nwg % NXCD, xcd = wgid % NXCD, off = wgid / NXCD; wgid = (xcd < r ? xcd * (q + 1) : r * (q + 1) + (xcd - r) * q) + off; }
    const int nig = WGM * nN, gid = wgid / nig, fm = gid * WGM, gsz = (nM - fm) < WGM ? (nM - fm) : WGM;
    pm = fm + ((wgid % nig) % gsz); pn = (wgid % nig) / gsz;
}

template <class Epi, class Sched>
__device__ __forceinline__ void gemm_phase(LAS unsigned char* lds, const int tid, const int K, const int lda, const int ldb, const Sched& S, const Epi& E) {
    const int  wid = __builtin_amdgcn_readfirstlane(tid >> 6), lane = tid & 63, wr = wid >> 2, wc = wid & 3, fr = lane & 15, fq = lane >> 4;
    const int nt = K / BK;
    unsigned voffA[2], voffB[2];
#pragma unroll
    for (int i = 0; i < 2; ++i) { int R, C; stage_rc(tid * 16 + i * 8192, R, C); const int Rb = (R & ~31) + perm32(R & 31);
        voffA[i] = (unsigned)(R * lda + C) * 2u; voffB[i] = (unsigned)(Rb * ldb + C) * 2u; }
    const size_t kstep = (size_t)(BK * 2);
    const size_t hstepA = (size_t)HALF * lda * 2, hstepB = (size_t)HALF * ldb * 2;
    const unsigned ldsw = (unsigned)wid * 1024u;
    const int aoff = lds_byte(wr * 64 + fr, fq * 8), boff = lds_byte(wc * 32 + fr, fq * 8);
#define PG8_SA(b, h) (((b) * 2 + (h)) * HTB)
#define PG8_SB(b, h) ((4 + (b) * 2 + (h)) * HTB)
#define PG8_STAGE(bufoff, gbase, voff) do { _Pragma("unroll") for (int _i = 0; _i < 2; ++_i) \
        __builtin_amdgcn_global_load_lds((const unsigned*)((const char*)(gbase) + (voff)[_i]), (LAS unsigned*)(lds + (bufoff) + ldsw + _i * 8192), 16, 0, 0); } while (0)
#define PG8_LDA(dst, b, h) do { _Pragma("unroll") for (int m = 0; m < 4; ++m) _Pragma("unroll") for (int k = 0; k < 2; ++k) dst[m][k] = *(const LAS bf16x8*)(lds + PG8_SA(b, h) + aoff + m * 2048 + k * 1024); } while (0)
#define PG8_LDB(dst, b, h) do { _Pragma("unroll") for (int n = 0; n < 2; ++n) _Pragma("unroll") for (int k = 0; k < 2; ++k) dst[n][k] = *(const LAS bf16x8*)(lds + PG8_SB(b, h) + boff + n * 2048 + k * 1024); } while (0)
#define PG8_MMA(ai, bj, At, Bt) do { __builtin_amdgcn_s_setprio(1); _Pragma("unroll") for (int m = 0; m < 4; ++m) _Pragma("unroll") for (int n = 0; n < 2; ++n) _Pragma("unroll") for (int k = 0; k < 2; ++k) \
        acc[ai][bj][m][n] = __builtin_amdgcn_mfma_f32_16x16x32_bf16(Bt[n][k], At[m][k], acc[ai][bj][m][n], 0, 0, 0); __builtin_amdgcn_s_setprio(0); } while (0)
#define PG8_WAIT_V(n) asm volatile("s_waitcnt vmcnt(" #n ")" ::: "memory")
#define PG8_WAIT_L(n) asm volatile("s_waitcnt lgkmcnt(" #n ")" ::: "memory")
#define PG8_BAR __builtin_amdgcn_s_barrier()
#define PG8_SCHED __builtin_amdgcn_sched_barrier(0)
    Unit cur, nxt; int ui = 0;
    if (!S.next(0, cur)) return;
    f32x4 acc[2][2][4][2];
#pragma unroll
    for (int a = 0; a < 2; ++a)
#pragma unroll
        for (int b = 0; b < 2; ++b)
#pragma unroll
            for (int m = 0; m < 4; ++m)
#pragma unroll
                for (int n = 0; n < 2; ++n) acc[a][b][m][n] = (f32x4){0.f, 0.f, 0.f, 0.f};
    bf16x8 At[4][2], B0[2][2], B1[2][2];
    const char* cA = cur.a; const char* cB = cur.b;
    PG8_STAGE(PG8_SB(0, 0), cB, voffB); PG8_STAGE(PG8_SA(0, 0), cA, voffA); PG8_STAGE(PG8_SB(0, 1), cB + hstepB, voffB); PG8_STAGE(PG8_SA(0, 1), cA + hstepA, voffA);
    if (wr == 1) PG8_BAR;
    PG8_WAIT_V(4); PG8_BAR;
    PG8_STAGE(PG8_SB(1, 0), cB + kstep, voffB); PG8_STAGE(PG8_SA(1, 0), cA + kstep, voffA); PG8_STAGE(PG8_SB(1, 1), cB + hstepB + kstep, voffB);
    PG8_WAIT_V(6); PG8_BAR;
    for (;;) {
        const bool has_next = S.next(ui + 1, nxt);
        const char* nA = has_next ? nxt.a : cA; const char* nB = has_next ? nxt.b : cB;
        for (int t = 0; t < nt; t += 2) {
            const bool last = (t == nt - 2);
            const char* a1 = cA + (size_t)(t + 1) * kstep;
            const char* a2 = last ? nA : cA + (size_t)(t + 2) * kstep; const char* b2 = last ? nB : cB + (size_t)(t + 2) * kstep;
            const char* a3 = a2 + kstep; const char* b3 = b2 + kstep;
            PG8_LDB(B0, 0, 0); PG8_SCHED; PG8_LDA(At, 0, 0); PG8_STAGE(PG8_SA(1, 1), a1 + hstepA, voffA);
            PG8_WAIT_L(8); PG8_BAR; PG8_WAIT_L(0); PG8_MMA(0, 0, At, B0); PG8_BAR; PG8_SCHED;
            PG8_LDB(B1, 0, 1); PG8_STAGE(PG8_SB(0, 0), b2, voffB);
            PG8_BAR; PG8_WAIT_L(0); PG8_MMA(0, 1, At, B1); PG8_BAR;
            PG8_LDA(At, 0, 1); PG8_STAGE(PG8_SA(0, 0), a2, voffA);
            PG8_BAR; PG8_WAIT_L(0); PG8_MMA(1, 0, At, B0); PG8_BAR; PG8_SCHED;
            PG8_STAGE(PG8_SB(0, 1), b2 + hstepB, voffB);
            PG8_WAIT_V(6); PG8_BAR; PG8_MMA(1, 1, At, B1); PG8_BAR;
            PG8_LDB(B0, 1, 0); PG8_SCHED; PG8_LDA(At, 1, 0); PG8_STAGE(PG8_SA(0, 1), a2 + hstepA, voffA);
            PG8_WAIT_L(8); PG8_BAR; PG8_WAIT_L(0); PG8_MMA(0, 0, At, B0); PG8_BAR; PG8_SCHED;
            PG8_LDB(B1, 1, 1); PG8_STAGE(PG8_SB(1, 0), b3, voffB);
            PG8_BAR; PG8_WAIT_L(0); PG8_MMA(0, 1, At, B1); PG8_BAR;
            PG8_LDA(At, 1, 1); PG8_STAGE(PG8_SA(1, 0), a3, voffA);
            PG8_BAR; PG8_WAIT_L(0); PG8_MMA(1, 0, At, B0); PG8_BAR; PG8_SCHED;
            PG8_STAGE(PG8_SB(1, 1), b3 + hstepB, voffB);
            PG8_WAIT_V(6); PG8_BAR; PG8_MMA(1, 1, At, B1); PG8_BAR;
        }
        E(acc, cur, wr, wc, fr, fq);
        if (!has_next) break;
        if (cur.aux != 1)
#pragma unroll
        for (int a = 0; a < 2; ++a)
#pragma unroll
            for (int b = 0; b < 2; ++b)
#pragma unroll
                for (int m = 0; m < 4; ++m)
#pragma unroll
                    for (int n = 0; n < 2; ++n) acc[a][b][m][n] = (f32x4){0.f, 0.f, 0.f, 0.f};
        cur = nxt; cA = nA; cB = nB; ++ui;
    }
    PG8_WAIT_V(0);
    if (wr == 0) PG8_BAR;
    PG8_BAR;
#undef PG8_SA
#undef PG8_SB
#undef PG8_STAGE
#undef PG8_LDA
#undef PG8_LDB
#undef PG8_MMA
#undef PG8_WAIT_V
#undef PG8_WAIT_L
#undef PG8_BAR
#undef PG8_SCHED
}
}
typedef f32x4 (&AccRef)[2][2][4][2];

#define XB_TMO      128
#define XB_XCNT(j)  (256  + 64 * (j))
#define XB_XSUB(j)  (1280 + 64 * (j))
#define XB_XGEN(j)  (2304 + 64 * (j))
#define XB_TOP      3328
#define XB_TOPGEN   3392
#define XCD_BAR_WORDS 3456
#define XB_SPIN_CAP (1u << 22)
__device__ __forceinline__ unsigned xb_ld(unsigned* p)              { return __hip_atomic_load(p, __ATOMIC_RELAXED, __HIP_MEMORY_SCOPE_AGENT); }
__device__ __forceinline__ unsigned xb_add(unsigned* p, unsigned v) { return __hip_atomic_fetch_add(p, v, __ATOMIC_RELAXED, __HIP_MEMORY_SCOPE_AGENT); }
__device__ __forceinline__ unsigned xb_xcc_id() { return (unsigned)__builtin_amdgcn_s_getreg((3 << 11) | 20) & 0xFu; }
#define XB_SPIN(cond, bar) do { unsigned _sp = 0; while (cond) { \
    if ((++_sp & 255u) == 0u) { if (xb_ld(&(bar)[XB_TMO])) break; if (_sp > XB_SPIN_CAP) { atomicAdd(&(bar)[XB_TMO], 1u); break; } } } } while (0)
struct XcdBarrier { unsigned* bar; unsigned x; volatile LAS unsigned* st; };
__device__ __forceinline__ XcdBarrier xcd_barrier_post(unsigned* bar, volatile LAS unsigned* st) {
    XcdBarrier b; b.bar = bar; b.x = xb_xcc_id(); b.st = st;
    if (threadIdx.x == 0) (void)xb_add(&bar[XB_XCNT(b.x)], 1u);
    return b;
}
__device__ __forceinline__ void xcd_barrier_complete(unsigned* bar, unsigned x, unsigned& nloc, unsigned& nx) {
    const unsigned G = gridDim.x * gridDim.y * gridDim.z;
    unsigned sum, cnt, mine, sp = 0u;
    for (;;) {
        sum = 0u; cnt = 0u; mine = 0u;
#pragma unroll
        for (unsigned j = 0; j < 16; ++j) { const unsigned c = xb_ld(&bar[XB_XCNT(j)]); sum += c; cnt += (c > 0u) ? 1u : 0u; }
        mine = xb_ld(&bar[XB_XCNT(x)]);
        if (sum == G) break;
        __builtin_amdgcn_s_sleep(1);
        if ((++sp & 255u) == 0u) { if (xb_ld(&bar[XB_TMO])) break; if (sp > XB_SPIN_CAP) { atomicAdd(&bar[XB_TMO], 1u); break; } }
    }
    nloc = mine > 0u ? mine : 1u; nx = cnt > 0u ? cnt : 1u;
}
__device__ __forceinline__ void xcd_barrier(const XcdBarrier& b) {
    asm volatile("s_waitcnt vmcnt(0)" ::: "memory");
    __syncthreads();
    if (threadIdx.x == 0) {
        unsigned* bar = b.bar;
        __builtin_amdgcn_s_waitcnt(0);
        unsigned nloc = b.st[0], nx = b.st[1];
        if (nloc == 0u) { xcd_barrier_complete(bar, b.x, nloc, nx); b.st[0] = nloc; b.st[1] = nx; }
        const unsigned old = xb_add(&bar[XB_XSUB(b.x)], 1u);
        const unsigned gen = old / nloc;
        if (old + 1u == (gen + 1u) * nloc) {
            __builtin_amdgcn_fence(__ATOMIC_RELEASE, "agent");
            asm volatile("s_waitcnt vmcnt(0)" ::: "memory");
            const unsigned og = xb_add(&bar[XB_TOP], 1u);
            const unsigned tg = og / nx;
            if (og + 1u == (tg + 1u) * nx) xb_add(&bar[XB_TOPGEN], 1u);
            else XB_SPIN(xb_ld(&bar[XB_TOPGEN]) == tg, bar);
            __builtin_amdgcn_fence(__ATOMIC_ACQUIRE, "agent");
            xb_add(&bar[XB_XGEN(b.x)], 1u);
            asm volatile("s_waitcnt vmcnt(0)" ::: "memory");
        } else {
            XB_SPIN(xb_ld(&bar[XB_XGEN(b.x)]) == gen, bar);
            __builtin_amdgcn_fence(__ATOMIC_ACQUIRE, "agent");
            asm volatile("s_waitcnt vmcnt(0)" ::: "memory");
        }
    }
    __syncthreads();
}
using pg8::Unit;
typedef const unsigned long long __attribute__((address_space(4)))* CPtr64;
struct InTab { CPtr64 p; __device__ __forceinline__ const float* operator[](int i) const { return (const float*)(GAS const float*)p[i]; } };
struct Ctx {
    unsigned char* ws; float* out; InTab in;
    int G, c, tid;
};
#define WSP(T_, off) ((T_*)(X.ws + (off)))

struct SchedZ {
    const char* h; const char* w; int G, c, mode;
    __device__ __forceinline__ bool next(int i, Unit& u) const {
        const int ntn = mode ? 37 : 24; const long Lx = (long)i * G + c; if (Lx >= 32 * ntn) return false;
        int pm, pj; pg8::tile_order((int)Lx, 32, ntn, pm, pj);
        const int pn = mode ? (pj < 4 ? 4 + pj : pj < 8 ? 16 + pj : 24 + pj) : (pj < 4 ? pj : pj < 16 ? pj + 4 : pj + 8);
        const char* hp = h + (size_t)pm * 256 * 2048 * 2; const char* wp = w + (size_t)pn * 256 * 2048 * 2;
        const bool sw = (pn >= 12 && pn < 16) || (pn >= 28 && pn < 32);
        u.pm = pm; u.pn = pn; u.kind = sw ? 1 : 0; u.aux = 0; u.a = sw ? wp : hp; u.b = sw ? hp : wp; return true;
    }
};
struct EpiZ {
    bf16_t* z; bf16_t* vsT; bf16_t* rvT; float* rss; bool doss;
    __device__ __forceinline__ void operator()(AccRef acc, const Unit& u, int wr, int wc, int fr, int fq) const {
        if (u.kind == 0) {
            const int pn = u.pn;
            const int act = (pn >= 36 && pn < 60) ? 2 : ((pn >= 4 && pn < 8) || (pn >= 16 && pn < 20) || (pn >= 32 && pn < 36)) ? 1 : (pn >= 24 && pn < 28) ? 3 : 0;
            const int row0 = u.pm * 256 + wr * 64 + fr, col0 = pn * 256 + wc * 32 + 8 * fq;
#pragma unroll
            for (int ai = 0; ai < 2; ++ai)
#pragma unroll
                for (int m = 0; m < 4; ++m) {
                    const int row = row0 + ai * 128 + m * 16; bf16_t* rowp = z + (size_t)row * ZW + col0; float ss = 0.f;
#pragma unroll
                    for (int bj = 0; bj < 2; ++bj) { f32x4 v0 = acc[ai][bj][m][0], v1 = acc[ai][bj][m][1];
                        if (act == 0) { ss += v0[0] * v0[0] + v0[1] * v0[1] + v0[2] * v0[2] + v0[3] * v0[3] + v1[0] * v1[0] + v1[1] * v1[1] + v1[2] * v1[2] + v1[3] * v1[3]; }
                        else if (act == 1) {
#pragma unroll
                            for (int j = 0; j < 4; ++j) { v0[j] = silu_f(v0[j]); v1[j] = silu_f(v1[j]); } }
                        else if (act == 2) {
#pragma unroll
                            for (int j = 0; j < 4; ++j) { v0[j] = fmaxf(sigm_f(v0[j]), 1e-20f); v1[j] = fmaxf(sigm_f(v1[j]), 1e-20f); } }
                        else { v0 = v0 * 0.08838834764831845f; v1 = v1 * 0.08838834764831845f; }
                        u32x4 w; w.x = cvt_pk(v0[0], v0[1]); w.y = cvt_pk(v0[2], v0[3]); w.z = cvt_pk(v1[0], v1[1]); w.w = cvt_pk(v1[2], v1[3]);
                        *(u32x4*)(rowp + bj * 128) = w; }
                    if (pn < 4 && doss) { ss += __shfl_xor(ss, 16); ss += __shfl_xor(ss, 32); if (fq == 0) atomicAdd(rss + (pn >> 1) * T + row, ss); }
                }
        } else {
            const bool isv = u.pn < 16; bf16_t* dst = isv ? vsT : rvT; const int f0 = (u.pn - (isv ? 12 : 28)) * 256 + wr * 64 + fr, tok0 = u.pm * 256 + wc * 32 + 8 * fq;
            float cs[2][2][4];
#pragma unroll
            for (int bj = 0; bj < 2; ++bj)
#pragma unroll
                for (int n = 0; n < 2; ++n)
#pragma unroll
                    for (int j = 0; j < 4; ++j) cs[bj][n][j] = 0.f;
#pragma unroll
            for (int ai = 0; ai < 2; ++ai)
#pragma unroll
                for (int m = 0; m < 4; ++m) { bf16_t* rowp = dst + (size_t)(f0 + ai * 128 + m * 16) * T + tok0;
#pragma unroll
                    for (int bj = 0; bj < 2; ++bj) { const f32x4 v0 = acc[ai][bj][m][0], v1 = acc[ai][bj][m][1];
#pragma unroll
                        for (int j = 0; j < 4; ++j) { cs[bj][0][j] += v0[j] * v0[j]; cs[bj][1][j] += v1[j] * v1[j]; }
                        u32x4 w; w.x = cvt_pk(v0[0], v0[1]); w.y = cvt_pk(v0[2], v0[3]); w.z = cvt_pk(v1[0], v1[1]); w.w = cvt_pk(v1[2], v1[3]);
                        *(u32x4*)(rowp + bj * 128) = w; } }
            if (isv && doss) {
#pragma unroll
                for (int bj = 0; bj < 2; ++bj)
#pragma unroll
                    for (int n = 0; n < 2; ++n)
#pragma unroll
                        for (int j = 0; j < 4; ++j) { float s = cs[bj][n][j]; s += __shfl_xor(s, 1); s += __shfl_xor(s, 2); s += __shfl_xor(s, 4); s += __shfl_xor(s, 8);
                            if (fr == 0) atomicAdd(rss + 2 * T + tok0 + bj * 128 + n * 4 + j, s); }
            }
        }
    }
};

__device__ __forceinline__ int deal_qk(int i, int G, int c) {
    if (G != 256) { const int L = i * G + c; return L < 320 ? L : -1; }
    if (c < 160) return i == 0 ? c : -1;
    const int r = c - 160; if (r < 64) return i < 2 ? 160 + 2 * r + i : -1;
    return i == 0 ? 288 + (r - 64) : -1;
}
__device__ __forceinline__ int deal_vt(int i, int G, int c) {
    if (G != 256) { const int L = i * G + c; return L < 128 ? L : -1; }
    if (c < 160) return -1;
    const int r = c - 160; if (r < 64) return i == 0 ? r : -1;
    return i < 2 ? 64 + 2 * (r - 64) + i : -1;
}
struct SchedQK {
    const char* z; const char* wq; const char* wk; int G, c;
    __device__ __forceinline__ bool next(int i, Unit& u) const {
        const int Lx = deal_qk(i, G, c); if (Lx < 0) return false;
        if (Lx < 192) { u.pm = Lx / 6; u.pn = Lx % 6; u.kind = 0; u.a = z + (size_t)u.pm * 256 * ZW * 2 + Z_CQ * 2; u.b = wq + (size_t)u.pn * 256 * 512 * 2; }
        else { const int r = Lx - 192; u.pm = r / 4; u.pn = r % 4; u.kind = 1; u.a = z + (size_t)u.pm * 256 * ZW * 2 + Z_CKV * 2; u.b = wk + (size_t)u.pn * 256 * 512 * 2; }
        u.aux = 0; return true;
    }
};
constexpr float QSCALE = 0.07216878364870322f * 1.4426950408889634f;
struct EpiQK {
    bf16_t* q; bf16_t* kn; const float* rss; const LAS float* rope;
    __device__ __forceinline__ void operator()(AccRef acc, const Unit& u, int wr, int wc, int fr, int fq) const {
        const int row0 = u.pm * 256 + wr * 64 + fr, col0 = u.pn * 256 + wc * 32 + 8 * fq;
        float rr[2][4];
#pragma unroll
        for (int ai = 0; ai < 2; ++ai)
#pragma unroll
            for (int m = 0; m < 4; ++m) rr[ai][m] = rss[(u.kind == 0 ? 0 : T) + row0 + ai * 128 + m * 16];
        __builtin_amdgcn_sched_barrier(0);
        if (u.kind == 0) {
#pragma unroll
            for (int ai = 0; ai < 2; ++ai)
#pragma unroll
                for (int m = 0; m < 4; ++m) {
                    const int row = row0 + ai * 128 + m * 16; const float ri = rsqrtf(rr[ai][m] * (1.f / 512.f) + EPSN) * QSCALE;
                    const int t = (row - 4096) & 2047;
#pragma unroll
                    for (int bj = 0; bj < 2; ++bj) { f32x4 v0 = acc[ai][bj][m][0] * ri, v1 = acc[ai][bj][m][1] * ri;
                        const int g0 = u.pn * 256 + bj * 128 + wc * 32, off = g0 % 192;
                        if (off >= 128 && row >= 4096) {
                            const int p = (off == 128) ? (t >> 6) : (t & 63); const LAS float* tb = rope + (p * 16 + (fq & 1) * 8) * 2;
                            const float sg = (fq & 2) ? 1.f : -1.f;
#pragma unroll
                            for (int j = 0; j < 4; ++j) { const float p0 = __shfl_xor(v0[j], 32), p1 = __shfl_xor(v1[j], 32);
                                const float c0 = tb[2 * j], s0 = tb[2 * j + 1], c1 = tb[2 * (4 + j)], s1 = tb[2 * (4 + j) + 1];
                                v0[j] = v0[j] * c0 + sg * p0 * s0; v1[j] = v1[j] * c1 + sg * p1 * s1; }
                        }
                        u32x4 w; w.x = cvt_pk(v0[0], v0[1]); w.y = cvt_pk(v0[2], v0[3]); w.z = cvt_pk(v1[0], v1[1]); w.w = cvt_pk(v1[2], v1[3]);
                        *(u32x4*)(q + (size_t)row * 1536 + col0 + bj * 128) = w; }
                }
        } else {
#pragma unroll
            for (int ai = 0; ai < 2; ++ai)
#pragma unroll
                for (int m = 0; m < 4; ++m) {
                    const int row = row0 + ai * 128 + m * 16; const float ri = rsqrtf(rr[ai][m] * (1.f / 512.f) + EPSN);
#pragma unroll
                    for (int bj = 0; bj < 2; ++bj) { const f32x4 v0 = acc[ai][bj][m][0] * ri, v1 = acc[ai][bj][m][1] * ri;
                        u32x4 w; w.x = cvt_pk(v0[0], v0[1]); w.y = cvt_pk(v0[2], v0[3]); w.z = cvt_pk(v1[0], v1[1]); w.w = cvt_pk(v1[2], v1[3]);
                        *(u32x4*)(kn + (size_t)row * 1024 + col0 + bj * 128) = w; }
                }
        }
    }
};

struct SchedVT {
    const char* z; const char* wv; int G, c;
    __device__ __forceinline__ bool next(int i, Unit& u) const {
        const int Lx = deal_vt(i, G, c); if (Lx < 0) return false;
        u.pm = Lx & 3; u.pn = Lx >> 2; u.kind = 0; u.aux = 0; u.a = wv + (size_t)u.pm * 256 * 512 * 2; u.b = z + (size_t)u.pn * 256 * ZW * 2 + Z_CKV * 2; return true;
    }
};
struct EpiVT {
    bf16_t* vt; const float* rss;
    __device__ __forceinline__ void operator()(AccRef acc, const Unit& u, int wr, int wc, int fr, int fq) const {
        const int f0 = u.pm * 256 + wr * 64 + fr, tok0 = u.pn * 256 + wc * 32 + 8 * fq;
        f32x4 ri[2][2];
#pragma unroll
        for (int bj = 0; bj < 2; ++bj)
#pragma unroll
            for (int n = 0; n < 2; ++n)
#pragma unroll
                for (int j = 0; j < 4; ++j) ri[bj][n][j] = rsqrtf(rss[T + tok0 + bj * 128 + n * 4 + j] * (1.f / 512.f) + EPSN);
#pragma unroll
        for (int ai = 0; ai < 2; ++ai)
#pragma unroll
            for (int m = 0; m < 4; ++m) { bf16_t* rowp = vt + (size_t)(f0 + ai * 128 + m * 16) * T + tok0;
#pragma unroll
                for (int bj = 0; bj < 2; ++bj) { const f32x4 v0 = acc[ai][bj][m][0] * ri[bj][0], v1 = acc[ai][bj][m][1] * ri[bj][1];
                    u32x4 w; w.x = cvt_pk(v0[0], v0[1]); w.y = cvt_pk(v0[2], v0[3]); w.z = cvt_pk(v1[0], v1[1]); w.w = cvt_pk(v1[2], v1[3]);
                    *(u32x4*)(rowp + bj * 128) = w; } }
    }
};

struct SchedC {
    const char* cc; const char* wk; const char* wv; int G, c, l;
    __device__ __forceinline__ bool next(int i, Unit& u) const {
        const int r = i * G + c; if (r >= 16) return false;
        u.aux = l;
        if (r < 8) { u.kind = 0; u.pm = r >> 2; u.pn = r & 3; u.a = cc + ((size_t)l * 512 + u.pm * 256) * 512 * 2; u.b = wk + ((size_t)l * 1024 + u.pn * 256) * 512 * 2; }
        else { const int s = r - 8; u.kind = 1; u.pm = s >> 1; u.pn = s & 1; u.a = wv + ((size_t)l * 1024 + u.pm * 256) * 512 * 2; u.b = cc + ((size_t)l * 512 + u.pn * 256) * 512 * 2; }
        return true;
    }
};
struct EpiC {
    bf16_t* kc; bf16_t* vtc;
    __device__ __forceinline__ void operator()(AccRef acc, const Unit& u, int wr, int wc, int fr, int fq) const {
        const int r0 = u.pm * 256 + wr * 64 + fr, c0 = u.pn * 256 + wc * 32 + 8 * fq;
        bf16_t* base = u.kind == 0 ? kc + (size_t)u.aux * 512 * 1024 : vtc + (size_t)u.aux * 1024 * 512; const int ld = u.kind == 0 ? 1024 : 512;
#pragma unroll
        for (int ai = 0; ai < 2; ++ai)
#pragma unroll
            for (int m = 0; m < 4; ++m) { bf16_t* rowp = base + (size_t)(r0 + ai * 128 + m * 16) * ld + c0;
#pragma unroll
                for (int bj = 0; bj < 2; ++bj) { const f32x4 v0 = acc[ai][bj][m][0], v1 = acc[ai][bj][m][1];
                    u32x4 w; w.x = cvt_pk(v0[0], v0[1]); w.y = cvt_pk(v0[2], v0[3]); w.z = cvt_pk(v1[0], v1[1]); w.w = cvt_pk(v1[2], v1[3]);
                    *(u32x4*)(rowp + bj * 128) = w; } }
    }
};

struct SchedBr {
    const char* am; const char* as; const char* ar; const char* w; int G, c;
    __device__ __forceinline__ bool next(int i, Unit& u) const {
        const int tile = (i / 3) * G + c; if (tile >= 256) return false;
        const int br = i % 3; pg8::tile_order(tile, 32, 8, u.pm, u.pn); u.kind = br; u.aux = br < 2 ? 1 : 0;
        u.a = (br == 0 ? am : br == 1 ? as : ar) + (size_t)u.pm * 256 * 1024 * 2; u.b = w + ((size_t)br * 2048 + u.pn * 256) * 1024 * 2; return true;
    }
};
struct EpiBr {
    const bf16_t* z; bf16_t* ymb;
    __device__ __forceinline__ void operator()(AccRef acc, const Unit& u, int wr, int wc, int fr, int fq) const {
        const int row0 = u.pm * 256 + wr * 64 + fr, col0 = u.pn * 256 + wc * 32 + 8 * fq;
#pragma unroll
        for (int ai = 0; ai < 2; ++ai) {
            u32x4 g0[4][2], g1[4][2];
#pragma unroll
            for (int m = 0; m < 4; ++m)
#pragma unroll
                for (int bj = 0; bj < 2; ++bj) { const bf16_t* mp = z + (size_t)(row0 + ai * 128 + m * 16) * ZW + Z_MRG + u.kind * 2048 + col0 + bj * 128;
                    g0[m][bj] = *(const u32x4*)mp; if (u.kind < 2) g1[m][bj] = *(const u32x4*)(mp + 2048); }
            __builtin_amdgcn_sched_barrier(0);
#pragma unroll
            for (int m = 0; m < 4; ++m) { const int row = row0 + ai * 128 + m * 16;
#pragma unroll
                for (int bj = 0; bj < 2; ++bj) { const int col = col0 + bj * 128;
                    const u32x4 mg = g0[m][bj];
                    f32x4 s0, s1; s0[0] = bflo(mg.x); s0[1] = bfhi(mg.x); s0[2] = bflo(mg.y); s0[3] = bfhi(mg.y); s1[0] = bflo(mg.z); s1[1] = bfhi(mg.z); s1[2] = bflo(mg.w); s1[3] = bfhi(mg.w);
                    if (u.kind < 2) { const u32x4 mn = g1[m][bj];
                        s0[0] *= __builtin_amdgcn_rcpf(bflo(mn.x)); s0[1] *= __builtin_amdgcn_rcpf(bfhi(mn.x)); s0[2] *= __builtin_amdgcn_rcpf(bflo(mn.y)); s0[3] *= __builtin_amdgcn_rcpf(bfhi(mn.y));
                        s1[0] *= __builtin_amdgcn_rcpf(bflo(mn.z)); s1[1] *= __builtin_amdgcn_rcpf(bfhi(mn.z)); s1[2] *= __builtin_amdgcn_rcpf(bflo(mn.w)); s1[3] *= __builtin_amdgcn_rcpf(bfhi(mn.w));
                        acc[ai][bj][m][0] *= s0; acc[ai][bj][m][1] *= s1; }
                    else { const f32x4 v0 = acc[ai][bj][m][0] * s0, v1 = acc[ai][bj][m][1] * s1;
                        u32x4 w; w.x = cvt_pk(v0[0], v0[1]); w.y = cvt_pk(v0[2], v0[3]); w.z = cvt_pk(v1[0], v1[1]); w.w = cvt_pk(v1[2], v1[3]);
                        *(u32x4*)(ymb + (size_t)row * DM + col) = w; }
                } }
            __builtin_amdgcn_sched_barrier(0);
        }
    }
};

struct SchedOut {
    const char* a; const char* w; int G, c;
    __device__ __forceinline__ bool next(int i, Unit& u) const {
        const int tile = i * G + c; if (tile >= 256) return false;
        pg8::tile_order(tile, 32, 8, u.pm, u.pn); u.kind = 0; u.aux = 0; u.a = a + (size_t)u.pm * 256 * 2048 * 2; u.b = w + (size_t)u.pn * 256 * 2048 * 2; return true;
    }
};
struct EpiOut {
    float* y; float* rss; bool doss;
    __device__ __forceinline__ void operator()(AccRef acc, const Unit& u, int wr, int wc, int fr, int fq) const {
        const int row0 = u.pm * 256 + wr * 64 + fr, col0 = u.pn * 256 + wc * 32 + 8 * fq;
#pragma unroll
        for (int ai = 0; ai < 2; ++ai)
#pragma unroll
            for (int m = 0; m < 4; ++m) { const int row = row0 + ai * 128 + m * 16; float ss = 0.f;
#pragma unroll
                for (int bj = 0; bj < 2; ++bj) { const f32x4 v0 = acc[ai][bj][m][0], v1 = acc[ai][bj][m][1]; float* yp = y + (size_t)row * DM + col0 + bj * 128;
                    ss += v0[0] * v0[0] + v0[1] * v0[1] + v0[2] * v0[2] + v0[3] * v0[3] + v1[0] * v1[0] + v1[1] * v1[1] + v1[2] * v1[2] + v1[3] * v1[3];
                    *(f32x4*)yp = v0; *(f32x4*)(yp + 4) = v1; }
                ss += __shfl_xor(ss, 16); ss += __shfl_xor(ss, 32); if (fq == 0 && doss) atomicAdd(rss + 3 * T + row, ss); }
    }
};
__device__ __forceinline__ void transpose_item(const float* W, int K, int N, int k0, int n0, bf16_t* dst0, const float* gk, LAS float* scr, int lane) {
    const int kr = lane >> 3, c4 = (lane & 7) * 4;
    f32x4 v[8];
#pragma unroll
    for (int i = 0; i < 8; ++i) v[i] = __builtin_nontemporal_load((const f32x4*)(W + (size_t)(k0 + 8 * i + kr) * N + n0 + c4));
    if (gk) {
#pragma unroll
        for (int i = 0; i < 8; ++i) v[i] = v[i] * gk[k0 + 8 * i + kr]; }
#pragma unroll
    for (int i = 0; i < 8; ++i) { LAS float* sp = scr + (8 * i + kr) * 33 + c4; sp[0] = v[i][0]; sp[1] = v[i][1]; sp[2] = v[i][2]; sp[3] = v[i][3]; }
    asm volatile("s_waitcnt lgkmcnt(0)" ::: "memory");
    const int c = lane & 7;
#pragma unroll
    for (int j = 0; j < 4; ++j) { const int n = (lane >> 3) + 8 * j; const LAS float* s = scr + (8 * c) * 33 + n;
        u32x4 o; o.x = cvt_pk(s[0 * 33], s[1 * 33]); o.y = cvt_pk(s[2 * 33], s[3 * 33]); o.z = cvt_pk(s[4 * 33], s[5 * 33]); o.w = cvt_pk(s[6 * 33], s[7 * 33]);
        *(u32x4*)(dst0 + (size_t)n * K + k0 + 8 * c) = o; }
    asm volatile("s_waitcnt lgkmcnt(0)" ::: "memory");
}

__device__ __forceinline__ void phase_prologue(const Ctx& X, LAS unsigned char* lds) {
    const int tid = X.tid, lane = tid & 63, wave = tid >> 6;
    const int gw = X.c * 8 + wave, NGW = X.G * 8;
    LAS float* scr = (LAS float*)(lds + wave * 8704);
    constexpr int I_IN = 32 * 482, I_UQ = 8 * 48, I_UKV = 8 * 64, I_BR = 16 * 64, I_OUT = 32 * 64;
    constexpr int PER_L = I_IN + I_UQ + 2 * I_UKV + 3 * I_BR + I_OUT;
    for (int it = gw; it < NL * PER_L; it += NGW) {
        const int l = it / PER_L; int r = it % PER_L;
        if (r < I_IN) { const int kb = r / 482, nb = r % 482, n0 = nb * 32; const int d0 = n0 < 1024 ? n0 : (n0 < 1088 ? Z_KR + (n0 - 1024) : n0 - 64);
            transpose_item(X.in[11] + (size_t)l * 2048 * INC, 2048, INC, kb * 64, n0, WSP(bf16_t, O_WIN) + ((size_t)l * ZW + d0) * 2048, nullptr, scr, lane); continue; }
        r -= I_IN;
        if (r < I_UQ) { const int kb = r / 48, nb = r % 48;
            transpose_item(X.in[14] + (size_t)l * 512 * 1536, 512, 1536, kb * 64, nb * 32, WSP(bf16_t, O_WUQ) + ((size_t)l * 1536 + nb * 32) * 512, X.in[12] + l * 512, scr, lane); continue; }
        r -= I_UQ;
        if (r < 2 * I_UKV) { const int gfold = r >= I_UKV; if (gfold) r -= I_UKV; const int kb = r / 64, nb = r % 64, n0 = nb * 32, hd = n0 >> 8, d = n0 & 255;
            bf16_t* dst = (d < 128 ? WSP(bf16_t, gfold ? O_WKG : O_WKP) : WSP(bf16_t, gfold ? O_WVG : O_WVP)) + ((size_t)l * 1024 + hd * 128 + (d & 127)) * 512;
            transpose_item(X.in[15] + (size_t)l * 512 * 2048, 512, 2048, kb * 64, n0, dst, gfold ? X.in[13] + l * 512 : nullptr, scr, lane); continue; }
        r -= 2 * I_UKV;
        if (r < 3 * I_BR) { const int br = r / I_BR; r %= I_BR; const int kb = r / 64, nb = r % 64;
            transpose_item(X.in[21 + br] + (size_t)l * 1024 * 2048, 1024, 2048, kb * 64, nb * 32, WSP(bf16_t, O_WBR) + (((size_t)l * 3 + br) * 2048 + nb * 32) * 1024, nullptr, scr, lane); continue; }
        r -= 3 * I_BR;
        { const int kb = r / 64, nb = r % 64;
            transpose_item(X.in[24] + (size_t)l * 2048 * 2048, 2048, 2048, kb * 64, nb * 32, WSP(bf16_t, O_WOUT) + ((size_t)l * 2048 + nb * 32) * 2048, nullptr, scr, lane); }
    }
    const int gt = X.c * NTHREADS + tid, NGT = X.G * NTHREADS;
    for (int i = gt; i < NL * 512 * 512 / 4; i += NGT) { const int e = i * 4, l = e / (512 * 512), rr = (e / 512) % 512, cidx = e % 512, b = rr >> 8, t = rr & 255;
        const f32x4 v = *(const f32x4*)(X.in[2] + (((size_t)b * NL + l) * 256 + t) * 512 + cidx);
        u32x2 w; w.x = cvt_pk(v[0], v[1]); w.y = cvt_pk(v[2], v[3]); *(u32x2*)(WSP(bf16_t, O_CKVC) + e) = w; }
    for (int i = gt; i < NL * 512 * 64 / 4; i += NGT) { const int e = i * 4, l = e / (512 * 64), rr = (e / 64) % 512, cidx = e % 64, b = rr >> 8, t = rr & 255;
        const f32x4 v = *(const f32x4*)(X.in[3] + (((size_t)b * NL + l) * 256 + t) * 64 + cidx);
        u32x2 w; w.x = cvt_pk(v[0], v[1]); w.y = cvt_pk(v[2], v[3]); *(u32x2*)(WSP(bf16_t, O_KRC) + e) = w; }
    for (int i = gt; i < 64 * 16; i += NGT) { const int p = i >> 4, f = i & 15; const float inv = powf(10000.f, -(float)f / 16.f); const float ang = (float)p * inv;
        WSP(float, O_ROPE)[2 * i] = cosf(ang); WSP(float, O_ROPE)[2 * i + 1] = sinf(ang); }
    for (int i = gt; i < 4 * T; i += NGT) WSP(float, O_RSS)[i] = 0.f;
    LAS float* sl = (LAS float*)(lds + 69632);
    LAS float* red = (LAS float*)(lds + 69632 + 24576);
    __syncthreads();
    for (int i = tid; i < 3 * 2048; i += NTHREADS) { const int cidx = i >> 11, k = i & 2047; const float v = cidx == 0 ? X.in[6][k] : X.in[5][(cidx - 1) * 2048 + k]; sl[i] = silu_f(v); }
    __syncthreads();
    for (int un = X.c; un < NL * 192; un += X.G) {
        const int l = un / 192, col0 = (un % 192) * 32, kg = tid >> 3, c4 = tid & 7;
        const float* wp = X.in[7] + (size_t)l * 2048 * 6144 + col0 + 4 * c4;
        f32x4 a0 = {0.f, 0.f, 0.f, 0.f}, a1 = a0, a2 = a0;
#pragma unroll 1
        for (int kb = 0; kb < 32; kb += 8) {
            f32x4 w[8];
#pragma unroll
            for (int q = 0; q < 8; ++q) w[q] = __builtin_nontemporal_load((const f32x4*)(wp + (size_t)(kg + 64 * (kb + q)) * 6144));
            __builtin_amdgcn_sched_barrier(0);
#pragma unroll
            for (int q = 0; q < 8; ++q) { const int k = kg + 64 * (kb + q); a0 += w[q] * sl[k]; a1 += w[q] * sl[2048 + k]; a2 += w[q] * sl[4096 + k]; }
        }
        LAS float* rp = red + (kg * 8 + c4) * 12;
#pragma unroll
        for (int j = 0; j < 4; ++j) { rp[j] = a0[j]; rp[4 + j] = a1[j]; rp[8 + j] = a2[j]; }
        __syncthreads();
        if (tid < 96) { const int cc = tid / 12, jj = tid % 12; float s = 0.f; for (int g = 0; g < 64; ++g) s += red[(g * 8 + cc) * 12 + jj];
            const int cidx = jj >> 2, col = col0 + 4 * cc + (jj & 3); WSP(float, O_MOD)[((size_t)l * 3 + cidx) * 6144 + col] = s + X.in[8][l * 6144 + col]; }
        __syncthreads();
    }
}

__device__ __forceinline__ void phase_rows(const Ctx& X, int l, bool upd, int ln) {
    const int tid = X.tid, lane = tid & 63, wave = tid >> 6;
    const float* mod = WSP(float, O_MOD);
    for (int row0 = (X.c * 8 + wave) * 2; row0 < T; row0 += X.G * 16) {
        f32x4 v[2][8];
#pragma unroll
        for (int rr = 0; rr < 2; ++rr) { const int row = row0 + rr;
            const float* xsrc = (upd && l > 0) || (!upd && ln > 0) ? WSP(float, O_X) + (size_t)row * DM : (row < 4096 ? X.in[0] + (size_t)row * DM : X.in[1] + (size_t)(row - 4096) * DM);
#pragma unroll
            for (int j = 0; j < 8; ++j) v[rr][j] = *(const f32x4*)(xsrc + j * 256 + lane * 4); }
        const int cidx = row0 < 4096 ? 0 : 1 + ((row0 - 4096) >> 11);
        if (upd) {
            const float* gate = mod + ((size_t)l * 3 + cidx) * 6144 + 4096; const float* gp = X.in[10] + l * 2048;
            f32x4 gg[8], y[8];
#pragma unroll
            for (int j = 0; j < 8; ++j) { const int c = j * 256 + lane * 4; gg[j] = *(const f32x4*)(gate + c); y[j] = *(const f32x4*)(gp + c); }
            const float ri0 = rsqrtf(WSP(float, O_RSS)[3 * T + row0] * (1.f / 2048.f) + EPSN), ri1 = rsqrtf(WSP(float, O_RSS)[3 * T + row0 + 1] * (1.f / 2048.f) + EPSN);
            __builtin_amdgcn_sched_barrier(0);
#pragma unroll
            for (int j = 0; j < 8; ++j) gg[j] = gg[j] * y[j];
#pragma unroll
            for (int rr = 0; rr < 2; ++rr) { const int row = row0 + rr; const float ri = rr ? ri1 : ri0; const float* yp = WSP(float, O_Y) + (size_t)row * DM;
#pragma unroll
                for (int j = 0; j < 8; ++j) y[j] = *(const f32x4*)(yp + j * 256 + lane * 4);
                __builtin_amdgcn_sched_barrier(0);
                float* xdst = (l == NL - 1) ? X.out + (row < 4096 ? OUT_YP + (size_t)row * DM : OUT_YS + (size_t)(row - 4096) * DM) : WSP(float, O_X) + (size_t)row * DM;
#pragma unroll
                for (int j = 0; j < 8; ++j) { v[rr][j] += gg[j] * (y[j] * ri); *(f32x4*)(xdst + j * 256 + lane * 4) = v[rr][j]; }
                __builtin_amdgcn_sched_barrier(0); }
        }
        __builtin_amdgcn_sched_barrier(0);
        if (ln < NL) {
            const float* sh = mod + ((size_t)ln * 3 + cidx) * 6144; const float* sc = sh + 2048; const float* gp = X.in[9] + ln * 2048;
            f32x4 s[8], b[8], g[8];
#pragma unroll
            for (int j = 0; j < 8; ++j) { const int c = j * 256 + lane * 4; s[j] = *(const f32x4*)(sc + c); b[j] = *(const f32x4*)(sh + c); g[j] = *(const f32x4*)(gp + c); }
            float ss0 = 0.f, ss1 = 0.f;
#pragma unroll
            for (int j = 0; j < 8; ++j) { ss0 += v[0][j][0] * v[0][j][0] + v[0][j][1] * v[0][j][1] + v[0][j][2] * v[0][j][2] + v[0][j][3] * v[0][j][3];
                ss1 += v[1][j][0] * v[1][j][0] + v[1][j][1] * v[1][j][1] + v[1][j][2] * v[1][j][2] + v[1][j][3] * v[1][j][3]; }
            ss0 = wave_sum(ss0); ss1 = wave_sum(ss1); const float ri0 = rsqrtf(ss0 * (1.f / 2048.f) + EPSN), ri1 = rsqrtf(ss1 * (1.f / 2048.f) + EPSN);
            __builtin_amdgcn_sched_barrier(0);
            bf16_t* hp = WSP(bf16_t, O_H) + (size_t)row0 * DM;
#pragma unroll
            for (int j = 0; j < 8; ++j) { const int c = j * 256 + lane * 4;
                const f32x4 gs = g[j] * (s[j] + 1.f);
                const f32x4 h0 = v[0][j] * ri0 * gs + b[j], h1 = v[1][j] * ri1 * gs + b[j];
                u32x2 w; w.x = cvt_pk(h0[0], h0[1]); w.y = cvt_pk(h0[2], h0[3]); *(u32x2*)(hp + c) = w;
                w.x = cvt_pk(h1[0], h1[1]); w.y = cvt_pk(h1[2], h1[3]); *(u32x2*)(hp + DM + c) = w; }
        }
    }
}

__device__ __forceinline__ void phase_misc(const Ctx& X, int l) {
    const int tid = X.tid, lane = tid & 63, wave = tid >> 6;
    const bf16_t* z = WSP(bf16_t, O_Z);
    for (int row = X.c * 8 + wave; row < 4096; row += X.G * 8) {
        const bf16_t* zr = z + (size_t)row * ZW;
        const int b = row >> 8, t = row & 255;
        const float ri = rsqrtf(WSP(float, O_RSS)[T + row] * (1.f / 512.f) + EPSN);
        const u32x4 w = *(const u32x4*)(zr + Z_CKV + lane * 8); const float* g = X.in[13] + l * 512 + lane * 8;
        const f32x4 g0 = *(const f32x4*)g, g1 = *(const f32x4*)(g + 4);
        float* o = X.out + OUT_CKV + (((size_t)b * NL + l) * 256 + t) * 512 + lane * 8;
        f32x4 o0, o1; o0[0] = bflo(w.x) * ri * g0[0]; o0[1] = bfhi(w.x) * ri * g0[1]; o0[2] = bflo(w.y) * ri * g0[2]; o0[3] = bfhi(w.y) * ri * g0[3];
        o1[0] = bflo(w.z) * ri * g1[0]; o1[1] = bfhi(w.z) * ri * g1[1]; o1[2] = bflo(w.w) * ri * g1[2]; o1[3] = bfhi(w.w) * ri * g1[3];
        *(f32x4*)o = o0; *(f32x4*)(o + 4) = o1;
    }
}
__device__ __forceinline__ void phase_krope(const Ctx& X, int l) {
    const int tid = X.tid, lane = tid & 63, wave = tid >> 6;
    const bf16_t* z = WSP(bf16_t, O_Z); const float* rope = WSP(float, O_ROPE);
    for (int row = X.c * 8 + wave; row < T; row += X.G * 8) {
        float kr = bf2f(z[(size_t)row * ZW + Z_KR + lane]);
        if (row < 4096) { const int b = row >> 8, t = row & 255; X.out[OUT_KR + (((size_t)b * NL + l) * 256 + t) * 64 + lane] = kr; }
        else {
            const int t = (row - 4096) & 2047; const int p = lane < 32 ? (t >> 6) : (t & 63); const int f = lane & 15;
            const float cs = rope[(p * 16 + f) * 2], sn = rope[(p * 16 + f) * 2 + 1];
            const float pr = __shfl_xor(kr, 16);
            kr = (lane & 16) ? kr * cs + pr * sn : kr * cs - pr * sn;
        }
        const float nb = __shfl_down(kr, 1);
        if ((lane & 1) == 0) *(unsigned*)(WSP(bf16_t, O_KR) + (size_t)row * 64 + lane) = cvt_pk(kr, nb);
    }
}
constexpr int PB = 272;
constexpr int BUFB = 128 * PB;
constexpr int PO = 132;
__device__ __forceinline__ void mma128(const LAS unsigned char* As, const LAS unsigned char* Bs, f32x16 (&acc)[2], int wr, int wc, int lane) {
    const int r32 = lane & 31, hi = lane >> 5;
    const LAS unsigned char* ap = As + (32 * wr + r32) * PB + hi * 16;
    const LAS unsigned char* bp = Bs + (64 * wc + r32) * PB + hi * 16;
#pragma unroll 2
    for (int s = 0; s < 8; ++s) {
        const bf16x8 a = *(const LAS bf16x8*)(ap + s * 32);
        const bf16x8 b0 = *(const LAS bf16x8*)(bp + s * 32);
        const bf16x8 b1 = *(const LAS bf16x8*)(bp + 32 * PB + s * 32);
        acc[0] = __builtin_amdgcn_mfma_f32_32x32x16_bf16(a, b0, acc[0], 0, 0, 0);
        acc[1] = __builtin_amdgcn_mfma_f32_32x32x16_bf16(a, b1, acc[1], 0, 0, 0);
    }
}
__device__ __forceinline__ int crow(int r, int hi) { return (r & 3) + 8 * (r >> 2) + 4 * hi; }
__device__ __forceinline__ void stage_tile(LAS unsigned char* dst, const bf16_t* src, size_t ld, int tid) {
#pragma unroll
    for (int i = 0; i < 4; ++i) { const int c = tid + i * NTHREADS, r = c >> 4, ch = c & 15;
        *(LAS u32x4*)(dst + r * PB + ch * 16) = *(const u32x4*)(src + (size_t)r * ld + ch * 8); }
}
__device__ __forceinline__ float log_sigmoid_f(float x) { return -log1pf(expf(-x)); }

__device__ __forceinline__ void sgu_item(const Ctx& X, LAS unsigned char* lds, int l, int item) {
    int tid_ = X.tid; asm volatile("" : "+v"(tid_));
    const int tid = tid_, lane = tid & 63, wave = tid >> 6, wr = wave >> 1, wc = wave & 1;
    const int n = item >> 3, g = item & 7, tok0 = n * 128;
    LAS unsigned char* As = lds; LAS unsigned char* Bs = lds + BUFB; LAS float* Os = (LAS float*)(lds + 2 * BUFB);
    const float* ws = X.in[17] + ((size_t)l * 8 + g) * 16384; const float* rss = WSP(float, O_RSS) + 2 * T + tok0;
    { f32x4 w0[4], w1[4], s0[4], s1[4];
#pragma unroll
      for (int i = 0; i < 4; ++i) { const int c = tid + i * NTHREADS, r = c >> 4, ch = c & 15;
          w0[i] = *(const f32x4*)(ws + r * 128 + ch * 8); w1[i] = *(const f32x4*)(ws + r * 128 + ch * 8 + 4); s0[i] = *(const f32x4*)(rss + ch * 8); s1[i] = *(const f32x4*)(rss + ch * 8 + 4); }
      __builtin_amdgcn_sched_barrier(0);
#pragma unroll
      for (int i = 0; i < 4; ++i) { const int c = tid + i * NTHREADS, r = c >> 4, ch = c & 15;
          u32x4 o; o.x = cvt_pk(w0[i][0] * rsqrtf(s0[i][0] * (1.f / 1024.f) + EPSN), w0[i][1] * rsqrtf(s0[i][1] * (1.f / 1024.f) + EPSN));
          o.y = cvt_pk(w0[i][2] * rsqrtf(s0[i][2] * (1.f / 1024.f) + EPSN), w0[i][3] * rsqrtf(s0[i][3] * (1.f / 1024.f) + EPSN));
          o.z = cvt_pk(w1[i][0] * rsqrtf(s1[i][0] * (1.f / 1024.f) + EPSN), w1[i][1] * rsqrtf(s1[i][1] * (1.f / 1024.f) + EPSN));
          o.w = cvt_pk(w1[i][2] * rsqrtf(s1[i][2] * (1.f / 1024.f) + EPSN), w1[i][3] * rsqrtf(s1[i][3] * (1.f / 1024.f) + EPSN));
          *(LAS u32x4*)(As + r * PB + ch * 16) = o; } }
    stage_tile(Bs, WSP(bf16_t, O_VST) + (size_t)(g * 128) * T + tok0, T, tid);
    const int p = tid >> 2, cseg = (tid & 3) * 32; const bf16_t* zr = WSP(bf16_t, O_Z) + (size_t)(tok0 + p) * ZW;
    u32x4 uu4[4], gg4[4]; f32x4 gs4[8];
#pragma unroll
    for (int i = 0; i < 4; ++i) { uu4[i] = *(const u32x4*)(zr + Z_U + g * 128 + cseg + i * 8); gg4[i] = *(const u32x4*)(zr + Z_GPS + g * 128 + cseg + i * 8); }
#pragma unroll
    for (int i = 0; i < 8; ++i) gs4[i] = *(const f32x4*)(X.in[16] + l * 1024 + g * 128 + cseg + i * 4);
    const float bs = X.in[18][((size_t)l * 128 + p) * 8 + g];
    __syncthreads();
    f32x16 acc[2]; acc[0] = (f32x16)(0.f); acc[1] = (f32x16)(0.f);
    mma128(As, Bs, acc, wr, wc, lane);
    { const int hi = lane >> 5, cb = 64 * wc + (lane & 31);
#pragma unroll
      for (int t = 0; t < 2; ++t)
#pragma unroll
        for (int r = 0; r < 16; ++r) Os[(32 * wr + crow(r, hi)) * PO + cb + 32 * t] = acc[t][r]; }
    __syncthreads();
    {
      bf16_t* op = WSP(bf16_t, O_AS) + (size_t)(tok0 + p) * 1024 + g * 128 + cseg;
#pragma unroll
      for (int i = 0; i < 4; ++i) {
          const u32x4 uu = uu4[i], gg = gg4[i];
          const f32x4 s0 = *(const LAS f32x4*)(Os + p * PO + cseg + i * 8), s1 = *(const LAS f32x4*)(Os + p * PO + cseg + i * 8 + 4);
          const f32x4 g0 = gs4[2 * i], g1 = gs4[2 * i + 1];
          u32x4 o; o.x = cvt_pk((s0[0] * g0[0] + bs) * bflo(uu.x) * bflo(gg.x), (s0[1] * g0[1] + bs) * bfhi(uu.x) * bfhi(gg.x));
          o.y = cvt_pk((s0[2] * g0[2] + bs) * bflo(uu.y) * bflo(gg.y), (s0[3] * g0[3] + bs) * bfhi(uu.y) * bfhi(gg.y));
          o.z = cvt_pk((s1[0] * g1[0] + bs) * bflo(uu.z) * bflo(gg.z), (s1[1] * g1[1] + bs) * bfhi(uu.z) * bfhi(gg.z));
          o.w = cvt_pk((s1[2] * g1[2] + bs) * bflo(uu.w) * bflo(gg.w), (s1[3] * g1[3] + bs) * bfhi(uu.w) * bfhi(gg.w));
          *(u32x4*)(op + i * 8) = o; } }
    __syncthreads();
}

__device__ __forceinline__ void retstate_item(const Ctx& X, LAS unsigned char* lds, int l, int item) {
    int tid_ = X.tid; asm volatile("" : "+v"(tid_));
    const int tid = tid_, lane = tid & 63, wave = tid >> 6, wr = wave >> 1, wc = wave & 1;
    const int n = item >> 3, hd = item & 7, tok0 = n * 128;
    LAS unsigned char* As = lds; LAS unsigned char* Bf = lds + BUFB; LAS unsigned char* Bb = lds + 2 * BUFB;
    const float lgf = log_sigmoid_f(X.in[19][(l * 2 + 0) * 8 + hd]) * 1.4426950408889634f, lgb = log_sigmoid_f(X.in[19][(l * 2 + 1) * 8 + hd]) * 1.4426950408889634f;
    stage_tile(As, WSP(bf16_t, O_RVT) + (size_t)(hd * 128) * T + tok0, T, tid);
    { const bf16_t* kz = WSP(bf16_t, O_Z) + (size_t)tok0 * ZW + Z_RK + hd * 128;
      const int j0 = 2 * lane;
      const float wf0 = exp2f(lgf * (float)(127 - j0)), wf1 = exp2f(lgf * (float)(126 - j0)), wb0 = exp2f(lgb * (float)j0), wb1 = exp2f(lgb * (float)(j0 + 1));
      u32x4 wa[2], wb[2];
#pragma unroll
      for (int i = 0; i < 2; ++i) { const int d0 = (wave * 2 + i) * 8; wa[i] = *(const u32x4*)(kz + (size_t)j0 * ZW + d0); wb[i] = *(const u32x4*)(kz + (size_t)(j0 + 1) * ZW + d0); }
#pragma unroll
      for (int i = 0; i < 2; ++i) { const int d0 = (wave * 2 + i) * 8;
          const float ka[8] = {bflo(wa[i].x), bfhi(wa[i].x), bflo(wa[i].y), bfhi(wa[i].y), bflo(wa[i].z), bfhi(wa[i].z), bflo(wa[i].w), bfhi(wa[i].w)};
          const float kb[8] = {bflo(wb[i].x), bfhi(wb[i].x), bflo(wb[i].y), bfhi(wb[i].y), bflo(wb[i].z), bfhi(wb[i].z), bflo(wb[i].w), bfhi(wb[i].w)};
#pragma unroll
          for (int e = 0; e < 8; ++e) { *(LAS unsigned*)(Bf + (d0 + e) * PB + j0 * 2) = cvt_pk(ka[e] * wf0, kb[e] * wf1); *(LAS unsigned*)(Bb + (d0 + e) * PB + j0 * 2) = cvt_pk(ka[e] * wb0, kb[e] * wb1); } } }
    __syncthreads();
    f32x16 af[2], ab[2]; af[0] = (f32x16)(0.f); af[1] = (f32x16)(0.f); ab[0] = (f32x16)(0.f); ab[1] = (f32x16)(0.f);
    mma128(As, Bf, af, wr, wc, lane); mma128(As, Bb, ab, wr, wc, lane);
    float* st = WSP(float, O_ST) + ((size_t)(n * 8 + hd) * 2) * 16384;
    { const int hi = lane >> 5, cb = 64 * wc + (lane & 31);
#pragma unroll
      for (int t = 0; t < 2; ++t)
#pragma unroll
        for (int r = 0; r < 16; ++r) { const int e = 32 * wr + crow(r, hi); st[e * 128 + cb + 32 * t] = af[t][r]; st[16384 + e * 128 + cb + 32 * t] = ab[t][r]; } }
    __syncthreads();
}

__device__ __forceinline__ void retout_item(const Ctx& X, LAS unsigned char* lds, int l, int item) {
    int tid_ = X.tid; asm volatile("" : "+v"(tid_));
    const int tid = tid_, lane = tid & 63, wave = tid >> 6, wr = wave >> 1, wc = wave & 1;
    const int n = item >> 3, hd = item & 7, tok0 = n * 128;
    LAS unsigned char* B0 = lds; LAS unsigned char* B1 = lds + BUFB; LAS unsigned char* B2 = lds + 2 * BUFB; LAS unsigned char* B3 = lds + 3 * BUFB;
    LAS unsigned char* B4 = lds + 4 * BUFB;
    const float lgf = log_sigmoid_f(X.in[19][(l * 2 + 0) * 8 + hd]) * 1.4426950408889634f, lgb = log_sigmoid_f(X.in[19][(l * 2 + 1) * 8 + hd]) * 1.4426950408889634f;
    const bf16_t* z = WSP(bf16_t, O_Z); const bf16_t* pf = WSP(bf16_t, O_PF) + (size_t)(n * 8 + hd) * 2 * 16384;
    (void)B4;
    stage_tile(B0, z + (size_t)tok0 * ZW + Z_RQ + hd * 128, ZW, tid);
    stage_tile(B1, z + (size_t)tok0 * ZW + Z_RK + hd * 128, ZW, tid);
    stage_tile(B3, WSP(bf16_t, O_RVT) + (size_t)(hd * 128) * T + tok0, T, tid);
    u32x4 pfr[2][4];
#pragma unroll
    for (int d = 0; d < 2; ++d)
#pragma unroll
        for (int i = 0; i < 4; ++i) { const int c = tid + i * NTHREADS; pfr[d][i] = *(const u32x4*)(pf + d * 16384 + (size_t)(c >> 4) * 128 + (c & 15) * 8); }
    const int p_ = tid >> 2, cseg_ = (tid & 3) * 32;
    u32x4 gpr[4]; f32x4 grr[8];
#pragma unroll
    for (int q = 0; q < 4; ++q) gpr[q] = *(const u32x4*)(z + (size_t)(tok0 + p_) * ZW + Z_GPR + hd * 128 + cseg_ + q * 8);
#pragma unroll
    for (int q = 0; q < 8; ++q) grr[q] = *(const f32x4*)(X.in[20] + l * 1024 + hd * 128 + cseg_ + q * 4);
    __syncthreads();
    const int hi = lane >> 5, cb = 64 * wc + (lane & 31);
    { f32x16 aw[2]; aw[0] = (f32x16)(0.f); aw[1] = (f32x16)(0.f);
      mma128(B0, B1, aw, wr, wc, lane);
#pragma unroll
      for (int t = 0; t < 2; ++t)
#pragma unroll
        for (int r = 0; r < 16; ++r) { const int i = 32 * wr + crow(r, hi), j = cb + 32 * t; const float dd = (float)(i - j);
            const float dec = (i >= j) ? __builtin_amdgcn_exp2f(lgf * dd) : __builtin_amdgcn_exp2f(-lgb * dd);
            *(LAS bf16_t*)(B2 + i * PB + j * 2) = (bf16_t)(cvt_pk(aw[t][r] * dec, 0.f) & 0xffffu); } }
    __syncthreads();
#pragma unroll
    for (int i = 0; i < 4; ++i) { const int c = tid + i * NTHREADS; *(LAS u32x4*)(B1 + (c >> 4) * PB + (c & 15) * 16) = pfr[0][i]; }
    f32x16 ao[2]; ao[0] = (f32x16)(0.f); ao[1] = (f32x16)(0.f);
    mma128(B2, B3, ao, wr, wc, lane);
    __syncthreads();
#pragma unroll
    for (int i = 0; i < 4; ++i) { const int c = tid + i * NTHREADS; *(LAS u32x4*)(B3 + (c >> 4) * PB + (c & 15) * 16) = pfr[1][i]; }
    f32x16 ac[2]; ac[0] = (f32x16)(0.f); ac[1] = (f32x16)(0.f);
    mma128(B0, B1, ac, wr, wc, lane);
#pragma unroll
    for (int t = 0; t < 2; ++t)
#pragma unroll
        for (int r = 0; r < 16; ++r) { const int i = 32 * wr + crow(r, hi); ao[t][r] += ac[t][r] * __builtin_amdgcn_exp2f(lgf * (float)(i + 1)); }
    __syncthreads();
    ac[0] = (f32x16)(0.f); ac[1] = (f32x16)(0.f);
    mma128(B0, B3, ac, wr, wc, lane);
    LAS float* Os = (LAS float*)(lds + BUFB);
#pragma unroll
    for (int t = 0; t < 2; ++t)
#pragma unroll
        for (int r = 0; r < 16; ++r) { const int i = 32 * wr + crow(r, hi); Os[i * PO + cb + 32 * t] = ao[t][r] + ac[t][r] * __builtin_amdgcn_exp2f(lgb * (float)(128 - i)); }
    __syncthreads();
    { const int p = tid >> 2, cseg = (tid & 3) * 32; f32x4 v[8]; float s = 0.f;
#pragma unroll
      for (int q = 0; q < 8; ++q) { v[q] = *(const LAS f32x4*)(Os + p * PO + cseg + q * 4); s += v[q][0] + v[q][1] + v[q][2] + v[q][3]; }
      s += __shfl_xor(s, 1); s += __shfl_xor(s, 2); const float mu = s * (1.f / 128.f); float s2 = 0.f;
#pragma unroll
      for (int q = 0; q < 8; ++q) { v[q] = v[q] - mu; s2 += v[q][0] * v[q][0] + v[q][1] * v[q][1] + v[q][2] * v[q][2] + v[q][3] * v[q][3]; }
      s2 += __shfl_xor(s2, 1); s2 += __shfl_xor(s2, 2); const float rs = rsqrtf(s2 * (1.f / 128.f) + EPSN);

      bf16_t* op = WSP(bf16_t, O_AR) + (size_t)(tok0 + p) * 1024 + hd * 128 + cseg;
#pragma unroll
      for (int q = 0; q < 4; ++q) { const u32x4 gg = gpr[q]; const f32x4 g0 = grr[2 * q], g1 = grr[2 * q + 1]; const f32x4 a = v[2 * q] * rs * g0, b = v[2 * q + 1] * rs * g1;
          u32x4 o; o.x = cvt_pk(a[0] * bflo(gg.x), a[1] * bfhi(gg.x)); o.y = cvt_pk(a[2] * bflo(gg.y), a[3] * bfhi(gg.y)); o.z = cvt_pk(b[0] * bflo(gg.z), b[1] * bfhi(gg.z)); o.w = cvt_pk(b[2] * bflo(gg.w), b[3] * bfhi(gg.w));
          *(u32x4*)(op + q * 8) = o; } }
    __syncthreads();
}

__device__ __forceinline__ void phase_prefix(const Ctx& X, int l) {
    const int tid = X.tid;
    const float* stb = WSP(float, O_ST); bf16_t* pf = WSP(bf16_t, O_PF);
    for (int it = X.c; it < 256; it += X.G) {
        const int chain = it >> 3, sl = it & 7, b = chain >> 4, hd = (chain >> 1) & 7, dir = chain & 1;
        const int e = sl * 16 + (tid >> 5), d4 = (tid & 31) * 4, n0 = 32 + b * 16;
        const float gc = exp2f(128.f * 1.4426950408889634f * log_sigmoid_f(X.in[19][(l * 2 + dir) * 8 + hd]));
        f32x4 S[16];
#pragma unroll
        for (int j = 0; j < 16; ++j) S[j] = *(const f32x4*)(stb + ((size_t)((n0 + j) * 8 + hd) * 2 + dir) * 16384 + e * 128 + d4);
        const float* s0 = X.in[4] + ((((size_t)b * NL + l) * 2 + dir) * 8 + hd) * 16384;
        f32x4 R; R[0] = s0[(size_t)(d4 + 0) * 128 + e]; R[1] = s0[(size_t)(d4 + 1) * 128 + e]; R[2] = s0[(size_t)(d4 + 2) * 128 + e]; R[3] = s0[(size_t)(d4 + 3) * 128 + e];
#pragma unroll
        for (int jj = 0; jj < 16; ++jj) { const int j = dir ? 15 - jj : jj;
            u32x2 o; o.x = cvt_pk(R[0], R[1]); o.y = cvt_pk(R[2], R[3]);
            *(u32x2*)(pf + ((size_t)((n0 + j) * 8 + hd) * 2 + dir) * 16384 + e * 128 + d4) = o;
            R = R * gc + S[j]; }
    }
    for (int it = X.c; it < 256; it += X.G) {
        const int s = it >> 4, hd = (it >> 1) & 7, dir = it & 1, n0 = s * 2;
        const float gc = exp2f(128.f * 1.4426950408889634f * log_sigmoid_f(X.in[19][(l * 2 + dir) * 8 + hd]));
        float* o = X.out + OUT_RET + ((((size_t)s * NL + l) * 2 + dir) * 8 + hd) * 16384;
        const int nfirst = dir ? n0 + 1 : n0, nsecond = dir ? n0 : n0 + 1;
#pragma unroll
        for (int k = 0; k < 8; ++k) { const int idx = (k * NTHREADS + tid) * 4, e = idx >> 7, d4 = idx & 127;
            const f32x4 Sa = *(const f32x4*)(stb + ((size_t)(nfirst * 8 + hd) * 2 + dir) * 16384 + idx), Sb = *(const f32x4*)(stb + ((size_t)(nsecond * 8 + hd) * 2 + dir) * 16384 + idx);
            u32x2 z0; z0.x = 0u; z0.y = 0u; u32x2 w; w.x = cvt_pk(Sa[0], Sa[1]); w.y = cvt_pk(Sa[2], Sa[3]);
            *(u32x2*)(pf + ((size_t)(nfirst * 8 + hd) * 2 + dir) * 16384 + idx) = z0;
            *(u32x2*)(pf + ((size_t)(nsecond * 8 + hd) * 2 + dir) * 16384 + idx) = w;
            const f32x4 f = Sa * gc + Sb;
            o[(size_t)(d4 + 0) * 128 + e] = f[0]; o[(size_t)(d4 + 1) * 128 + e] = f[1]; o[(size_t)(d4 + 2) * 128 + e] = f[2]; o[(size_t)(d4 + 3) * 128 + e] = f[3]; }
    }
}
constexpr int KPB = 400;
constexpr int VPB = 272;
constexpr int ATT_KB = 128 * KPB;
__device__ __forceinline__ float xmax16(float x) { const unsigned u = __float_as_uint(x); auto r = __builtin_amdgcn_permlane16_swap(u, u, false, false); return fmaxf(__uint_as_float(r[0]), __uint_as_float(r[1])); }
__device__ __forceinline__ float xmax32(float x) { const unsigned u = __float_as_uint(x); auto r = __builtin_amdgcn_permlane32_swap(u, u, false, false); return fmaxf(__uint_as_float(r[0]), __uint_as_float(r[1])); }
__device__ __forceinline__ float xsum16(float x) { const unsigned u = __float_as_uint(x); auto r = __builtin_amdgcn_permlane16_swap(u, u, false, false); return __uint_as_float(r[0]) + __uint_as_float(r[1]); }
__device__ __forceinline__ float xsum32(float x) { const unsigned u = __float_as_uint(x); auto r = __builtin_amdgcn_permlane32_swap(u, u, false, false); return __uint_as_float(r[0]) + __uint_as_float(r[1]); }
__device__ __forceinline__ void attn_unit(const Ctx& X, LAS unsigned char* lds, int l, int unit) {
    int tid_ = X.tid; asm volatile("" : "+v"(tid_));
    const int tid = tid_, lane = tid & 63, wave = tid >> 6, qi = lane & 15, g = lane >> 4;
    const int rbw = wave & 3, kh = wave >> 2;
    int tokb, ncache, nnew, hd, qb, bc = 0;
    if (unit < 256) { bc = unit >> 7; hd = (unit >> 4) & 7; qb = unit & 15; tokb = 4096 + bc * 2048; ncache = 256; nnew = 2048; }
    else { const int r = unit - 256; const int s = r >> 4; hd = (r >> 1) & 7; qb = r & 1; tokb = s * 256; ncache = 0; nnew = 256; }
    const int nct = ncache >> 7, ntile = (ncache + nnew) >> 7;
    const bf16_t* KN = WSP(bf16_t, O_KN); const bf16_t* KR = WSP(bf16_t, O_KR); const bf16_t* VT = WSP(bf16_t, O_VT);
    const bf16_t* KC = WSP(bf16_t, O_KC) + (size_t)l * 512 * 1024; const bf16_t* KRC = WSP(bf16_t, O_KRC) + (size_t)l * 512 * 64; const bf16_t* VTC = WSP(bf16_t, O_VTC) + (size_t)l * 1024 * 512;
    const int tokq = tokb + qb * 128 + rbw * 32 + qi;
    LAS unsigned char* qb_l = lds + ATT_KB + 128 * VPB;
    const LAS unsigned char* qbase = qb_l + (32 * rbw + qi) * KPB + 16 * g;
    LAS unsigned char* kb = lds; LAS unsigned char* vb = lds + ATT_KB;
    u32x4 sk[4], sr[2], sv[4];
#define ATT_LOAD(j) do { const int _j = (j); const bf16_t *kn_, *kr_, *vt_; size_t ldv_; \
        if (_j < nct) { const int r0 = bc * 256 + _j * 128; kn_ = KC + (size_t)r0 * 1024 + hd * 128; kr_ = KRC + (size_t)r0 * 64; vt_ = VTC + (size_t)(hd * 128) * 512 + r0; ldv_ = 512; } \
        else { const int r0 = tokb + (_j - nct) * 128; kn_ = KN + (size_t)r0 * 1024 + hd * 128; kr_ = KR + (size_t)r0 * 64; vt_ = VT + (size_t)(hd * 128) * T + r0; ldv_ = T; } \
        _Pragma("unroll") for (int i = 0; i < 4; ++i) { const int c = tid + i * NTHREADS; sk[i] = *(const u32x4*)(kn_ + (size_t)(c >> 4) * 1024 + (c & 15) * 8); sv[i] = *(const u32x4*)(vt_ + (size_t)(c >> 4) * ldv_ + (c & 15) * 8); } \
        _Pragma("unroll") for (int i = 0; i < 2; ++i) { const int c = tid + i * NTHREADS; sr[i] = *(const u32x4*)(kr_ + (size_t)(c >> 3) * 64 + (c & 7) * 8); } } while (0)
#define ATT_STORE() do { \
        _Pragma("unroll") for (int i = 0; i < 4; ++i) { const int c = tid + i * NTHREADS; *(LAS u32x4*)(kb + (c >> 4) * KPB + (c & 15) * 16) = sk[i]; *(LAS u32x4*)(vb + (c >> 4) * VPB + (c & 15) * 16) = sv[i]; } \
        _Pragma("unroll") for (int i = 0; i < 2; ++i) { const int c = tid + i * NTHREADS; *(LAS u32x4*)(kb + (c >> 3) * KPB + 256 + (c & 7) * 16) = sr[i]; } } while (0)
    f32x4 O[2][8];
#pragma unroll
    for (int rb = 0; rb < 2; ++rb)
#pragma unroll
        for (int u = 0; u < 8; ++u) O[rb][u] = (f32x4){0.f, 0.f, 0.f, 0.f};
    float mrun[2] = {-INFINITY, -INFINITY}, lrun[2] = {0.f, 0.f};
    const LAS unsigned char* kbase = kb + (64 * kh + qi) * KPB + 16 * g;
    const LAS unsigned char* vbase = vb + qi * VPB + (64 * kh + 4 * g) * 2;
    ATT_LOAD(0);
    u32x4 qst[6];
    { const bf16_t* qp = WSP(bf16_t, O_Q) + (size_t)(tokb + qb * 128) * 1536 + hd * 192;
#pragma unroll
      for (int i = 0; i < 6; ++i) { const int c = tid + i * NTHREADS, r = c / 24, ch = c % 24; qst[i] = *(const u32x4*)(qp + (size_t)r * 1536 + ch * 8); } }
#pragma unroll
    for (int i = 0; i < 6; ++i) { const int c = tid + i * NTHREADS, r = c / 24, ch = c % 24; *(LAS u32x4*)(qb_l + r * KPB + ch * 16) = qst[i]; }
    ATT_STORE();
    __syncthreads();
    for (int j = 0; j < ntile; ++j) {
        if (j + 1 < ntile) ATT_LOAD(j + 1);
        f32x4 S[2][4];
#pragma unroll
        for (int t = 0; t < 4; ++t) { S[0][t] = (f32x4){0.f, 0.f, 0.f, 0.f}; S[1][t] = (f32x4){0.f, 0.f, 0.f, 0.f}; }
#pragma unroll
        for (int s = 0; s < 6; ++s) { const bf16x8 q0 = *(const LAS bf16x8*)(qbase + 64 * s), q1 = *(const LAS bf16x8*)(qbase + 16 * KPB + 64 * s);
#pragma unroll
            for (int t = 0; t < 4; ++t) { const bf16x8 a = *(const LAS bf16x8*)(kbase + 16 * t * KPB + 64 * s);
                S[0][t] = __builtin_amdgcn_mfma_f32_16x16x32_bf16(a, q0, S[0][t], 0, 0, 0);
                S[1][t] = __builtin_amdgcn_mfma_f32_16x16x32_bf16(a, q1, S[1][t], 0, 0, 0); } }
        bf16x8 pb[2][2];
#pragma unroll
        for (int rb = 0; rb < 2; ++rb) {
            float mx = S[rb][0][0];
#pragma unroll
            for (int t = 0; t < 4; ++t)
#pragma unroll
                for (int i = 0; i < 4; ++i) mx = fmaxf(mx, S[rb][t][i]);
            if (!__all(mx - mrun[rb] <= 11.f)) { mx = xmax32(xmax16(mx)); const float mnew_ = fmaxf(mrun[rb], mx), alpha = __builtin_amdgcn_exp2f(mrun[rb] - mnew_); mrun[rb] = mnew_; lrun[rb] *= alpha;
#pragma unroll
                for (int u = 0; u < 8; ++u) O[rb][u] = O[rb][u] * alpha; }
            const float mnew = mrun[rb];
            float ps = 0.f;
#pragma unroll
            for (int t = 0; t < 4; ++t)
#pragma unroll
                for (int i = 0; i < 4; ++i) { S[rb][t][i] = __builtin_amdgcn_exp2f(S[rb][t][i] - mnew); ps += S[rb][t][i]; }
            lrun[rb] += ps;
#pragma unroll
            for (int c = 0; c < 2; ++c) { u32x4 pw; pw.x = cvt_pk(S[rb][2 * c][0], S[rb][2 * c][1]); pw.y = cvt_pk(S[rb][2 * c][2], S[rb][2 * c][3]); pw.z = cvt_pk(S[rb][2 * c + 1][0], S[rb][2 * c + 1][1]); pw.w = cvt_pk(S[rb][2 * c + 1][2], S[rb][2 * c + 1][3]);
                pb[rb][c] = __builtin_bit_cast(bf16x8, pw); }
        }
#pragma unroll
        for (int c = 0; c < 2; ++c)
#pragma unroll
            for (int u = 0; u < 8; ++u) { const LAS unsigned char* vp = vbase + 16 * u * VPB + 64 * c;
                const u32x2 lo = *(const LAS u32x2*)vp, hi2 = *(const LAS u32x2*)(vp + 32);
                u32x4 aw; aw.x = lo.x; aw.y = lo.y; aw.z = hi2.x; aw.w = hi2.y; const bf16x8 av = __builtin_bit_cast(bf16x8, aw);
                O[0][u] = __builtin_amdgcn_mfma_f32_16x16x32_bf16(av, pb[0][c], O[0][u], 0, 0, 0);
                O[1][u] = __builtin_amdgcn_mfma_f32_16x16x32_bf16(av, pb[1][c], O[1][u], 0, 0, 0); }
        __syncthreads();
        if (j + 1 < ntile) { ATT_STORE(); __syncthreads(); }
    }
    lrun[0] = xsum32(xsum16(lrun[0])); lrun[1] = xsum32(xsum16(lrun[1]));
    LAS float* xch = (LAS float*)lds + (size_t)rbw * 68 * 64 + lane;
    if (kh == 1) {
#pragma unroll
        for (int rb = 0; rb < 2; ++rb) {
#pragma unroll
            for (int u = 0; u < 8; ++u)
#pragma unroll
                for (int i = 0; i < 4; ++i) xch[(rb * 34 + u * 4 + i) * 64] = O[rb][u][i];
            xch[(rb * 34 + 32) * 64] = mrun[rb]; xch[(rb * 34 + 33) * 64] = lrun[rb]; }
    }
    __syncthreads();
    if (kh == 0) {
#pragma unroll
        for (int rb = 0; rb < 2; ++rb) {
            const float m1 = xch[(rb * 34 + 32) * 64], l1 = xch[(rb * 34 + 33) * 64];
            const float m = fmaxf(mrun[rb], m1), a0 = __builtin_amdgcn_exp2f(mrun[rb] - m), a1 = __builtin_amdgcn_exp2f(m1 - m);
            const float il = 1.f / (lrun[rb] * a0 + l1 * a1);
            const int tq = tokq + 16 * rb;
            const bf16_t* gp = WSP(bf16_t, O_Z) + (size_t)tq * ZW + Z_GPM + hd * 128 + 4 * g; bf16_t* op = WSP(bf16_t, O_AM) + (size_t)tq * 1024 + hd * 128 + 4 * g;
#pragma unroll
            for (int u = 0; u < 8; ++u) { const u32x2 gg = *(const u32x2*)(gp + 16 * u); f32x4 o;
#pragma unroll
                for (int i = 0; i < 4; ++i) o[i] = (O[rb][u][i] * a0 + xch[(rb * 34 + u * 4 + i) * 64] * a1) * il;
                u32x2 w; w.x = cvt_pk(o[0] * bflo(gg.x), o[1] * bfhi(gg.x)); w.y = cvt_pk(o[2] * bflo(gg.y), o[3] * bfhi(gg.y));
                *(u32x2*)(op + 16 * u) = w; } }
    }
    __syncthreads();
#undef ATT_LOAD
#undef ATT_STORE
}
constexpr int NPHASE = 2 + 7 * NL;
#define REOPAQUE(X) do { unsigned long long w_ = (unsigned long long)args.ws, o_ = (unsigned long long)args.out, i_ = (unsigned long long)__builtin_amdgcn_kernarg_segment_ptr(); int t_ = threadIdx.x, c_ = blockIdx.x, g_ = gridDim.x; \
    asm volatile("" : "+s"(w_), "+s"(o_), "+s"(i_), "+v"(t_), "+s"(c_), "+s"(g_)); X.ws = (unsigned char*)(GAS unsigned char*)w_; X.out = (float*)(GAS float*)o_; X.in.p = (CPtr64)i_; X.tid = t_; X.c = c_; X.G = g_; } while (0)
#ifndef PROBE_SP
#define PROBE_SP -1
#endif
#ifndef RPTM
#define RPTM 0
#endif
#define NREP(k) ((((RPTM) >> (k)) & 1) + 1)
#ifndef PHM
#define PHM 0xffff
#endif
__global__ void __launch_bounds__(NTHREADS, 2) mk_fwd(Args args) {
    extern __shared__ __attribute__((aligned(16))) unsigned char lds_raw[];
    LAS unsigned char* lds = (LAS unsigned char*)lds_raw;
    cg::grid_group grid = cg::this_grid();
    volatile LAS unsigned* bst = (volatile LAS unsigned*)(lds + LDS_BYTES - 64);
    if (threadIdx.x < 16) bst[threadIdx.x] = 0u;
    __syncthreads();
    XcdBarrier xbar = xcd_barrier_post((unsigned*)(args.ws + O_BAR), bst);
#if PROBE_SP >= 0
    unsigned long long pacc = 0ull;
#endif
    for (int ph = args.ph_lo; ph < args.ph_hi; ++ph) {
#if PROBE_SP >= 0
        const unsigned long long pt0 = __builtin_amdgcn_s_memrealtime();
#endif
        Ctx X; REOPAQUE(X);
        const int tid = X.tid;
        const char* ws = (const char*)X.ws;
        if (ph == 0) { for (int rep = 0; rep < NREP(0); ++rep) if (PHM & 1) phase_prologue(X, lds); }
        else if (ph == 1) { for (int rep = 0; rep < NREP(1); ++rep) {
            if (PHM & 4) phase_rows(X, 0, false, 0); }
        } else {
            const int l = (ph - 2) / 7, sp7 = (ph - 2) % 7, sp = sp7 < 2 ? sp7 : sp7 - 1;
            if (sp7 == 2) { phase_prefix(X, l); REOPAQUE(X); phase_krope(X, l); }
            else if (sp == 0) {
                SchedZ S{ws + O_H, ws + O_WIN + (size_t)l * ZW * 2048 * 2, X.G, X.c, 0}; EpiZ E{WSP(bf16_t, O_Z), WSP(bf16_t, O_VST), WSP(bf16_t, O_RVT), WSP(float, O_RSS), true};
                if (PHM & 8) pg8::gemm_phase(lds, tid, 2048, 2048, 2048, S, E);
            } else if (sp == 1) {
                for (int i = tid; i < 2048; i += NTHREADS) ((LAS float*)(lds + 131072))[i] = WSP(float, O_ROPE)[i];
                __syncthreads();
                { SchedZ S{ws + O_H, ws + O_WIN + (size_t)l * ZW * 2048 * 2, X.G, X.c, 1}; EpiZ E{WSP(bf16_t, O_Z), WSP(bf16_t, O_VST), WSP(bf16_t, O_RVT), WSP(float, O_RSS), true};
                  if (PHM & 8) pg8::gemm_phase(lds, tid, 2048, 2048, 2048, S, E); }
                REOPAQUE(X);
                { const char* ws2 = (const char*)X.ws;
                  SchedQK S{ws2 + O_Z, ws2 + O_WUQ + (size_t)l * 1536 * 512 * 2, ws2 + O_WKG + (size_t)l * 1024 * 512 * 2, X.G, X.c}; EpiQK E{WSP(bf16_t, O_Q), WSP(bf16_t, O_KN), WSP(float, O_RSS), (const LAS float*)(lds + 131072)};
                  if (PHM & 16) pg8::gemm_phase(lds, X.tid, 512, ZW, 512, S, E); }
                { const char* ws2 = (const char*)X.ws;
                  SchedVT S{ws2 + O_Z, ws2 + O_WVG + (size_t)l * 1024 * 512 * 2, X.G, X.c}; EpiVT E{WSP(bf16_t, O_VT), WSP(float, O_RSS)};
                  if (PHM & 32) pg8::gemm_phase(lds, X.tid, 512, 512, ZW, S, E); }
                REOPAQUE(X);
                { const char* ws2 = (const char*)X.ws;
                  SchedC S2{ws2 + O_CKVC, ws2 + O_WKP, ws2 + O_WVP, X.G, X.c, l}; EpiC E2{WSP(bf16_t, O_KC), WSP(bf16_t, O_VTC)};
                  if (PHM & 2) pg8::gemm_phase(lds, X.tid, 512, 512, 512, S2, E2); }
                REOPAQUE(X); if (PHM & 64) phase_misc(X, l);
                REOPAQUE(X);
                { int i0, i1;
                  if (X.G == 256) { const int c = X.c; if (c < 16) { i0 = 2 * c; i1 = i0 + 2; } else if (c < 96) { i0 = 32 + 4 * (c - 16); i1 = i0 + 4; } else if (c < 160) { i0 = 352 + 3 * (c - 96); i1 = i0 + 3; } else { i0 = 544 + 5 * (c - 160); i1 = i0 + 5; } }
                  else { const int per = (1024 + X.G - 1) / X.G; i0 = X.c * per; i1 = i0 + per < 1024 ? i0 + per : 1024; }
                  for (int it = i0; it < i1; ++it) { if (it < 512) { if (PHM & 128) sgu_item(X, lds, l, it); } else { if (PHM & 256) retstate_item(X, lds, l, it - 512); } } }
            } else if (sp == 2) { for (int rep = 0; rep < NREP(4); ++rep) {
                for (int i = X.c * NTHREADS + tid; i < T; i += X.G * NTHREADS) WSP(float, O_RSS)[3 * T + i] = 0.f;
#if PROBE_SP == 200 || PROBE_SP == 201
                const unsigned long long pa0 = __builtin_amdgcn_s_memrealtime();
#endif
                for (int r2 = 0; r2 < NREP(7); ++r2)
                for (int it = X.c; it < 512; it += X.G) if (PHM & 512) {
                    const int x = it & 7, slot = (it & 255) >> 3;
                    const int un = it < 256 ? (((x * 2 + (slot >> 4)) << 4) | (slot & 15)) : 256 + (((x * 16 + (slot >> 1)) << 1) | (slot & 1));
                    attn_unit(X, lds, l, un); }
#if PROBE_SP == 200
                pacc += __builtin_amdgcn_s_memrealtime() - pa0;
#endif
                REOPAQUE(X);
#if PROBE_SP == 201
                const unsigned long long pa1 = __builtin_amdgcn_s_memrealtime();
#endif
                for (int r2 = 0; r2 < NREP(8); ++r2)
                for (int it = X.c; it < 512; it += X.G) if (PHM & 1024) retout_item(X, lds, l, (it < 256) ? 256 + it : it - 256); }
#if PROBE_SP == 201
                pacc += __builtin_amdgcn_s_memrealtime() - pa1;
#endif
            } else if (sp == 3) { for (int rep = 0; rep < NREP(5); ++rep) {
                SchedBr S{ws + O_AM, ws + O_AS, ws + O_AR, ws + O_WBR + (size_t)l * 3 * 2048 * 1024 * 2, X.G, X.c}; EpiBr E{WSP(bf16_t, O_Z), WSP(bf16_t, O_YMB)};
                if (PHM & 2048) pg8::gemm_phase(lds, tid, 1024, 1024, 1024, S, E); }
            } else if (sp == 4) { for (int rep = 0; rep < NREP(6); ++rep) {
                for (int i = X.c * NTHREADS + tid; i < 3 * T; i += X.G * NTHREADS) WSP(float, O_RSS)[i] = 0.f;
                SchedOut S{ws + O_YMB, ws + O_WOUT + (size_t)l * 2048 * 2048 * 2, X.G, X.c}; EpiOut E{WSP(float, O_Y), WSP(float, O_RSS), rep == 0};
                if (PHM & 4096) pg8::gemm_phase(lds, tid, 2048, 2048, 2048, S, E); }
            } else {
                if (PHM & 8192) phase_rows(X, l, true, l + 1);
            }
        }
        if (ph + 1 < args.ph_hi) { if (ph == 0) { __syncthreads(); grid.sync(); } else { REOPAQUE(X); xbar.bar = (unsigned*)(X.ws + O_BAR); xcd_barrier(xbar); } }
#if PROBE_SP >= 0
        if (PROBE_SP < 200) { const bool hit = (PROBE_SP >= 100) ? (ph == PROBE_SP - 100) : (ph >= 2 && (ph - 2) % 7 == PROBE_SP); if (hit) pacc += __builtin_amdgcn_s_memrealtime() - pt0; }
#endif
    }
#if PROBE_SP == 300
    for (int k = 0; k < 20; ++k) xcd_barrier(xbar);
#endif
#if PROBE_SP >= 0
    if (blockIdx.x == 0 && threadIdx.x == 0) { const unsigned long long t1 = __builtin_amdgcn_s_memrealtime(); while (__builtin_amdgcn_s_memrealtime() - t1 < pacc) __builtin_amdgcn_s_sleep(8); }
#endif
}

extern "C" void kernel_launch(void* const* d_in, const int* in_sizes, int n_in, void* d_out, int out_size, void* d_ws, size_t ws_size, hipStream_t stream) {
    static int grid = 0;
    if (grid == 0) {
        if (n_in != 25 || ws_size < WS_END) { fprintf(stderr, "kernel_launch: unexpected n_in %d / ws %zu (need %zu)\n", n_in, ws_size, (size_t)WS_END); grid = -1; return; }
        int dev = 0, cus = 0, per_cu = 0;
        (void)hipGetDevice(&dev); (void)hipDeviceGetAttribute(&cus, hipDeviceAttributeMultiprocessorCount, dev);
        (void)hipFuncSetAttribute((const void*)mk_fwd, hipFuncAttributeMaxDynamicSharedMemorySize, LDS_BYTES);
        (void)hipOccupancyMaxActiveBlocksPerMultiprocessor(&per_cu, (const void*)mk_fwd, NTHREADS, LDS_BYTES);
        if (per_cu < 1) { fprintf(stderr, "kernel_launch: occupancy query says %d blocks per CU\n", per_cu); per_cu = 1; }
        grid = cus * per_cu;
    }
    if (grid < 0) return;
    Args a{};
    for (int i = 0; i < 25; ++i) a.in[i] = (const float*)d_in[i];
    a.out = (float*)d_out; a.ws = (unsigned char*)d_ws;
#if MK_MULTI
    for (int ph = 0; ph < NPHASE; ++ph) { a.ph_lo = ph; a.ph_hi = ph + 1; hipLaunchKernelGGL(mk_fwd, dim3(grid), dim3(NTHREADS), LDS_BYTES, stream, a); }
#else
    a.ph_lo = 0; a.ph_hi = NPHASE;
    (void)hipMemsetAsync((unsigned char*)d_ws + O_BAR, 0, 16384, stream);
    void* kargs[] = {&a};
    hipError_t e = hipLaunchCooperativeKernel((const void*)mk_fwd, dim3(grid), dim3(NTHREADS), kargs, LDS_BYTES, stream);
    if (e != hipSuccess) fprintf(stderr, "cooperative launch failed: %s (grid %d)\n", hipGetErrorString(e), grid);
#endif
}
```
